# Optimizing an MI355X kernel written in HIP

```python
import math
import jax, jax.numpy as jnp
from jax import lax
import numpy as np

D_MODEL = 1024
BATCH = 16
SEQ = 4096
DEPTH = 2
DEC_BATCH = 8
DEC_SEQ = 16
PAST_LEN = 4096

CHUNK = 64
D_MIX = D_MODEL
D_LRU = D_MIX // 4
LRU_HEADS = 4
LRU_BLOCK = D_LRU // LRU_HEADS
CONV_W = 4
LRU_C = 8.0
D_SSM = D_MIX // 4
SSM_GROUP = 16
SSM_GROUPS = D_SSM // SSM_GROUP
SSM_STATE = 64
HEAD_DIM = 64
N_Q_HEADS = (D_MIX // 2) // HEAD_DIM
N_KV_HEADS = 2
GQA_GROUP = N_Q_HEADS // N_KV_HEADS
D_ATT = N_Q_HEADS * HEAD_DIM
D_KV = N_KV_HEADS * HEAD_DIM
WINDOW = 128
BAND_PREV = WINDOW // CHUNK
ROPE_THETA = 10000.0
D_IN = 2 * D_LRU + D_SSM + D_ATT + 2 * D_KV
D_FF = 4 * D_MODEL
RMS_EPS = 1e-6
NEG_INF = -1e30

kernel_name = "hybrid_rglru_s5_swa_stream_step"

F32 = jnp.float32


def _rms_norm(x, g):
    xf = x.astype(F32)
    y = xf * lax.rsqrt(jnp.mean(xf * xf, axis=-1, keepdims=True) + RMS_EPS)
    return (y * g.astype(F32)).astype(x.dtype)


def _rope(x, pos):
    half = HEAD_DIM // 2
    inv = ROPE_THETA ** (-jnp.arange(half, dtype=F32) / half)
    ang = pos.astype(F32)[:, None] * inv[None, :]
    cos = jnp.cos(ang)[None, :, None, :]
    sin = jnp.sin(ang)[None, :, None, :]
    xf = x.astype(F32)
    x1, x2 = xf[..., :half], xf[..., half:]
    return jnp.concatenate([x1 * cos - x2 * sin, x2 * cos + x1 * sin], axis=-1).astype(x.dtype)


def _lin_combine(e1, e2):
    a1, b1 = e1
    a2, b2 = e2
    return a1 * a2, a2 * b1 + b2


def _cplx_combine(e1, e2):
    a1r, a1i, b1r, b1i = e1
    a2r, a2i, b2r, b2i = e2
    return (a2r * a1r - a2i * a1i,
            a2r * a1i + a2i * a1r,
            a2r * b1r - a2i * b1i + b2r,
            a2r * b1i + a2i * b1r + b2i)


def _rglru_mixer(u, gate, conv_buf, h0, conv_w, conv_b, w_r, b_r, w_i, b_i, lam):
    B, L = u.shape[0], u.shape[1]
    xx = jnp.concatenate([conv_buf.astype(u.dtype), u], axis=1)
    xc = conv_b.astype(F32)
    for j in range(CONV_W):
        xc = xc + xx[:, j:j + L].astype(F32) * conv_w[j].astype(F32)
    new_buf = xx[:, L:]
    xb = xc.reshape(B, L, LRU_HEADS, LRU_BLOCK)
    r = jax.nn.sigmoid(jnp.einsum('blhi,hij->blhj', xb, w_r.astype(F32)).reshape(B, L, D_LRU) + b_r.astype(F32))
    i = jax.nn.sigmoid(jnp.einsum('blhi,hij->blhj', xb, w_i.astype(F32)).reshape(B, L, D_LRU) + b_i.astype(F32))
    log_a = -LRU_C * r * jax.nn.softplus(-lam.astype(F32))
    a = jnp.exp(log_a)
    b = jnp.sqrt(-jnp.expm1(2.0 * log_a)) * (i * xc)
    b = b.at[:, 0].add(a[:, 0] * h0.astype(F32))
    h = lax.associative_scan(_lin_combine, (a, b), axis=1)[1]
    out = h * jax.nn.gelu(gate.astype(F32))
    return out.astype(u.dtype), new_buf, h[:, -1].astype(u.dtype)


def _s5_mixer(u, s0_re, s0_im, a_re, a_im, b_re, b_im, c_re, c_im, d, log_dt, w_glu, b_glu):
    B, L = u.shape[0], u.shape[1]
    dt = jnp.exp(log_dt.astype(F32))[:, None]
    lr, li = a_re.astype(F32), a_im.astype(F32)
    mag = jnp.exp(lr * dt)
    abar_r, abar_i = mag * jnp.cos(li * dt), mag * jnp.sin(li * dt)
    den = lr * lr + li * li
    nr = abar_r - 1.0
    fr = (nr * lr + abar_i * li) / den
    fi = (abar_i * lr - nr * li) / den
    br, bi = b_re.astype(F32), b_im.astype(F32)
    bb_r = fr[..., None] * br - fi[..., None] * bi
    bb_i = fr[..., None] * bi + fi[..., None] * br
    uf = u.astype(F32)
    ug = uf.reshape(B, L, SSM_GROUPS, SSM_GROUP)
    bu_r = jnp.einsum('blgc,gpc->blgp', ug, bb_r)
    bu_i = jnp.einsum('blgc,gpc->blgp', ug, bb_i)
    sr0, si0 = s0_re.astype(F32), s0_im.astype(F32)
    bu_r = bu_r.at[:, 0].add(abar_r * sr0 - abar_i * si0)
    bu_i = bu_i.at[:, 0].add(abar_r * si0 + abar_i * sr0)
    ar = jnp.broadcast_to(abar_r, bu_r.shape)
    ai = jnp.broadcast_to(abar_i, bu_i.shape)
    _, _, s_r, s_i = lax.associative_scan(_cplx_combine, (ar, ai, bu_r, bu_i), axis=1)
    y = (jnp.einsum('blgp,gcp->blgc', s_r, c_re.astype(F32))
         - jnp.einsum('blgp,gcp->blgc', s_i, c_im.astype(F32))).reshape(B, L, D_SSM)
    y = y + d.astype(F32) * uf
    z = jax.nn.gelu(y)
    out = z * jax.nn.sigmoid(z @ w_glu.astype(F32) + b_glu.astype(F32))
    return out.astype(u.dtype), s_r[:, -1].astype(u.dtype), s_i[:, -1].astype(u.dtype)


def _sink_softmax(scores, sinks, mask=None):
    s = sinks.astype(F32).reshape(N_KV_HEADS, GQA_GROUP, 1, 1)
    if mask is not None:
        scores = jnp.where(mask, scores, NEG_INF)
    m = jnp.maximum(jnp.max(scores, axis=-1, keepdims=True), s)
    e = jnp.exp(scores - m)
    return e / (jnp.sum(e, axis=-1, keepdims=True) + jnp.exp(s - m))


def _swa_prompt(q, k, v, sinks):
    B, L = q.shape[0], q.shape[1]
    nc = L // CHUNK
    scale = HEAD_DIM ** -0.5
    qc = q.astype(F32).reshape(B, nc, CHUNK, N_KV_HEADS, GQA_GROUP, HEAD_DIM)
    kc = k.astype(F32).reshape(B, nc, CHUNK, N_KV_HEADS, HEAD_DIM)
    vc = v.astype(F32).reshape(B, nc, CHUNK, N_KV_HEADS, HEAD_DIM)
    pad = ((0, 0), (BAND_PREV, 0), (0, 0), (0, 0), (0, 0))
    kp, vp = jnp.pad(kc, pad), jnp.pad(vc, pad)
    kb = jnp.concatenate([kp[:, j:j + nc] for j in range(BAND_PREV + 1)], axis=2)
    vb = jnp.concatenate([vp[:, j:j + nc] for j in range(BAND_PREV + 1)], axis=2)
    scores = jnp.einsum('bnqkgd,bnskd->bnkgqs', qc, kb) * scale
    key_chunk = jnp.arange(nc)[:, None] + (jnp.arange((BAND_PREV + 1) * CHUNK) // CHUNK)[None, :] - BAND_PREV
    mask = (key_chunk >= 0)[None, :, None, None, None, :]
    probs = _sink_softmax(scores, sinks, mask)
    out = jnp.einsum('bnkgqs,bnskd->bnqkgd', probs, vb)
    return out.reshape(B, L, D_ATT)


def _swa_cached(q, k, v, cache_k, cache_v, sinks):
    Bd, S = q.shape[0], q.shape[1]
    scale = HEAD_DIM ** -0.5
    kk = jnp.concatenate([cache_k.astype(F32), k.astype(F32)], axis=1)
    vv = jnp.concatenate([cache_v.astype(F32), v.astype(F32)], axis=1)
    qs = q.astype(F32).reshape(Bd, S, N_KV_HEADS, GQA_GROUP, HEAD_DIM)
    scores = jnp.einsum('bqkgd,bskd->bkgqs', qs, kk) * scale
    probs = _sink_softmax(scores, sinks)
    out = jnp.einsum('bkgqs,bskd->bqkgd', probs, vv)
    return out.reshape(Bd, S, D_ATT)


def _hybrid_layer(x, pos, conv_buf, h0, s0_re, s0_im, cache_k, cache_v, p):
    B, L = x.shape[0], x.shape[1]
    hn = _rms_norm(x, p['norm1'])
    proj = hn @ p['w_in']
    o1 = D_LRU
    o2 = o1 + D_LRU
    o3 = o2 + D_SSM
    o4 = o3 + D_ATT
    o5 = o4 + D_KV
    u_a, g_a, u_b = proj[..., :o1], proj[..., o1:o2], proj[..., o2:o3]
    q = proj[..., o3:o4].reshape(B, L, N_Q_HEADS, HEAD_DIM)
    k = proj[..., o4:o5].reshape(B, L, N_KV_HEADS, HEAD_DIM)
    v = proj[..., o5:].reshape(B, L, N_KV_HEADS, HEAD_DIM)

    out_a, conv_new, h_last = _rglru_mixer(u_a, g_a, conv_buf, h0, p['conv_w'], p['conv_b'],
                                           p['w_rg'], p['b_rg'], p['w_ig'], p['b_ig'], p['lru_lambda'])
    out_b, s_re, s_im = _s5_mixer(u_b, s0_re, s0_im, p['ssm_a_re'], p['ssm_a_im'], p['ssm_b_re'],
                                  p['ssm_b_im'], p['ssm_c_re'], p['ssm_c_im'], p['ssm_d'],
                                  p['ssm_log_dt'], p['w_glu'], p['b_glu'])
    q = _rope(q, pos)
    k = _rope(k, pos)
    if cache_k is None:
        out_c = _swa_prompt(q, k, v, p['attn_sinks'])
        k_new, v_new = k[:, -WINDOW:], v[:, -WINDOW:]
    else:
        out_c = _swa_cached(q, k, v, cache_k, cache_v, p['attn_sinks'])
        k_new, v_new = k, v

    mix = jnp.concatenate([out_a, out_b, out_c.astype(x.dtype)], axis=-1) @ p['w_out']
    x = x + mix
    hm = _rms_norm(x, p['norm2'])
    act = jnp.square(jax.nn.relu(hm @ p['w_up']))
    x = x + act @ p['w_down']
    return x, (conv_new, h_last, s_re, s_im, k_new, v_new)


def setup_inputs(seed: int = 0) -> dict:
    key = jax.random.key(seed)
    ks = jax.random.split(key, 40)
    nrm = lambda k, shape, s: jax.random.normal(k, shape, F32) * s
    a0 = jax.random.uniform(ks[10], (DEPTH, D_LRU), F32, 0.9, 0.999) ** (1.0 / LRU_C)
    lru_lambda = jnp.log(a0 / (1.0 - a0))
    ssm_a_re = -0.5 * jnp.exp(nrm(ks[11], (DEPTH, SSM_GROUPS, SSM_STATE), 0.05))
    ssm_a_im = math.pi * jnp.arange(SSM_STATE, dtype=F32)[None, None, :] + nrm(ks[12], (DEPTH, SSM_GROUPS, SSM_STATE), 0.01)
    ssm_log_dt = jax.random.uniform(ks[19], (DEPTH, SSM_GROUPS), F32, math.log(1e-3), math.log(1e-1))
    return {
        'x_prompt': nrm(ks[0], (BATCH, SEQ, D_MODEL), 1.0),
        'x_sample': nrm(ks[1], (DEC_BATCH, DEC_SEQ, D_MODEL), 1.0),
        'cache_conv_a': nrm(ks[2], (DEPTH, DEC_BATCH, CONV_W - 1, D_LRU), 1.0),
        'state_lru': nrm(ks[3], (DEPTH, DEC_BATCH, D_LRU), 0.5),
        'state_ssm_re': nrm(ks[4], (DEPTH, DEC_BATCH, SSM_GROUPS, SSM_STATE), 0.1),
        'state_ssm_im': nrm(ks[5], (DEPTH, DEC_BATCH, SSM_GROUPS, SSM_STATE), 0.1),
        'cache_k': nrm(ks[6], (DEPTH, DEC_BATCH, WINDOW, N_KV_HEADS, HEAD_DIM), 1.0),
        'cache_v': nrm(ks[7], (DEPTH, DEC_BATCH, WINDOW, N_KV_HEADS, HEAD_DIM), 1.0),
        'norm1': 1.0 + nrm(ks[8], (DEPTH, D_MODEL), 0.01),
        'w_in': nrm(ks[9], (DEPTH, D_MODEL, D_IN), D_MODEL ** -0.5),
        'conv_w': nrm(ks[13], (DEPTH, CONV_W, D_LRU), 0.5),
        'conv_b': nrm(ks[14], (DEPTH, D_LRU), 0.01),
        'w_rg': nrm(ks[15], (DEPTH, LRU_HEADS, LRU_BLOCK, LRU_BLOCK), LRU_BLOCK ** -0.5),
        'b_rg': nrm(ks[16], (DEPTH, D_LRU), 0.01),
        'w_ig': nrm(ks[17], (DEPTH, LRU_HEADS, LRU_BLOCK, LRU_BLOCK), LRU_BLOCK ** -0.5),
        'b_ig': nrm(ks[18], (DEPTH, D_LRU), 0.01),
        'lru_lambda': lru_lambda,
        'ssm_a_re': ssm_a_re,
        'ssm_a_im': ssm_a_im,
        'ssm_b_re': nrm(ks[20], (DEPTH, SSM_GROUPS, SSM_STATE, SSM_GROUP), (2 * SSM_GROUP) ** -0.5),
        'ssm_b_im': nrm(ks[21], (DEPTH, SSM_GROUPS, SSM_STATE, SSM_GROUP), (2 * SSM_GROUP) ** -0.5),
        'ssm_c_re': nrm(ks[22], (DEPTH, SSM_GROUPS, SSM_GROUP, SSM_STATE), SSM_STATE ** -0.5),
        'ssm_c_im': nrm(ks[23], (DEPTH, SSM_GROUPS, SSM_GROUP, SSM_STATE), SSM_STATE ** -0.5),
        'ssm_d': nrm(ks[24], (DEPTH, D_SSM), 0.5),
        'ssm_log_dt': ssm_log_dt,
        'w_glu': nrm(ks[25], (DEPTH, D_SSM, D_SSM), D_SSM ** -0.5),
        'b_glu': nrm(ks[26], (DEPTH, D_SSM), 0.01),
        'attn_sinks': nrm(ks[27], (DEPTH, N_Q_HEADS), 0.5),
        'w_out': nrm(ks[28], (DEPTH, D_MIX, D_MODEL), D_MIX ** -0.5),
        'norm2': 1.0 + nrm(ks[29], (DEPTH, D_MODEL), 0.01),
        'w_up': nrm(ks[30], (DEPTH, D_MODEL, D_FF), D_MODEL ** -0.5),
        'w_down': nrm(ks[31], (DEPTH, D_FF, D_MODEL), D_FF ** -0.5),
        'norm_f': 1.0 + nrm(ks[32], (D_MODEL,), 0.01),
    }


def reference(x_prompt, x_sample, cache_conv_a, state_lru, state_ssm_re, state_ssm_im, cache_k, cache_v,
              norm1, w_in, conv_w, conv_b, w_rg, b_rg, w_ig, b_ig, lru_lambda,
              ssm_a_re, ssm_a_im, ssm_b_re, ssm_b_im, ssm_c_re, ssm_c_im, ssm_d, ssm_log_dt,
              w_glu, b_glu, attn_sinks, w_out, norm2, w_up, w_down, norm_f):
    Bp, Lp = x_prompt.shape[0], x_prompt.shape[1]
    Ls = x_sample.shape[1]
    pos_p = jnp.arange(Lp, dtype=jnp.int32)
    pos_s = PAST_LEN + jnp.arange(Ls, dtype=jnp.int32)
    dt = x_prompt.dtype
    zero_conv = jnp.zeros((Bp, CONV_W - 1, D_LRU), dt)
    zero_h = jnp.zeros((Bp, D_LRU), dt)
    zero_s = jnp.zeros((Bp, SSM_GROUPS, SSM_STATE), dt)

    xp, xs = x_prompt, x_sample
    st_p = []
    st_s = []
    for l in range(DEPTH):
        p = dict(norm1=norm1[l], w_in=w_in[l], conv_w=conv_w[l], conv_b=conv_b[l], w_rg=w_rg[l],
                 b_rg=b_rg[l], w_ig=w_ig[l], b_ig=b_ig[l], lru_lambda=lru_lambda[l],
                 ssm_a_re=ssm_a_re[l], ssm_a_im=ssm_a_im[l], ssm_b_re=ssm_b_re[l], ssm_b_im=ssm_b_im[l],
                 ssm_c_re=ssm_c_re[l], ssm_c_im=ssm_c_im[l], ssm_d=ssm_d[l], ssm_log_dt=ssm_log_dt[l],
                 w_glu=w_glu[l], b_glu=b_glu[l], attn_sinks=attn_sinks[l], w_out=w_out[l],
                 norm2=norm2[l], w_up=w_up[l], w_down=w_down[l])
        xp, sp = _hybrid_layer(xp, pos_p, zero_conv, zero_h, zero_s, zero_s, None, None, p)
        xs, ss = _hybrid_layer(xs, pos_s, cache_conv_a[l], state_lru[l], state_ssm_re[l], state_ssm_im[l],
                               cache_k[l], cache_v[l], p)
        st_p.append(sp)
        st_s.append(ss)

    y_prompt = _rms_norm(xp, norm_f)
    y_sample = _rms_norm(xs, norm_f)
    conv_a_p = jnp.stack([s[0] for s in st_p], 0)
    lru_p = jnp.stack([s[1] for s in st_p], 0)
    ssm_re_p = jnp.stack([s[2] for s in st_p], 0)
    ssm_im_p = jnp.stack([s[3] for s in st_p], 0)
    k_p = jnp.stack([s[4] for s in st_p], 0)
    v_p = jnp.stack([s[5] for s in st_p], 0)
    conv_a_s = jnp.stack([s[0] for s in st_s], 0)
    lru_s = jnp.stack([s[1] for s in st_s], 0)
    ssm_re_s = jnp.stack([s[2] for s in st_s], 0)
    ssm_im_s = jnp.stack([s[3] for s in st_s], 0)
    k_s = jnp.stack([s[4] for s in st_s], 0)
    v_s = jnp.stack([s[5] for s in st_s], 0)
    return (y_prompt, y_sample, conv_a_p, lru_p, ssm_re_p, ssm_im_p, k_p, v_p,
            conv_a_s, lru_s, ssm_re_s, ssm_im_s, k_s, v_s)
```

```cpp
#define NOCG 1
#include <hip/hip_runtime.h>
#include <hip/hip_cooperative_groups.h>
#include <cstdio>
#include <cstdint>
namespace cg = cooperative_groups;
namespace pg8 {
#define PG8_LAS __attribute__((address_space(3)))
typedef unsigned short bf16_t;
typedef short bf16x8 __attribute__((ext_vector_type(8)));
typedef float f32x4 __attribute__((ext_vector_type(4)));
typedef unsigned u32x4 __attribute__((ext_vector_type(4)));
constexpr int BM = 256, BK = 64, HALF = 128, HTB = HALF * BK * 2  , STAGE_BYTES = 8 * HTB, NXCD = 8, WGM = 8;

__host__ __device__ __forceinline__ int lds_byte(int r, int c) { const int st = (r >> 4) * 2 + (c >> 5), rr = r & 15, cc = c & 31, ob = rr * 64 + cc * 2; return st * 1024 + (ob ^ (((ob >> 9) & 1) << 5)); }
__host__ __device__ __forceinline__ void stage_rc(int b, int& R, int& C) { const int st = b / 1024, sb = b % 1024, swz = sb ^ (((sb >> 9) & 1) << 5); R = (st >> 1) * 16 + swz / 64; C = (st & 1) * 32 + (swz % 64) / 2; }
__host__ __device__ __forceinline__ int perm32(int rho) { const int n = rho >> 4, i = rho & 15; return 8 * (i >> 2) + 4 * n + (i & 3); }

struct Unit { int pm, pn; };
struct Gemm { const bf16_t* A; const bf16_t* Bt; int M, N, K; };

struct StaticOrder {
    int nM, nN, nwg, G, c;
    __host__ __device__ void init(int M, int N, int G_, int c_) { nM = M / BM; nN = N / BM; nwg = nM * nN; G = G_; c = c_; }
    __host__ __device__ bool next(int i, Unit& u) const {
        const long L = (long)i * G + c; if (L >= nwg) return false;
        int wgid = (int)L; { const int q = nwg / NXCD, r = nwg % NXCD, xcd = wgid % NXCD, off = wgid / NXCD; wgid = (xcd < r ? xcd * (q + 1) : r * (q + 1) + (xcd - r) * q) + off; }
        const int nig = WGM * nN, gid = wgid / nig, fm = gid * WGM, gsz = (nM - fm) < WGM ? (nM - fm) : WGM;
        u.pm = fm + ((wgid % nig) % gsz); u.pn = (wgid % nig) / gsz; return true;
    }
    __device__ __forceinline__ void a_ready(const Unit&) const {}
    __device__ __forceinline__ void done(const Unit&) const {}
};

__device__ __forceinline__ unsigned cvt_pk_bf16(float lo, float hi) { unsigned r; asm volatile("v_cvt_pk_bf16_f32 %0, %1, %2" : "=v"(r) : "v"(lo), "v"(hi)); return r; }
typedef float f32x2 __attribute__((ext_vector_type(2)));
template <class Epi, class Sched, bool ALIGN_EPI = false, bool SP2 = false>
__device__ __forceinline__ void gemm_phase(PG8_LAS unsigned char* lds, const Gemm g, const Sched& S, const Epi& E) {
    int tid_ = threadIdx.x; asm volatile("" : "+v"(tid_));
    const int tid = tid_, wid = __builtin_amdgcn_readfirstlane(tid >> 6), lane = tid & 63, wr = wid >> 2, wc = wid & 3, fr = lane & 15, fq = lane >> 4;
    const int K = g.K, nt = K / BK;
    unsigned voffA[2], voffB[2];
#pragma unroll
    for (int i = 0; i < 2; ++i) { int R, C; stage_rc(tid * 16 + i * 8192, R, C); const int Rb = Epi::PERM ? ((R & ~31) + perm32(R & 31)) : R;
        voffA[i] = (unsigned)(R * K + C) * 2u; voffB[i] = (unsigned)(Rb * K + C) * 2u; }
    const size_t kstep = (size_t)(BK * 2);
    const size_t hstep = (size_t)HALF * K * 2;
    const size_t tstep = 2 * hstep;
    const unsigned ldsw = (unsigned)wid * 1024u;
    const int aoff = lds_byte(wr * 64 + fr, fq * 8), boff = lds_byte(wc * 32 + fr, fq * 8);
#define PG8_SA(b, h) (((b) * 2 + (h)) * HTB)
#define PG8_SB(b, h) ((4 + (b) * 2 + (h)) * HTB)
#define PG8_STAGE(bufoff, gbase, voff) do { _Pragma("unroll") for (int _i = 0; _i < 2; ++_i) \
        __builtin_amdgcn_global_load_lds((const unsigned*)((const char*)(gbase) + (voff)[_i]), (PG8_LAS unsigned*)(lds + (bufoff) + ldsw + _i * 8192), 16, 0, 0); } while (0)
#define PG8_LDA(dst, b, h) do { _Pragma("unroll") for (int m = 0; m < 4; ++m) _Pragma("unroll") for (int k = 0; k < 2; ++k) dst[m][k] = *(const PG8_LAS bf16x8*)(lds + PG8_SA(b, h) + aoff + m * 2048 + k * 1024); } while (0)
#define PG8_LDB(dst, b, h) do { _Pragma("unroll") for (int n = 0; n < 2; ++n) _Pragma("unroll") for (int k = 0; k < 2; ++k) dst[n][k] = *(const PG8_LAS bf16x8*)(lds + PG8_SB(b, h) + boff + n * 2048 + k * 1024); } while (0)
#define PG8_MMA(ai, bj, At, Bt) do { __builtin_amdgcn_s_setprio(1); _Pragma("unroll") for (int m = 0; m < 4; ++m) _Pragma("unroll") for (int n = 0; n < 2; ++n) _Pragma("unroll") for (int k = 0; k < 2; ++k) \
        acc[ai][bj][m][n] = __builtin_amdgcn_mfma_f32_16x16x32_bf16(Bt[n][k], At[m][k], acc[ai][bj][m][n], 0, 0, 0); __builtin_amdgcn_s_setprio(0); } while (0)
#define PG8_WAIT_V(n) asm volatile("s_waitcnt vmcnt(" #n ")" ::: "memory")
#define PG8_WAIT_L(n) asm volatile("s_waitcnt lgkmcnt(" #n ")" ::: "memory")
#define PG8_BAR __builtin_amdgcn_s_barrier()
#define PG8_SCHED __builtin_amdgcn_sched_barrier(0)
    Unit cur, nxt; int ui = 0;
    if (!S.next(0, cur)) return;
    f32x4 acc[2][2][4][2];
#pragma unroll
    for (int a = 0; a < 2; ++a)
#pragma unroll
        for (int b = 0; b < 2; ++b)
#pragma unroll
            for (int m = 0; m < 4; ++m)
#pragma unroll
                for (int n = 0; n < 2; ++n) acc[a][b][m][n] = (f32x4){0.f, 0.f, 0.f, 0.f};
    bf16x8 At[4][2], B0[2][2], B1[2][2];
    const char* cA = (const char*)g.A + (size_t)cur.pm * tstep; const char* cB = (const char*)g.Bt + (size_t)cur.pn * tstep;
    S.a_ready(cur);
    if constexpr (SP2) {
        PG8_STAGE(PG8_SB(0, 0), cB, voffB); PG8_STAGE(PG8_SB(0, 1), cB + hstep, voffB); PG8_STAGE(PG8_SA(0, 0), cA, voffA); PG8_STAGE(PG8_SA(0, 1), cA + hstep, voffA);
        if (wr == 1) PG8_BAR;
        PG8_WAIT_V(2); PG8_BAR;
        PG8_STAGE(PG8_SB(1, 0), cB + kstep, voffB); PG8_STAGE(PG8_SA(1, 0), cA + kstep, voffA); PG8_STAGE(PG8_SB(1, 1), cB + hstep + kstep, voffB);
        PG8_WAIT_V(6); PG8_BAR;
    } else {
        PG8_STAGE(PG8_SB(0, 0), cB, voffB); PG8_STAGE(PG8_SA(0, 0), cA, voffA); PG8_STAGE(PG8_SB(0, 1), cB + hstep, voffB); PG8_STAGE(PG8_SA(0, 1), cA + hstep, voffA);
        if (wr == 1) PG8_BAR;
        PG8_WAIT_V(4); PG8_BAR;
        PG8_STAGE(PG8_SB(1, 0), cB + kstep, voffB); PG8_STAGE(PG8_SA(1, 0), cA + kstep, voffA); PG8_STAGE(PG8_SB(1, 1), cB + hstep + kstep, voffB);
        PG8_WAIT_V(6); PG8_BAR;
    }
    for (;;) {
        const bool has_next = S.next(ui + 1, nxt);
        const char* nA = has_next ? (const char*)g.A + (size_t)nxt.pm * tstep : cA; const char* nB = has_next ? (const char*)g.Bt + (size_t)nxt.pn * tstep : cB;
        for (int t = 0; t < nt; t += 2) {
            const bool last = (t == nt - 2);
            const char* a1 = cA + (size_t)(t + 1) * kstep;
            const char* a2 = last ? nA : cA + (size_t)(t + 2) * kstep; const char* b2 = last ? nB : cB + (size_t)(t + 2) * kstep;
            const char* a3 = a2 + kstep; const char* b3 = b2 + kstep;
            if (last && has_next) S.a_ready(nxt);
            if constexpr (SP2) {
            PG8_LDB(B0, 0, 0); PG8_LDB(B1, 0, 1); PG8_SCHED; PG8_LDA(At, 0, 0); PG8_STAGE(PG8_SA(1, 1), a1 + hstep, voffA);
            PG8_WAIT_V(8); PG8_WAIT_L(0); PG8_BAR; PG8_MMA(0, 0, At, B0); PG8_MMA(0, 1, At, B1); PG8_BAR; PG8_SCHED;
            PG8_LDA(At, 0, 1); PG8_STAGE(PG8_SB(0, 0), b2, voffB); PG8_STAGE(PG8_SB(0, 1), b2 + hstep, voffB); PG8_STAGE(PG8_SA(0, 0), a2, voffA);
            PG8_WAIT_V(8); PG8_WAIT_L(0); PG8_BAR; PG8_MMA(1, 0, At, B0); PG8_MMA(1, 1, At, B1); PG8_BAR; PG8_SCHED;
            PG8_LDB(B0, 1, 0); PG8_LDB(B1, 1, 1); PG8_SCHED; PG8_LDA(At, 1, 0); PG8_STAGE(PG8_SA(0, 1), a2 + hstep, voffA);
            PG8_WAIT_V(8); PG8_WAIT_L(0); PG8_BAR; PG8_MMA(0, 0, At, B0); PG8_MMA(0, 1, At, B1); PG8_BAR; PG8_SCHED;
            PG8_LDA(At, 1, 1); PG8_STAGE(PG8_SB(1, 0), b3, voffB); PG8_STAGE(PG8_SB(1, 1), b3 + hstep, voffB); PG8_STAGE(PG8_SA(1, 0), a3, voffA);
            PG8_WAIT_V(8); PG8_WAIT_L(0); PG8_BAR; PG8_MMA(1, 0, At, B0); PG8_MMA(1, 1, At, B1); PG8_BAR; PG8_SCHED;
            } else {
            PG8_LDB(B0, 0, 0); PG8_SCHED; PG8_LDA(At, 0, 0); PG8_STAGE(PG8_SA(1, 1), a1 + hstep, voffA);
            PG8_WAIT_L(8); PG8_BAR; PG8_WAIT_L(0); PG8_MMA(0, 0, At, B0); PG8_BAR; PG8_SCHED;
            PG8_LDB(B1, 0, 1); PG8_STAGE(PG8_SB(0, 0), b2, voffB);
            PG8_BAR; PG8_WAIT_L(0); PG8_MMA(0, 1, At, B1); PG8_BAR;
            PG8_LDA(At, 0, 1); PG8_STAGE(PG8_SA(0, 0), a2, voffA);
            PG8_BAR; PG8_WAIT_L(0); PG8_MMA(1, 0, At, B0); PG8_BAR; PG8_SCHED;
            PG8_STAGE(PG8_SB(0, 1), b2 + hstep, voffB);
            PG8_WAIT_V(6); PG8_BAR; PG8_MMA(1, 1, At, B1); PG8_BAR;
            PG8_LDB(B0, 1, 0); PG8_SCHED; PG8_LDA(At, 1, 0); PG8_STAGE(PG8_SA(0, 1), a2 + hstep, voffA);
            PG8_WAIT_L(8); PG8_BAR; PG8_WAIT_L(0); PG8_MMA(0, 0, At, B0); PG8_BAR; PG8_SCHED;
            PG8_LDB(B1, 1, 1); PG8_STAGE(PG8_SB(1, 0), b3, voffB);
            PG8_BAR; PG8_WAIT_L(0); PG8_MMA(0, 1, At, B1); PG8_BAR;
            PG8_LDA(At, 1, 1); PG8_STAGE(PG8_SA(1, 0), a3, voffA);
            PG8_BAR; PG8_WAIT_L(0); PG8_MMA(1, 0, At, B0); PG8_BAR; PG8_SCHED;
            PG8_STAGE(PG8_SB(1, 1), b3 + hstep, voffB);
            PG8_WAIT_V(6); PG8_BAR; PG8_MMA(1, 1, At, B1); PG8_BAR;
            }
        }
        if constexpr (ALIGN_EPI) { if (wr == 0) PG8_BAR; }
        if constexpr (!Epi::AFTER_DRAIN) { E(acc, cur, wr, wc, fr, fq); S.done(cur); }
        if (!has_next) break;
#pragma unroll
        for (int a = 0; a < 2; ++a)
#pragma unroll
            for (int b = 0; b < 2; ++b)
#pragma unroll
                for (int m = 0; m < 4; ++m)
#pragma unroll
                    for (int n = 0; n < 2; ++n) acc[a][b][m][n] = (f32x4){0.f, 0.f, 0.f, 0.f};
        cur = nxt; cA = nA; cB = nB; ++ui;
        if constexpr (ALIGN_EPI) { if (wr == 1) PG8_BAR; }
    }
    PG8_WAIT_V(0);
    if constexpr (!ALIGN_EPI) { if (wr == 0) PG8_BAR; }
    PG8_BAR;
    if constexpr (Epi::AFTER_DRAIN) { E.fused(acc, cur, wr, wc, fr, fq, lds, wid, lane); S.done(cur); }
#undef PG8_SA
#undef PG8_SB
#undef PG8_STAGE
#undef PG8_LDA
#undef PG8_LDB
#undef PG8_MMA
#undef PG8_WAIT_V
#undef PG8_WAIT_L
#undef PG8_BAR
#undef PG8_SCHED
}
}

using pg8::bf16_t; using pg8::bf16x8; using pg8::f32x4; using pg8::u32x4; using pg8::cvt_pk_bf16;
typedef short bf16x4 __attribute__((ext_vector_type(4)));
typedef unsigned u32x2 __attribute__((ext_vector_type(2)));
#define LAS __attribute__((address_space(3)))

constexpr int DM = 1024, NB = 16, SEQ = 4096, DEPTH = 2, SB = 8, SS = 16;
constexpr int MP = NB * SEQ, MS = SB * SS, MREAL = MP + MS, MPAD = 65792;
constexpr int DIN = 1536, DFF = 4096, NPOS = SEQ + SS;
constexpr float EPS = 1e-6f;
constexpr int NTHR = 512, NWAVES = 8;
constexpr int LDS_BYTES = 147456 + 512, L_MISC = 147456, L_PTAB = 147456 + 64;

constexpr size_t O_Y = 0;
constexpr size_t O_CONVP = (size_t)MREAL * DM;
constexpr size_t O_LRUP = O_CONVP + (size_t)DEPTH * NB * 3 * 256;
constexpr size_t O_SREP = O_LRUP + (size_t)DEPTH * NB * 256;
constexpr size_t O_SIMP = O_SREP + (size_t)DEPTH * NB * 1024;
constexpr size_t O_KP = O_SIMP + (size_t)DEPTH * NB * 1024;
constexpr size_t O_VP = O_KP + (size_t)DEPTH * NB * 128 * 128;
constexpr size_t O_CONVS = O_VP + (size_t)DEPTH * NB * 128 * 128;
constexpr size_t O_LRUS = O_CONVS + (size_t)DEPTH * SB * 3 * 256;
constexpr size_t O_SRES = O_LRUS + (size_t)DEPTH * SB * 256;
constexpr size_t O_SIMS = O_SRES + (size_t)DEPTH * SB * 1024;
constexpr size_t O_KS = O_SIMS + (size_t)DEPTH * SB * 1024;
constexpr size_t O_VS = O_KS + (size_t)DEPTH * SB * 16 * 128;
constexpr size_t O_END = O_VS + (size_t)DEPTH * SB * 16 * 128;
static_assert(O_END == 68501504, "d_out map");

constexpr size_t WS_WIN = 0;
constexpr size_t WS_WOUT = WS_WIN + (size_t)DEPTH * DIN * DM * 2;
constexpr size_t WS_WUP = WS_WOUT + (size_t)DEPTH * DM * DM * 2;
constexpr size_t WS_WDN = WS_WUP + (size_t)DEPTH * DFF * DM * 2;
constexpr size_t WS_ROPE = WS_WDN + (size_t)DEPTH * DM * DFF * 2;
constexpr size_t WS_GATE = WS_ROPE + (size_t)NPOS * 32 * 8;
constexpr size_t WS_SP = WS_GATE + (size_t)DEPTH * 2 * 4 * 64 * 64 * 2;
constexpr size_t WS_ABAR = WS_SP + (size_t)DEPTH * 256 * 4;
constexpr size_t WS_BBM = WS_ABAR + (size_t)DEPTH * 16 * 64 * 4 * 4;
constexpr size_t WS_CMT = WS_BBM + (size_t)DEPTH * 16 * 128 * 16 * 2;
constexpr size_t WS_WGT = WS_CMT + (size_t)DEPTH * 16 * 16 * 128 * 2;
constexpr size_t WS_KBS = WS_WGT + (size_t)DEPTH * 256 * 256 * 2;
constexpr size_t WS_VTS = WS_KBS + (size_t)DEPTH * SB * 144 * 128 * 2;
constexpr size_t WS_SMALL = WS_VTS + (size_t)DEPTH * SB * 128 * 144 * 2;
constexpr int SM_CCONV = 0, SM_SLRU = SM_CCONV + DEPTH * SB * 3 * 256, SM_SSRE = SM_SLRU + DEPTH * SB * 256, SM_SSIM = SM_SSRE + DEPTH * SB * 1024, SM_CW = SM_SSIM + DEPTH * SB * 1024,
              SM_CB = SM_CW + DEPTH * 4 * 256, SM_BRG = SM_CB + DEPTH * 256, SM_BIG = SM_BRG + DEPTH * 256, SM_SD = SM_BIG + DEPTH * 256, SM_BGLU = SM_SD + DEPTH * 256,
              SM_SINK = SM_BGLU + DEPTH * 256, SM_NF = SM_SINK + 64, SM_END = SM_NF + DM;
constexpr size_t WS_SS = WS_SMALL + (size_t)((SM_END * 4 + 255) / 256) * 256;
constexpr size_t WS_SUMA = WS_SS + (size_t)MPAD * 16 * 4;
constexpr size_t WS_SUMB = WS_SUMA + (size_t)NB * 64 * 256 * 4;
constexpr size_t WS_SUMS = WS_SUMB + (size_t)NB * 64 * 256 * 4;
constexpr size_t WS_FOLD = WS_SUMS + (size_t)NB * 64 * 16 * 128 * 4;
constexpr size_t WS_XB = WS_FOLD + (size_t)320 * 16 * 128 * 4;
constexpr size_t WS_XRES = WS_XB + (size_t)MPAD * DM * 2;
constexpr size_t WS_BIG = WS_XRES + (size_t)MPAD * DM * 4;
constexpr size_t WS_UA = WS_BIG;
constexpr size_t WS_GA = WS_UA + (size_t)MPAD * 256 * 2;
constexpr size_t WS_UB = WS_GA + (size_t)MPAD * 256 * 2;
constexpr size_t WS_Q = WS_UB + (size_t)MPAD * 256 * 2;
constexpr size_t WS_KBP = WS_Q + (size_t)MPAD * 512 * 2;
constexpr size_t WS_VTP = WS_KBP + (size_t)MP * 128 * 2;
constexpr size_t WS_MIX = WS_VTP + (size_t)NB * 128 * SEQ * 2;
constexpr size_t WS_MIXEND = WS_MIX + (size_t)MPAD * DM * 2;
constexpr size_t WS_HID = WS_BIG;
constexpr size_t WS_END = WS_BIG + (size_t)MPAD * DFF * 2;
constexpr size_t WS_CTL = WS_END, CTL_BYTES = 16384;
constexpr size_t WS_TOTAL = WS_CTL + CTL_BYTES;
static_assert(WS_MIXEND <= WS_END && WS_TOTAL <= (size_t)1 << 30, "d_ws map");

struct Params { const float* in[33]; float* out; unsigned char* ws; };
enum { I_XP = 0, I_XS, I_CCONV, I_SLRU, I_SSRE, I_SSIM, I_CK, I_CV, I_N1, I_WIN, I_CW, I_CB, I_WRG, I_BRG, I_WIG, I_BIG_, I_LAM,
       I_ARE, I_AIM, I_BRE, I_BIM, I_CRE, I_CIM, I_SD, I_LDT, I_WGLU, I_BGLU, I_SINK, I_WOUT, I_N2, I_WUP, I_WDN, I_NF };

__device__ __forceinline__ float bf2f(short v) { return __uint_as_float(((unsigned)(unsigned short)v) << 16); }
__device__ __forceinline__ bf16_t f2bf(float v) { return (bf16_t)(cvt_pk_bf16(v, 0.f) & 0xffffu); }
__device__ __forceinline__ float sigmoidf_(float x) { return __builtin_amdgcn_rcpf(1.f + __expf(-x)); }
__device__ __forceinline__ float gelu_tanh(float x) { const float u = 1.5957691216f * (x + 0.044715f * x * x * x); return x * __builtin_amdgcn_rcpf(1.f + __expf(-u)); }
__device__ __forceinline__ f32x4 mma16(bf16x8 x, bf16x8 y, f32x4 acc) { return __builtin_amdgcn_mfma_f32_16x16x32_bf16(x, y, acc, 0, 0, 0); }
__device__ __forceinline__ float wave_sum(float v) {
#pragma unroll
    for (int o = 1; o < 64; o <<= 1) v += __shfl_xor(v, o);
    return v;
}
__device__ __forceinline__ void store8(bf16_t* dst, const float (&v)[8]) {
    u32x4 w; w.x = cvt_pk_bf16(v[0], v[1]); w.y = cvt_pk_bf16(v[2], v[3]); w.z = cvt_pk_bf16(v[4], v[5]); w.w = cvt_pk_bf16(v[6], v[7]);
    *(u32x4*)dst = w;
}
__device__ __forceinline__ void store8_nt(bf16_t* dst, const float (&v)[8]) {
    u32x4 w; w.x = cvt_pk_bf16(v[0], v[1]); w.y = cvt_pk_bf16(v[2], v[3]); w.z = cvt_pk_bf16(v[4], v[5]); w.w = cvt_pk_bf16(v[6], v[7]);
    __builtin_nontemporal_store(w, (u32x4*)dst);
}
__device__ __forceinline__ float ss_rs(const float* ss, int row) {
    const f32x4* s4 = (const f32x4*)(ss + (size_t)row * 16);
    const f32x4 a = s4[0], b = s4[1], c = s4[2], d = s4[3];
    const float tot = (((a[0] + a[1]) + (a[2] + a[3])) + ((b[0] + b[1]) + (b[2] + b[3]))) + (((c[0] + c[1]) + (c[2] + c[3])) + ((d[0] + d[1]) + (d[2] + d[3])));
    return __builtin_amdgcn_rsqf(tot * (1.f / 1024.f) + EPS);
}
__device__ __forceinline__ void rope8(float (&v)[8], const float* rope, int pos, int jp) {
    const f32x4* r = (const f32x4*)(rope + ((size_t)pos * 32 + jp) * 2);
    const f32x4 a = r[0], b = r[1];
    float x1, x2;
    x1 = v[0]; x2 = v[1]; v[0] = x1 * a[0] - x2 * a[1]; v[1] = x2 * a[0] + x1 * a[1];
    x1 = v[2]; x2 = v[3]; v[2] = x1 * a[2] - x2 * a[3]; v[3] = x2 * a[2] + x1 * a[3];
    x1 = v[4]; x2 = v[5]; v[4] = x1 * b[0] - x2 * b[1]; v[5] = x2 * b[0] + x1 * b[1];
    x1 = v[6]; x2 = v[7]; v[6] = x1 * b[2] - x2 * b[3]; v[7] = x2 * b[2] + x1 * b[3];
}

__device__ __forceinline__ void rs8(float (&rsv)[2][4], const float* ss, int rowbase, int fq) {
    f32x4 part[2][4];
#pragma unroll
    for (int ai = 0; ai < 2; ++ai)
#pragma unroll
        for (int m = 0; m < 4; ++m) { const int row = rowbase + ai * 128 + m * 16;
            part[ai][m] = (f32x4){0.f, 0.f, 0.f, 0.f};
            if (row < MREAL) part[ai][m] = *(const f32x4*)(ss + (size_t)row * 16 + 4 * fq); }
#pragma unroll
    for (int ai = 0; ai < 2; ++ai)
#pragma unroll
        for (int m = 0; m < 4; ++m) { float t = (part[ai][m][0] + part[ai][m][1]) + (part[ai][m][2] + part[ai][m][3]);
            t += __shfl_xor(t, 16); t += __shfl_xor(t, 32);
            rsv[ai][m] = __builtin_amdgcn_rsqf(t * (1.f / 1024.f) + EPS); }
}

struct EpiIn {
    static constexpr bool PERM = true, AFTER_DRAIN = false;
    unsigned char* ws; float* out; int l;
    __device__ __forceinline__ void operator()(const f32x4 (&acc)[2][2][4][2], const pg8::Unit& u, int wr, int wc, int fr, int fq) const {
        asm volatile("" : "+v"(fr), "+v"(fq)); asm volatile("" : "+s"(wr), "+s"(wc));
        const int pn = u.pn;
        const float* ss = (const float*)(ws + WS_SS); const float* rope = (const float*)(ws + WS_ROPE);
        bf16_t* ua = (bf16_t*)(ws + WS_UA); bf16_t* ga = (bf16_t*)(ws + WS_GA); bf16_t* ub = (bf16_t*)(ws + WS_UB); bf16_t* q = (bf16_t*)(ws + WS_Q);
        bf16_t* kbp = (bf16_t*)(ws + WS_KBP); bf16_t* vtp = (bf16_t*)(ws + WS_VTP);
        bf16_t* kbs = (bf16_t*)(ws + WS_KBS) + (size_t)l * SB * 144 * 128; bf16_t* vts = (bf16_t*)(ws + WS_VTS) + (size_t)l * SB * 128 * 144;
        float* conv_p = out + O_CONVP + (size_t)l * NB * 3 * 256; float* conv_s = out + O_CONVS + (size_t)l * SB * 3 * 256;
        float* k_p = out + O_KP + (size_t)l * NB * 128 * 128; float* v_p = out + O_VP + (size_t)l * NB * 128 * 128;
        float* k_s = out + O_KS + (size_t)l * SB * 16 * 128; float* v_s = out + O_VS + (size_t)l * SB * 16 * 128;
        float rsv[2][4]; rs8(rsv, ss, u.pm * 256 + wr * 64 + fr, fq);
#pragma unroll
        for (int ai = 0; ai < 2; ++ai)
#pragma unroll
            for (int m = 0; m < 4; ++m) {
                const int row = u.pm * 256 + ai * 128 + wr * 64 + m * 16 + fr;
                if (row < MREAL) {
                    const float rs = rsv[ai][m];
                    const bool smp = row >= MP;
                    const int b = smp ? (row - MP) >> 4 : row >> 12, t = smp ? (row - MP) & 15 : row & 4095, pos = smp ? SEQ + t : t;
#pragma unroll
                    for (int bj = 0; bj < 2; ++bj) {
                        const int c0 = bj * 128 + wc * 32 + fq * 8;
                        float v[8];
#pragma unroll
                        for (int e = 0; e < 4; ++e) { v[e] = acc[ai][bj][m][0][e] * rs; v[4 + e] = acc[ai][bj][m][1][e] * rs; }
                        if (pn <= 2) {
                            bf16_t* dst = (pn == 0 ? ua : (pn == 1 ? ga : ub)) + (size_t)row * 256 + c0;
                            store8(dst, v);
                            if (pn == 0) {
                                const int tt = smp ? t - (SS - 3) : t - (SEQ - 3);
                                if (tt >= 0) { float* o = (smp ? conv_s : conv_p) + (size_t)(b * 3 + tt) * 256 + c0;
                                    *(f32x4*)o = (f32x4){v[0], v[1], v[2], v[3]}; *(f32x4*)(o + 4) = (f32x4){v[4], v[5], v[6], v[7]}; }
                            }
                        } else if (pn <= 4) {
                            rope8(v, rope, pos, (c0 & 63) >> 1);
#pragma unroll
                            for (int e = 0; e < 8; ++e) v[e] *= 0.125f;
                            store8(q + (size_t)row * 512 + (pn - 3) * 256 + c0, v);
                        } else if (bj == 0) {
                            const int kvh = c0 >> 6, jp = (c0 & 63) >> 1;
                            rope8(v, rope, pos, jp);
                            bf16_t* dst = smp ? kbs + (size_t)(b * 144 + 128 + t) * 128 + c0 : kbp + (size_t)row * 128 + c0;
                            store8(dst, v);
                            const int tt = smp ? t : t - (SEQ - 128);
                            if (tt >= 0) { float* o = (smp ? k_s + ((size_t)(b * SS + tt) * 2 + kvh) * 64 : k_p + ((size_t)(b * 128 + tt) * 2 + kvh) * 64) + jp;
                                *(f32x4*)o = (f32x4){v[0], v[2], v[4], v[6]}; *(f32x4*)(o + 32) = (f32x4){v[1], v[3], v[5], v[7]}; }
                        } else {
                            const int cv = c0 - 128, kvh = cv >> 6, d0 = cv & 63;
                            if (!smp) { bf16_t* dst = vtp + (size_t)(b * 128 + cv) * SEQ + t;
#pragma unroll
                                for (int e = 0; e < 8; ++e) dst[(size_t)e * SEQ] = f2bf(v[e]);
                            } else { bf16_t* dst = vts + (size_t)(b * 128 + cv) * 144 + 128 + t;
#pragma unroll
                                for (int e = 0; e < 8; ++e) dst[e * 144] = f2bf(v[e]); }
                            const int tt = smp ? t : t - (SEQ - 128);
                            if (tt >= 0) { float* o = (smp ? v_s + ((size_t)(b * SS + tt) * 2 + kvh) * 64 : v_p + ((size_t)(b * 128 + tt) * 2 + kvh) * 64) + d0;
                                *(f32x4*)o = (f32x4){v[0], v[1], v[2], v[3]}; *(f32x4*)(o + 4) = (f32x4){v[4], v[5], v[6], v[7]}; }
                        }
                    }
                }
                asm volatile("" ::: "memory");
            }
    }
};

struct EpiRes {
    static constexpr bool PERM = true, AFTER_DRAIN = false;
    const __attribute__((address_space(1))) float *xin_p, *xin_s;
    float *xout_p, *xout_s; bf16_t* xb; float* ss;
    __device__ __forceinline__ void operator()(const f32x4 (&acc)[2][2][4][2], const pg8::Unit& u, int wr, int wc, int fr, int fq) const {
        asm volatile("" : "+v"(fr), "+v"(fq)); asm volatile("" : "+s"(wr), "+s"(wc));
        const int pn = u.pn;
#pragma unroll
        for (int ai = 0; ai < 2; ++ai)
#pragma unroll
            for (int m = 0; m < 4; ++m) {
                const int row = u.pm * 256 + ai * 128 + wr * 64 + m * 16 + fr;
                const bool valid = row < MREAL;
                float sq = 0.f;
                if (valid) {
                    const size_t ro = row < MP ? (size_t)row * DM : (size_t)(row - MP) * DM;
                    const __attribute__((address_space(1))) float* xi = (row < MP ? xin_p : xin_s) + ro; float* xo = (row < MP ? xout_p : xout_s) + ro;
#pragma unroll
                    for (int bj = 0; bj < 2; ++bj) {
                        const int c = pn * 256 + bj * 128 + wc * 32 + fq * 8;
                        const f32x4 a0 = *(const __attribute__((address_space(1))) f32x4*)(xi + c) + acc[ai][bj][m][0], a1 = *(const __attribute__((address_space(1))) f32x4*)(xi + c + 4) + acc[ai][bj][m][1];
                        if (xout_p) { *(f32x4*)(xo + c) = a0; *(f32x4*)(xo + c + 4) = a1; }
                        sq += ((a0[0] * a0[0] + a0[1] * a0[1]) + (a0[2] * a0[2] + a0[3] * a0[3])) + ((a1[0] * a1[0] + a1[1] * a1[1]) + (a1[2] * a1[2] + a1[3] * a1[3]));
                        if (xb) { u32x4 w; w.x = cvt_pk_bf16(a0[0], a0[1]); w.y = cvt_pk_bf16(a0[2], a0[3]); w.z = cvt_pk_bf16(a1[0], a1[1]); w.w = cvt_pk_bf16(a1[2], a1[3]);
                            *(u32x4*)(xb + (size_t)row * DM + c) = w; }
                    }
                }
                sq += __shfl_xor(sq, 16); sq += __shfl_xor(sq, 32);
                if (valid && fq == 0) ss[(size_t)row * 16 + pn * 4 + wc] = sq;
            }
    }
};

struct EpiResB {
    static constexpr bool PERM = true, AFTER_DRAIN = false;
    bf16_t* xb; float* ss;
    __device__ __forceinline__ void operator()(const f32x4 (&acc)[2][2][4][2], const pg8::Unit& u, int wr, int wc, int fr, int fq) const {
        asm volatile("" : "+v"(fr), "+v"(fq)); asm volatile("" : "+s"(wr), "+s"(wc));
        const int pn = u.pn;
#pragma unroll
        for (int ai = 0; ai < 2; ++ai)
#pragma unroll
            for (int m = 0; m < 4; ++m) {
                const int row = u.pm * 256 + ai * 128 + wr * 64 + m * 16 + fr;
                const bool valid = row < MREAL;
                float sq = 0.f;
                if (valid) {
#pragma unroll
                    for (int bj = 0; bj < 2; ++bj) {
                        const int c = pn * 256 + bj * 128 + wc * 32 + fq * 8;
                        u32x4* px = (u32x4*)(xb + (size_t)row * DM + c);
                        const u32x4 xw = *px;
                        const f32x4 x0 = {__uint_as_float(xw.x << 16), __uint_as_float(xw.x & 0xffff0000u), __uint_as_float(xw.y << 16), __uint_as_float(xw.y & 0xffff0000u)};
                        const f32x4 x1 = {__uint_as_float(xw.z << 16), __uint_as_float(xw.z & 0xffff0000u), __uint_as_float(xw.w << 16), __uint_as_float(xw.w & 0xffff0000u)};
                        const f32x4 a0 = x0 + acc[ai][bj][m][0], a1 = x1 + acc[ai][bj][m][1];
                        sq += ((a0[0] * a0[0] + a0[1] * a0[1]) + (a0[2] * a0[2] + a0[3] * a0[3])) + ((a1[0] * a1[0] + a1[1] * a1[1]) + (a1[2] * a1[2] + a1[3] * a1[3]));
                        u32x4 w; w.x = cvt_pk_bf16(a0[0], a0[1]); w.y = cvt_pk_bf16(a0[2], a0[3]); w.z = cvt_pk_bf16(a1[0], a1[1]); w.w = cvt_pk_bf16(a1[2], a1[3]);
                        *px = w;
                    }
                }
                sq += __shfl_xor(sq, 16); sq += __shfl_xor(sq, 32);
                if (valid && fq == 0) ss[(size_t)row * 16 + pn * 4 + wc] = sq;
            }
    }
};

struct EpiUp {
    static constexpr bool PERM = true, AFTER_DRAIN = false;
    const float* ss; bf16_t* hid;
    __device__ __forceinline__ void operator()(const f32x4 (&acc)[2][2][4][2], const pg8::Unit& u, int wr, int wc, int fr, int fq) const {
        asm volatile("" : "+v"(fr), "+v"(fq)); asm volatile("" : "+s"(wr), "+s"(wc));
        float rsv[2][4]; rs8(rsv, ss, u.pm * 256 + wr * 64 + fr, fq);
#pragma unroll
        for (int ai = 0; ai < 2; ++ai)
#pragma unroll
            for (int m = 0; m < 4; ++m) {
                const int row = u.pm * 256 + ai * 128 + wr * 64 + m * 16 + fr;
                if (row < MREAL) {
                    const float rs = rsv[ai][m];
#pragma unroll
                    for (int bj = 0; bj < 2; ++bj) {
                        const int c = u.pn * 256 + bj * 128 + wc * 32 + fq * 8;
                        float v[8];
#pragma unroll
                        for (int e = 0; e < 4; ++e) { float a = fmaxf(acc[ai][bj][m][0][e] * rs, 0.f), b = fmaxf(acc[ai][bj][m][1][e] * rs, 0.f); v[e] = a * a; v[4 + e] = b * b; }
                        store8_nt(hid + (size_t)row * DFF + c, v);
                    }
                }
            }
    }
};

#define WSP(T, off) ((T*)(p.ws + (off)))
#define INP(i) ((const float*)(((const LAS unsigned long long*)(lds + L_PTAB))[i]))
#define LDS_WAIT() asm volatile("s_waitcnt lgkmcnt(0)" ::: "memory")

__device__ __forceinline__ void sincos_d(double x, double& s, double& c) {
    const double TWO_PI = 6.283185307179586476925;
    const double k = rint(x / TWO_PI), r = x - k * TWO_PI, r2 = r * r;
    double ps = 1.0, pc = 1.0;
#pragma unroll
    for (int n = 15; n >= 1; --n) { ps = 1.0 - r2 / ((2.0 * n) * (2.0 * n + 1.0)) * ps; pc = 1.0 - r2 / ((2.0 * n - 1.0) * (2.0 * n)) * pc; }
    s = r * ps; c = pc;
}

template <int MODE>
__device__ __forceinline__ void transpose_item(const float* W, const float* gain, int K, int N, bf16_t* WT, LAS float* scr, int item, int lane) {
    const int nblk = N / 32, kb = item / nblk, nb = item % nblk, k0 = 64 * kb, n0 = 32 * nb;
    float wv[32];
#pragma unroll
    for (int i = 0; i < 32; ++i) wv[i] = W[(size_t)(k0 + 2 * i + (lane >> 5)) * N + n0 + (lane & 31)];
    if (gain) {
#pragma unroll
        for (int i = 0; i < 32; ++i) wv[i] *= gain[k0 + 2 * i + (lane >> 5)];
    }
#pragma unroll
    for (int i = 0; i < 32; ++i) scr[(2 * i + (lane >> 5)) * 33 + (lane & 31)] = wv[i];
    LDS_WAIT();
    const int c = lane & 7;
#pragma unroll
    for (int j = 0; j < 4; ++j) { const int n = (lane >> 3) + 8 * j; const LAS float* s = scr + (8 * c) * 33 + n;
        u32x4 o; o.x = cvt_pk_bf16(s[0 * 33], s[1 * 33]); o.y = cvt_pk_bf16(s[2 * 33], s[3 * 33]); o.z = cvt_pk_bf16(s[4 * 33], s[5 * 33]); o.w = cvt_pk_bf16(s[6 * 33], s[7 * 33]);
        int nn = n0 + n;
        if (MODE == 1 && nn >= 768 && nn < 1408) { const int r = nn - 768, d = r & 63; nn = 768 + (r & ~63) + 2 * (d & 31) + (d >> 5); }
        *(u32x4*)(WT + (size_t)nn * K + k0 + 8 * c) = o; }
    LDS_WAIT();
}

__device__ __forceinline__ void prologue(const Params& p, LAS unsigned char* lds) {
    const int tid = threadIdx.x, lane = tid & 63, wave = tid >> 6;
    const int gw = blockIdx.x * NWAVES + wave, NGW = gridDim.x * NWAVES, gt = blockIdx.x * NTHR + tid, NGT = gridDim.x * NTHR;
    LAS float* scr = (LAS float*)(lds + wave * 16384);
#pragma unroll 1
    for (int ph = 0; ph < 2; ++ph) {
      if (((ph ^ wave) & 1) == 0) {
    constexpr int I_IN = 16 * 48, I_OUT = 16 * 32, I_UP = 16 * 128, I_DN = 64 * 32, I_L = I_IN + I_OUT + I_UP + I_DN;
    for (int it = gw; it < DEPTH * I_L; it += NGW) {
        const int l = it / I_L; int r = it % I_L;
        if (r < I_IN) { transpose_item<1>(INP(I_WIN) + (size_t)l * DM * DIN, INP(I_N1) + l * DM, DM, DIN, WSP(bf16_t, WS_WIN) + (size_t)l * DIN * DM, scr, r, lane); continue; } r -= I_IN;
        if (r < I_OUT) { transpose_item<0>(INP(I_WOUT) + (size_t)l * DM * DM, nullptr, DM, DM, WSP(bf16_t, WS_WOUT) + (size_t)l * DM * DM, scr, r, lane); continue; } r -= I_OUT;
        if (r < I_UP) { transpose_item<0>(INP(I_WUP) + (size_t)l * DM * DFF, INP(I_N2) + l * DM, DM, DFF, WSP(bf16_t, WS_WUP) + (size_t)l * DFF * DM, scr, r, lane); continue; } r -= I_UP;
        transpose_item<0>(INP(I_WDN) + (size_t)l * DFF * DM, nullptr, DFF, DM, WSP(bf16_t, WS_WDN) + (size_t)l * DM * DFF, scr, r, lane);
    }
      } else {
    {
        bf16_t* xb = WSP(bf16_t, WS_XB); float* ss = WSP(float, WS_SS);
        static_assert(MPAD % 4 == 0 && MREAL % 4 == 0 && MP % 4 == 0, "row groups of 4");
#pragma unroll 1
        for (int row0 = gw * 4; row0 < MPAD; row0 += NGW * 4) {
            f32x4 v[4][4];
            if (row0 < MREAL) {
                const float* xbase = row0 < MP ? INP(I_XP) + (size_t)row0 * DM : INP(I_XS) + (size_t)(row0 - MP) * DM;
#pragma unroll
                for (int r = 0; r < 4; ++r)
#pragma unroll
                    for (int j = 0; j < 4; ++j) v[r][j] = ((const f32x4*)(xbase + (size_t)r * DM) + lane)[64 * j];
            } else {
#pragma unroll
                for (int r = 0; r < 4; ++r)
#pragma unroll
                    for (int j = 0; j < 4; ++j) v[r][j] = (f32x4){0.f, 0.f, 0.f, 0.f};
            }
#pragma unroll
            for (int r = 0; r < 4; ++r) {
                float sq = 0.f;
#pragma unroll
                for (int j = 0; j < 4; ++j) sq += (v[r][j][0] * v[r][j][0] + v[r][j][1] * v[r][j][1]) + (v[r][j][2] * v[r][j][2] + v[r][j][3] * v[r][j][3]);
                const float tot = wave_sum(sq);
                unsigned long long* o8 = (unsigned long long*)(xb + (size_t)(row0 + r) * DM) + lane;
#pragma unroll
                for (int j = 0; j < 4; ++j) o8[64 * j] = (unsigned long long)cvt_pk_bf16(v[r][j][0], v[r][j][1]) | ((unsigned long long)cvt_pk_bf16(v[r][j][2], v[r][j][3]) << 32);
                if (lane < 16) ss[(size_t)(row0 + r) * 16 + lane] = lane == 0 ? tot : 0.f;
            }
        }
    }
      }
    }
    { float* sm = WSP(float, WS_SMALL);
#define CPY(I, OFF, N) for (int idx = gt; idx < (N); idx += NGT) sm[(OFF) + idx] = INP(I)[idx];
      CPY(I_CCONV, SM_CCONV, DEPTH * SB * 3 * 256) CPY(I_SLRU, SM_SLRU, DEPTH * SB * 256) CPY(I_SSRE, SM_SSRE, DEPTH * SB * 1024) CPY(I_SSIM, SM_SSIM, DEPTH * SB * 1024)
      CPY(I_CW, SM_CW, DEPTH * 4 * 256) CPY(I_CB, SM_CB, DEPTH * 256) CPY(I_BRG, SM_BRG, DEPTH * 256) CPY(I_BIG_, SM_BIG, DEPTH * 256) CPY(I_SD, SM_SD, DEPTH * 256)
      CPY(I_BGLU, SM_BGLU, DEPTH * 256) CPY(I_SINK, SM_SINK, DEPTH * 8) CPY(I_NF, SM_NF, DM)
#undef CPY
    }
    { float* rope = WSP(float, WS_ROPE);
      for (int idx = gt; idx < NPOS * 32; idx += NGT) { const int pos = idx >> 5, j = idx & 31;
          const float invf = (float)exp(-(double)j * (9.210340371976184 / 32.0)); double s, c; sincos_d((double)pos * (double)invf, s, c);
          rope[2 * idx] = (float)c; rope[2 * idx + 1] = (float)s; } }
    { bf16_t* gate = WSP(bf16_t, WS_GATE);
      for (int idx = gt; idx < DEPTH * 2 * 4 * 64 * 64; idx += NGT) { const int k = idx & 63, n = (idx >> 6) & 63, h = (idx >> 12) & 3, gt_ = (idx >> 14) & 1, l = idx >> 15;
          gate[idx] = f2bf((gt_ ? INP(I_WIG) : INP(I_WRG))[((size_t)(l * 4 + h) * 64 + k) * 64 + n]); } }
    { float* sp = WSP(float, WS_SP);
      for (int idx = gt; idx < DEPTH * 256; idx += NGT) sp[idx] = (float)log1p(exp(-(double)INP(I_LAM)[idx])); }
    { float* abar = WSP(float, WS_ABAR); bf16_t* bbm = WSP(bf16_t, WS_BBM);
      for (int idx = gt; idx < DEPTH * 16 * 64; idx += NGT) { const int lg = idx >> 6, pp = idx & 63;
          const double dt = exp((double)INP(I_LDT)[lg]), lr = (double)INP(I_ARE)[idx], li = (double)INP(I_AIM)[idx], mag = exp(lr * dt);
          double sn, cs; sincos_d(li * dt, sn, cs);
          const double ar = mag * cs, ai = mag * sn, den = lr * lr + li * li, nr = ar - 1.0, fr = (nr * lr + ai * li) / den, fi = (ai * lr - nr * li) / den;
          double xr = ar, xi = ai;
#pragma unroll
          for (int q = 0; q < 6; ++q) { const double t = xr * xr - xi * xi; xi = 2.0 * xr * xi; xr = t; }
          *(f32x4*)(abar + (size_t)idx * 4) = (f32x4){(float)ar, (float)ai, (float)xr, (float)xi};
          for (int c = 0; c < 16; ++c) { const double br = (double)INP(I_BRE)[(size_t)idx * 16 + c], bi = (double)INP(I_BIM)[(size_t)idx * 16 + c];
              bbm[((size_t)lg * 128 + pp) * 16 + c] = f2bf((float)(fr * br - fi * bi)); bbm[((size_t)lg * 128 + 64 + pp) * 16 + c] = f2bf((float)(fr * bi + fi * br)); } } }
    { bf16_t* cmt = WSP(bf16_t, WS_CMT);
      for (int idx = gt; idx < DEPTH * 16 * 16 * 128; idx += NGT) { const int k = idx & 127, lgc = idx >> 7;
          cmt[idx] = f2bf(k < 64 ? INP(I_CRE)[(size_t)lgc * 64 + k] : -INP(I_CIM)[(size_t)lgc * 64 + k - 64]); } }
    { bf16_t* wgt = WSP(bf16_t, WS_WGT);
      for (int idx = gt; idx < DEPTH * 65536; idx += NGT) { const int k = idx & 255, n = (idx >> 8) & 255, l = idx >> 16;
          wgt[idx] = f2bf(INP(I_WGLU)[((size_t)l * 256 + k) * 256 + n]); } }
    { bf16_t* kbs = WSP(bf16_t, WS_KBS); bf16_t* vts = WSP(bf16_t, WS_VTS);
      for (int idx = gt; idx < DEPTH * SB * 128 * 128; idx += NGT) { const int col = idx & 127, i = (idx >> 7) & 127, lb = idx >> 14;
          const int kvh = col >> 6, ph = col & 63, d = (ph >> 1) + 32 * (ph & 1);
          kbs[((size_t)lb * 144 + i) * 128 + col] = f2bf(INP(I_CK)[(((size_t)lb * 128 + i) * 2 + kvh) * 64 + d]);
          vts[((size_t)lb * 128 + col) * 144 + i] = f2bf(INP(I_CV)[((size_t)lb * 128 + i) * 128 + col]); } }
}

constexpr int L_AL = 0, L_BL = 33792;
constexpr int L_BU = 0;
constexpr int L_UA = 67584;
constexpr int L_SL = 67584;
constexpr int L_UZ = 103424;
constexpr int L_PAR = 137216;
constexpr int L_KL = 0, L_VL = 52224;
constexpr int UP = 264;
constexpr int P_CW = 0, P_CB = 1024, P_BRG = 1280, P_BIG = 1536, P_SP = 1792, P_SD = 2048, P_BGLU = 2304;
static_assert(L_PAR + 2560 * 4 <= L_MISC && L_UA + 67 * UP * 2 <= L_UZ && L_UZ + 64 * UP * 2 <= L_PAR && L_VL + 128 * 400 <= L_UZ, "mixer LDS map");

template <int NT, bool SMP>
__device__ __forceinline__ void stage_uab(const Params& p, int l, int b, int c, LAS unsigned char* lds) {
    int tid_ = threadIdx.x; asm volatile("" : "+v"(tid_));
    const int tid = tid_;
    const bf16_t* ua = WSP(const bf16_t, WS_UA); const bf16_t* ub = WSP(const bf16_t, WS_UB);
    const size_t seq0 = SMP ? (size_t)MP + b * SS : (size_t)b * SEQ;
    const int ts0 = SMP ? 0 : c * 64;
    constexpr int NR = NT * 16 + 3, NIA = (NR * 32 + NTHR - 1) / NTHR, NIB = (NT * 16 * 32 + NTHR - 1) / NTHR;
    u32x4 va[NIA], vb[NIB];
#pragma unroll
    for (int i = 0; i < NIA; ++i) { const int idx = tid + i * NTHR, r = idx >> 5, ck = idx & 31, ts = ts0 - 3 + r;
        va[i] = (u32x4){0u, 0u, 0u, 0u};
        if (idx < NR * 32) {
            if (ts >= 0) va[i] = *(const u32x4*)(ua + (seq0 + ts) * 256 + 8 * ck);
            else if (SMP) { const float* h = WSP(const float, WS_SMALL) + SM_CCONV + ((size_t)(l * SB + b) * 3 + (3 + ts)) * 256 + 8 * ck;
                const f32x4 x = *(const f32x4*)h, y = *(const f32x4*)(h + 4);
                va[i] = (u32x4){cvt_pk_bf16(x[0], x[1]), cvt_pk_bf16(x[2], x[3]), cvt_pk_bf16(y[0], y[1]), cvt_pk_bf16(y[2], y[3])}; }
        } }
#pragma unroll
    for (int i = 0; i < NIB; ++i) { const int idx = tid + i * NTHR, t = idx >> 5, ck = idx & 31;
        vb[i] = (u32x4){0u, 0u, 0u, 0u};
        if (idx < NT * 16 * 32) vb[i] = *(const u32x4*)(ub + (seq0 + ts0 + t) * 256 + 8 * ck); }
#pragma unroll
    for (int i = 0; i < NIA; ++i) { const int idx = tid + i * NTHR, r = idx >> 5, ck = idx & 31;
        if (idx < NR * 32) *(LAS u32x4*)(lds + L_UA + r * (UP * 2) + ck * 16) = va[i]; }
#pragma unroll
    for (int i = 0; i < NIB; ++i) { const int idx = tid + i * NTHR, t = idx >> 5, ck = idx & 31;
        if (idx < NT * 16 * 32) *(LAS u32x4*)(lds + L_UZ + t * (UP * 2) + ck * 16) = vb[i]; }
}

template <int NV>
__device__ __forceinline__ void conv_lds(float (&xc)[NV], const LAS bf16_t* uaL, const LAS float* par, int tl, int ch) {
#pragma unroll
    for (int e = 0; e < NV; e += 4) { const f32x4 cb = *(const LAS f32x4*)(par + P_CB + ch + e); xc[e] = cb[0]; xc[e + 1] = cb[1]; xc[e + 2] = cb[2]; xc[e + 3] = cb[3]; }
#pragma unroll
    for (int j = 0; j < 4; ++j) {
        float w[NV];
#pragma unroll
        for (int e = 0; e < NV; e += 4) { const f32x4 cw = *(const LAS f32x4*)(par + P_CW + j * 256 + ch + e); w[e] = cw[0]; w[e + 1] = cw[1]; w[e + 2] = cw[2]; w[e + 3] = cw[3]; }
        const LAS bf16_t* src = uaL + (tl + j) * UP + ch;
        if constexpr (NV == 8) { const bf16x8 v = *(const LAS bf16x8*)src;
#pragma unroll
            for (int e = 0; e < 8; ++e) xc[e] += bf2f(v[e]) * w[e];
        } else { const bf16x4 v = *(const LAS bf16x4*)src;
#pragma unroll
            for (int e = 0; e < 4; ++e) xc[e] += bf2f(v[e]) * w[e]; }
    }
}

template <int NT, bool SMP>
__device__ __forceinline__ void lru_item(const Params& p, int l, int b, int c, int pass, LAS unsigned char* lds, float& hfold, int cprev) {
    constexpr int HT = NT >= 2 ? 2 : 1, NH = NT / HT, TS = HT * 16 + 1, NPF = HT * 16 * 128 / NTHR;
    LAS float* aL = (LAS float*)(lds + L_AL); LAS float* bL = (LAS float*)(lds + L_BL);
    const LAS bf16_t* uaL = (const LAS bf16_t*)(lds + L_UA); const LAS float* par = (const LAS float*)(lds + L_PAR);
    int tid_ = threadIdx.x; asm volatile("" : "+v"(tid_));
    const int tid = tid_, wid = __builtin_amdgcn_readfirstlane(tid >> 6), lane = tid & 63, l15 = lane & 15, g = lane >> 4, h = wid >> 1, nh = wid & 1;
    const bf16_t* ga = WSP(const bf16_t, WS_GA); bf16_t* mix = WSP(bf16_t, WS_MIX);
    const size_t row0 = SMP ? (size_t)MP + b * SS : (size_t)b * SEQ + c * 64;
    const bf16_t* gwt = WSP(const bf16_t, WS_GATE) + (size_t)l * 2 * 4 * 4096;
    bf16x8 xr[2][2], xi[2][2];
#pragma unroll
    for (int nt2 = 0; nt2 < 2; ++nt2)
#pragma unroll
        for (int ks = 0; ks < 2; ++ks) { const int n = 32 * nh + 16 * nt2 + l15;
            xr[nt2][ks] = *(const bf16x8*)(gwt + ((size_t)(0 * 4 + h) * 64 + n) * 64 + 32 * ks + 8 * g);
            xi[nt2][ks] = *(const bf16x8*)(gwt + ((size_t)(1 * 4 + h) * 64 + n) * 64 + 32 * ks + 8 * g); }
    float fA[16], fB[16], hsm = 0.f;
#pragma unroll
    for (int i = 0; i < 16; ++i) { fA[i] = 1.f; fB[i] = 0.f; }
    if (tid < 256) {
        if (SMP) hsm = WSP(const float, WS_SMALL)[SM_SLRU + (size_t)(l * SB + b) * 256 + tid];
        else if (pass == 1) {
            const float* sA = WSP(const float, WS_SUMA) + (size_t)b * 64 * 256 + tid; const float* sB = WSP(const float, WS_SUMB) + (size_t)b * 64 * 256 + tid;
#pragma unroll
            for (int i = 0; i < 16; ++i) { const int cc = cprev + i < 63 ? cprev + i : 63; fA[i] = sA[cc * 256]; fB[i] = sB[cc * 256]; }
        }
    }
    {
        const int cgp = tid & 31, t0 = NT * (tid >> 5);
        float w[4][8], xc[NT][8];
#pragma unroll
        for (int j = 0; j < 4; ++j)
#pragma unroll
            for (int e = 0; e < 8; e += 4) { const f32x4 cw = *(const LAS f32x4*)(par + P_CW + j * 256 + 8 * cgp + e); w[j][e] = cw[0]; w[j][e + 1] = cw[1]; w[j][e + 2] = cw[2]; w[j][e + 3] = cw[3]; }
#pragma unroll
        for (int e = 0; e < 8; e += 4) { const f32x4 cb = *(const LAS f32x4*)(par + P_CB + 8 * cgp + e);
#pragma unroll
            for (int tk = 0; tk < NT; ++tk) { xc[tk][e] = cb[0]; xc[tk][e + 1] = cb[1]; xc[tk][e + 2] = cb[2]; xc[tk][e + 3] = cb[3]; } }
#pragma unroll
        for (int i = 0; i < NT + 3; ++i) { const bf16x8 v = *(const LAS bf16x8*)(uaL + (t0 + i) * UP + 8 * cgp);
#pragma unroll
            for (int tk = 0; tk < NT; ++tk) { const int j = i - tk; if (j >= 0 && j < 4) {
#pragma unroll
                for (int e = 0; e < 8; ++e) xc[tk][e] += bf2f(v[e]) * w[j][e]; } } }
        __syncthreads();
#pragma unroll
        for (int tk = 0; tk < NT; ++tk) { u32x4 o; o.x = cvt_pk_bf16(xc[tk][0], xc[tk][1]); o.y = cvt_pk_bf16(xc[tk][2], xc[tk][3]); o.z = cvt_pk_bf16(xc[tk][4], xc[tk][5]); o.w = cvt_pk_bf16(xc[tk][6], xc[tk][7]);
            *(LAS u32x4*)((LAS unsigned char*)(lds + L_UA) + ((t0 + tk) * UP + 8 * cgp) * 2) = o; }
        __syncthreads();
    }
    float hrun = 0.f, prun = 1.f;
    if (tid < 256) {
        if (SMP) hrun = hsm;
        else if (pass == 1) {
            float hf = hfold;
#pragma unroll
            for (int i = 0; i < 16; ++i) if (cprev + i < c) hf = fA[i] * hf + fB[i];
            hfold = hf; hrun = hf;
        }
    }
#pragma unroll 1
    for (int half = 0; half < NH; ++half) {
        unsigned gp[NPF];
        if (pass == 1) {
#pragma unroll
            for (int k = 0; k < NPF; ++k) { const int idx = tid + k * NTHR, t = idx >> 7, ch = 2 * (idx & 127); gp[k] = *(const unsigned*)(ga + (row0 + half * HT * 16 + t) * 256 + ch); }
        }
        f32x4 ar[2][HT], ai_[2][HT];
#pragma unroll
        for (int a = 0; a < 2; ++a)
#pragma unroll
            for (int t = 0; t < HT; ++t) { ar[a][t] = (f32x4){0.f, 0.f, 0.f, 0.f}; ai_[a][t] = (f32x4){0.f, 0.f, 0.f, 0.f}; }
#pragma unroll
        for (int tt = 0; tt < HT; ++tt) {
            const int tl = (half * HT + tt) * 16 + l15;
#pragma unroll
            for (int ks = 0; ks < 2; ++ks) {
                const bf16x8 y = *(const LAS bf16x8*)(uaL + tl * UP + 64 * h + 32 * ks + 8 * g);
#pragma unroll
                for (int nt2 = 0; nt2 < 2; ++nt2) { ar[nt2][tt] = mma16(xr[nt2][ks], y, ar[nt2][tt]); ai_[nt2][tt] = mma16(xi[nt2][ks], y, ai_[nt2][tt]); }
            }
        }
#pragma unroll
        for (int nt2 = 0; nt2 < 2; ++nt2)
#pragma unroll
            for (int tt = 0; tt < HT; ++tt) {
                const int tl = (half * HT + tt) * 16 + l15, ch0 = 64 * h + 32 * nh + 16 * nt2 + 4 * g;
                const bf16x4 xv = *(const LAS bf16x4*)(uaL + tl * UP + ch0);
                const f32x4 br4 = *(const LAS f32x4*)(par + P_BRG + ch0), bi4 = *(const LAS f32x4*)(par + P_BIG + ch0), sp4 = *(const LAS f32x4*)(par + P_SP + ch0);
#pragma unroll
                for (int j = 0; j < 4; ++j) { const int ch = ch0 + j;
                    const float r = sigmoidf_(ar[nt2][tt][j] + br4[j]), ig = sigmoidf_(ai_[nt2][tt][j] + bi4[j]);
                    const float la = -8.0f * r * sp4[j], a = __expf(la), x2 = 2.0f * la;
                    const float ser = -x2 * (1.0f + x2 * (0.5f + x2 * (0.16666667f + x2 * (0.041666668f + x2 * 0.008333334f))));
                    const float mult = __builtin_amdgcn_sqrtf(x2 > -0.25f ? ser : 1.0f - a * a);
                    aL[ch * TS + tt * 16 + l15] = a; bL[ch * TS + tt * 16 + l15] = mult * ig * bf2f(xv[j]); }
            }
        __syncthreads();
        if (tid < 256) {
#pragma unroll 8
            for (int t = 0; t < HT * 16; ++t) { const float a = aL[tid * TS + t]; hrun = a * hrun + bL[tid * TS + t]; prun *= a; bL[tid * TS + t] = hrun; }
        }
        __syncthreads();
        if (pass == 1) {
#pragma unroll
            for (int k = 0; k < NPF; ++k) { const int idx = tid + k * NTHR, t = idx >> 7, ch = 2 * (idx & 127); const size_t row = row0 + half * HT * 16 + t;
                const float h0 = bL[ch * TS + t], h1 = bL[(ch + 1) * TS + t];
                const float g0 = __uint_as_float(gp[k] << 16), g1 = __uint_as_float(gp[k] & 0xffff0000u);
                *(unsigned*)(mix + row * DM + ch) = cvt_pk_bf16(h0 * gelu_tanh(g0), h1 * gelu_tanh(g1)); }
        }
        __syncthreads();
    }
    if (tid < 256) {
        if (!SMP && pass == 0) { WSP(float, WS_SUMA)[((size_t)b * 64 + c) * 256 + tid] = prun; WSP(float, WS_SUMB)[((size_t)b * 64 + c) * 256 + tid] = hrun; }
        if (pass == 1) { if (SMP) p.out[O_LRUS + (size_t)(l * SB + b) * 256 + tid] = hrun; else if (c == 63) p.out[O_LRUP + (size_t)(l * NB + b) * 256 + tid] = hrun; }
    }
}

template <int NT, bool SMP>
__device__ __forceinline__ void s5_item(const Params& p, int l, int b, int c, int pass, LAS unsigned char* lds, int cprev) {
    const bool fin = SMP || pass == 1;
    int tid_ = threadIdx.x; asm volatile("" : "+v"(tid_));
    const int tid = tid_, wid = __builtin_amdgcn_readfirstlane(tid >> 6), lane = tid & 63, l15 = lane & 15, g = lane >> 4;
    LAS float* buL = (LAS float*)(lds + L_BU + wid * 8448);
    LAS bf16_t* sL = (LAS bf16_t*)(lds + L_SL + wid * 4352);
    LAS bf16_t* uz = (LAS bf16_t*)(lds + L_UZ);
    const LAS float* par = (const LAS float*)(lds + L_PAR);
    bf16_t* mix = WSP(bf16_t, WS_MIX);
    const size_t row0 = SMP ? (size_t)MP + b * SS : (size_t)b * SEQ + c * 64;
    const float* abar = WSP(const float, WS_ABAR); const bf16_t* bbm = WSP(const bf16_t, WS_BBM); const bf16_t* cmt = WSP(const bf16_t, WS_CMT);
    const bf16x8 z8 = {0, 0, 0, 0, 0, 0, 0, 0};
#pragma unroll 1
    for (int gi = 0; gi < 2; ++gi) {
        const int grp = 2 * wid + gi, lg = l * 16 + grp;
        const f32x4 ab = *(const f32x4*)(abar + ((size_t)lg * 64 + lane) * 4);
        float sre = 0.f, sim = 0.f;
        if (SMP) { sre = WSP(const float, WS_SMALL)[SM_SSRE + ((size_t)(l * SB + b) * 16 + grp) * 64 + lane]; sim = WSP(const float, WS_SMALL)[SM_SSIM + ((size_t)(l * SB + b) * 16 + grp) * 64 + lane]; }
        else if (pass == 1) {
            float* fs = WSP(float, WS_FOLD) + ((size_t)blockIdx.x * 16 + grp) * 128 + lane;
            if (cprev > 0) { sre = fs[0]; sim = fs[64]; }
            const float* S = WSP(const float, WS_SUMS) + ((size_t)b * 64 * 16 + grp) * 128 + lane;
            float re[16], im[16];
#pragma unroll
            for (int i = 0; i < 16; ++i) { const int cc = cprev + i < 63 ? cprev + i : 63; re[i] = S[(size_t)cc * 2048]; im[i] = S[(size_t)cc * 2048 + 64]; }
#pragma unroll
            for (int i = 0; i < 16; ++i) if (cprev + i < c) { const float nre = ab[2] * sre - ab[3] * sim + re[i], nim = ab[2] * sim + ab[3] * sre + im[i]; sre = nre; sim = nim; }
            fs[0] = sre; fs[64] = sim;
        }
        bf16x8 ybb[8], ycm[4];
#pragma unroll
        for (int pt = 0; pt < 8; ++pt) ybb[pt] = g < 2 ? *(const bf16x8*)(bbm + ((size_t)lg * 128 + 16 * pt + l15) * 16 + 8 * g) : z8;
#pragma unroll
        for (int ks = 0; ks < 4; ++ks) ycm[ks] = *(const bf16x8*)(cmt + ((size_t)lg * 16 + l15) * 128 + 32 * ks + 8 * g);
        const float dd = par[P_SD + 16 * grp + l15];
#pragma unroll 1
        for (int tt = 0; tt < NT; ++tt) {
            const bf16x8 x = g < 2 ? *(const LAS bf16x8*)(uz + (tt * 16 + l15) * UP + 16 * grp + 8 * g) : z8;
#pragma unroll
            for (int pt = 0; pt < 8; ++pt) { const f32x4 a = mma16(x, ybb[pt], (f32x4){0.f, 0.f, 0.f, 0.f});
#pragma unroll
                for (int j = 0; j < 4; ++j) buL[(4 * g + j) * 132 + 16 * pt + l15] = a[j]; }
            LDS_WAIT();
#pragma unroll 8
            for (int t = 0; t < 16; ++t) { const float re = buL[t * 132 + lane], im = buL[t * 132 + 64 + lane];
                const float nre = ab[0] * sre - ab[1] * sim + re, nim = ab[0] * sim + ab[1] * sre + im; sre = nre; sim = nim;
                if (fin) { sL[t * 136 + lane] = f2bf(sre); sL[t * 136 + 64 + lane] = f2bf(sim); } }
            LDS_WAIT();
            if (fin) {
                f32x4 y = {0.f, 0.f, 0.f, 0.f};
#pragma unroll
                for (int ks = 0; ks < 4; ++ks) { const bf16x8 xs = *(const LAS bf16x8*)(sL + l15 * 136 + 32 * ks + 8 * g); y = mma16(xs, ycm[ks], y); }
#pragma unroll
                for (int j = 0; j < 4; ++j) { const int t = tt * 16 + 4 * g + j, ch = 16 * grp + l15;
                    const float u = bf2f((short)uz[t * UP + ch]); uz[t * UP + ch] = f2bf(gelu_tanh(y[j] + dd * u)); }
            }
            LDS_WAIT();
        }
        if (!SMP && pass == 0) { float* S = WSP(float, WS_SUMS) + (((size_t)b * 64 + c) * 16 + grp) * 128; S[lane] = sre; S[64 + lane] = sim; }
        if (pass == 1) {
            if (SMP) { p.out[O_SRES + ((size_t)(l * SB + b) * 16 + grp) * 64 + lane] = sre; p.out[O_SIMS + ((size_t)(l * SB + b) * 16 + grp) * 64 + lane] = sim; }
            else if (c == 63) { p.out[O_SREP + ((size_t)(l * NB + b) * 16 + grp) * 64 + lane] = sre; p.out[O_SIMP + ((size_t)(l * NB + b) * 16 + grp) * 64 + lane] = sim; }
        }
    }
    if (fin) {
        __syncthreads();
        const bf16_t* wgt = WSP(const bf16_t, WS_WGT) + (size_t)l * 65536;
#pragma unroll 1
        for (int nt2 = 0; nt2 < 2; ++nt2) {
            bf16x8 yw[8];
#pragma unroll
            for (int ks = 0; ks < 8; ++ks) yw[ks] = *(const bf16x8*)(wgt + (size_t)(32 * wid + 16 * nt2 + l15) * 256 + 32 * ks + 8 * g);
            const float bg = par[P_BGLU + 32 * wid + 16 * nt2 + l15];
#pragma unroll 1
            for (int tt = 0; tt < NT; ++tt) {
                f32x4 a = {0.f, 0.f, 0.f, 0.f};
#pragma unroll
                for (int ks = 0; ks < 8; ++ks) { const bf16x8 xz = *(const LAS bf16x8*)(uz + (tt * 16 + l15) * UP + 32 * ks + 8 * g); a = mma16(xz, yw[ks], a); }
#pragma unroll
                for (int j = 0; j < 4; ++j) { const int t = tt * 16 + 4 * g + j, n = 32 * wid + 16 * nt2 + l15;
                    const float z = bf2f((short)uz[t * UP + n]); mix[(row0 + t) * DM + 256 + n] = f2bf(z * sigmoidf_(a[j] + bg)); }
            }
        }
    }
    __syncthreads();
}

template <int NQT, bool SMP>
__device__ __forceinline__ void attn_item(const Params& p, int l, int b, int c, LAS unsigned char* lds) {
    int tid_ = threadIdx.x; asm volatile("" : "+v"(tid_));
    const int tid = tid_, wid = __builtin_amdgcn_readfirstlane(tid >> 6), lane = tid & 63, l15 = lane & 15, g = lane >> 4, kvh = wid >> 2;
    const bf16_t* q = WSP(const bf16_t, WS_Q); bf16_t* mix = WSP(bf16_t, WS_MIX);
    const bf16_t* kbase; const bf16_t* vbase; size_t vstride, row0; int nkt;
    if (SMP) { kbase = WSP(const bf16_t, WS_KBS) + (size_t)(l * SB + b) * 144 * 128; vbase = WSP(const bf16_t, WS_VTS) + (size_t)(l * SB + b) * 128 * 144; vstride = 144; nkt = 9; row0 = (size_t)MP + b * SS; }
    else { const int c0 = c >= 2 ? c - 2 : 0; kbase = WSP(const bf16_t, WS_KBP) + ((size_t)b * SEQ + c0 * 64) * 128; vbase = WSP(const bf16_t, WS_VTP) + (size_t)b * 128 * SEQ + c0 * 64;
        vstride = SEQ; nkt = 4 * (c - c0 + 1); row0 = (size_t)b * SEQ + c * 64; }
    bf16x8 yq[NQT][2];
#pragma unroll
    for (int qt = 0; qt < NQT; ++qt)
#pragma unroll
        for (int ks = 0; ks < 2; ++ks) yq[qt][ks] = *(const bf16x8*)(q + (row0 + qt * 16 + l15) * 512 + wid * 64 + 32 * ks + 8 * g);
    {
        const int nkc = nkt * 16 * 16, cpr = nkt * 2, nvc = 128 * cpr;
        u32x4 kv[6], vv[6];
#pragma unroll
        for (int i = 0; i < 6; ++i) { const int idx = tid + i * NTHR; kv[i] = (u32x4){0u, 0u, 0u, 0u};
            if (idx < nkc) kv[i] = *(const u32x4*)(kbase + (size_t)(idx >> 4) * 128 + 8 * (idx & 15)); }
#pragma unroll
        for (int i = 0; i < 6; ++i) { const int idx = tid + i * NTHR, r = idx / cpr, ck = idx - r * cpr; vv[i] = (u32x4){0u, 0u, 0u, 0u};
            if (idx < nvc) vv[i] = *(const u32x4*)(vbase + (size_t)r * vstride + 8 * ck); }
#pragma unroll
        for (int i = 0; i < 6; ++i) { const int idx = tid + i * NTHR; if (idx < nkc) *(LAS u32x4*)(lds + L_KL + (idx >> 4) * 272 + (idx & 15) * 16) = kv[i]; }
#pragma unroll
        for (int i = 0; i < 6; ++i) { const int idx = tid + i * NTHR, r = idx / cpr, ck = idx - r * cpr; if (idx < nvc) *(LAS u32x4*)(lds + L_VL + r * 400 + ck * 16) = vv[i]; }
    }
    __syncthreads();
    const float sink = WSP(const float, WS_SMALL)[SM_SINK + l * 8 + wid];
    const bf16x4 z4 = {0, 0, 0, 0};
    const LAS unsigned char* kL = lds + L_KL + l15 * 272 + (kvh * 64 + 8 * g) * 2;
    const LAS unsigned char* vL = lds + L_VL + (kvh * 64 + l15) * 400 + (4 * g) * 2;
    constexpr int QB = NQT >= 2 ? 2 : 1;
#pragma unroll
    for (int qp = 0; qp < NQT / QB; ++qp) {
        f32x4 s[QB][12];
#pragma unroll
        for (int kt = 0; kt < 12; ++kt) {
#pragma unroll
            for (int qb = 0; qb < QB; ++qb) s[qb][kt] = (f32x4){0.f, 0.f, 0.f, 0.f};
            if (kt < nkt) {
#pragma unroll
                for (int ks = 0; ks < 2; ++ks) { const bf16x8 x = *(const LAS bf16x8*)(kL + kt * 16 * 272 + ks * 64);
#pragma unroll
                    for (int qb = 0; qb < QB; ++qb) s[qb][kt] = mma16(x, yq[qp * QB + qb][ks], s[qb][kt]); } } }
        float inv[QB];
#pragma unroll
        for (int qb = 0; qb < QB; ++qb) {
            float mx = sink;
#pragma unroll
            for (int kt = 0; kt < 12; ++kt) if (kt < nkt) mx = fmaxf(fmaxf(mx, fmaxf(s[qb][kt][0], s[qb][kt][1])), fmaxf(s[qb][kt][2], s[qb][kt][3]));
            mx = fmaxf(mx, __shfl_xor(mx, 16)); mx = fmaxf(mx, __shfl_xor(mx, 32));
            float sum = 0.f;
#pragma unroll
            for (int kt = 0; kt < 12; ++kt) if (kt < nkt) {
#pragma unroll
                for (int j = 0; j < 4; ++j) { const float e = __expf(s[qb][kt][j] - mx); s[qb][kt][j] = e; sum += e; } }
            sum += __shfl_xor(sum, 16); sum += __shfl_xor(sum, 32); sum += __expf(sink - mx);
            inv[qb] = 1.0f / sum;
        }
        f32x4 o[QB][4];
#pragma unroll
        for (int qb = 0; qb < QB; ++qb)
#pragma unroll
            for (int dt = 0; dt < 4; ++dt) o[qb][dt] = (f32x4){0.f, 0.f, 0.f, 0.f};
#pragma unroll
        for (int kk = 0; kk < 6; ++kk) if (2 * kk < nkt) {
            bf16x8 y[QB];
#pragma unroll
            for (int qb = 0; qb < QB; ++qb) { u32x4 w; w.x = cvt_pk_bf16(s[qb][2 * kk][0], s[qb][2 * kk][1]); w.y = cvt_pk_bf16(s[qb][2 * kk][2], s[qb][2 * kk][3]);
                w.z = cvt_pk_bf16(s[qb][2 * kk + 1][0], s[qb][2 * kk + 1][1]); w.w = cvt_pk_bf16(s[qb][2 * kk + 1][2], s[qb][2 * kk + 1][3]);
                y[qb] = __builtin_bit_cast(bf16x8, w); }
            const bool hi = 2 * kk + 1 < nkt;
#pragma unroll
            for (int dt = 0; dt < 4; ++dt) { const LAS unsigned char* vr = vL + dt * 16 * 400 + kk * 64;
                const bf16x4 lo = *(const LAS bf16x4*)vr; const bf16x4 h4 = hi ? *(const LAS bf16x4*)(vr + 32) : z4;
                const bf16x8 x = __builtin_shufflevector(lo, h4, 0, 1, 2, 3, 4, 5, 6, 7);
#pragma unroll
                for (int qb = 0; qb < QB; ++qb) o[qb][dt] = mma16(x, y[qb], o[qb][dt]); }
        }
#pragma unroll
        for (int qb = 0; qb < QB; ++qb) { const size_t qrow = row0 + (qp * QB + qb) * 16 + l15;
#pragma unroll
            for (int dt = 0; dt < 4; ++dt) { u32x2 w; w.x = cvt_pk_bf16(o[qb][dt][0] * inv[qb], o[qb][dt][1] * inv[qb]); w.y = cvt_pk_bf16(o[qb][dt][2] * inv[qb], o[qb][dt][3] * inv[qb]);
                *(u32x2*)(mix + qrow * DM + 512 + wid * 64 + 16 * dt + 4 * g) = w; } }
    }
    __syncthreads();
}

__device__ __forceinline__ void mixer_pass(const Params& p, int l, int pass, LAS unsigned char* lds) {
    {
        LAS float* par = (LAS float*)(lds + L_PAR); const float* sm = WSP(const float, WS_SMALL);
        for (int i = threadIdx.x; i < 2560; i += NTHR) { float v;
            if (i < 1024) v = sm[SM_CW + l * 1024 + i];
            else { const int k = (i - 1024) >> 8, j = i & 255;
                v = k == 0 ? sm[SM_CB + l * 256 + j] : k == 1 ? sm[SM_BRG + l * 256 + j] : k == 2 ? sm[SM_BIG + l * 256 + j] : k == 3 ? WSP(const float, WS_SP)[l * 256 + j] : k == 4 ? sm[SM_SD + l * 256 + j] : sm[SM_BGLU + l * 256 + j]; }
            par[i] = v; }
        __syncthreads();
    }
    float hfold = 0.f; int cprev = 0;
#pragma unroll 1
    for (int it = blockIdx.x; it < NB * 64 + SB; it += gridDim.x) {
        if (it < NB * 64) { const int b = it & 15, c = it >> 4;
            stage_uab<4, false>(p, l, b, c, lds); __syncthreads();
#ifndef DUPM
#define DUPM 0
#endif
            { float hf0 = hfold; for (int r2 = 0; r2 < ((DUPM & 1) ? 2 : 1); ++r2) { hfold = hf0; lru_item<4, false>(p, l, b, c, pass, lds, hfold, cprev); } }
            for (int r2 = 0; r2 < ((DUPM & 2) ? 2 : 1); ++r2) { if ((DUPM & 2) && r2 == 1) { stage_uab<4, false>(p, l, b, c, lds); __syncthreads(); } s5_item<4, false>(p, l, b, c, pass, lds, r2 == 1 && pass == 1 ? c : cprev); }
            cprev = c;
            for (int r2 = 0; r2 < ((DUPM & 4) ? 2 : 1); ++r2) if (pass == 0) attn_item<4, false>(p, l, b, c, lds);
        } else { const int b = it - NB * 64;
            if (pass == 0) { attn_item<1, true>(p, l, b, 0, lds);
                float hf = 0.f; stage_uab<1, true>(p, l, b, 0, lds); __syncthreads(); lru_item<1, true>(p, l, b, 0, 1, lds, hf, 0); s5_item<1, true>(p, l, b, 0, 1, lds, 0); }
        }
    }
}

__device__ __forceinline__ void final_norm(const Params& p) {
    int tid_ = threadIdx.x; asm volatile("" : "+v"(tid_));
    const int lane = tid_ & 63, gw = blockIdx.x * NWAVES + (tid_ >> 6), NGW = gridDim.x * NWAVES;
    const float* ss = WSP(const float, WS_SS); const f32x4* nf = (const f32x4*)(WSP(const float, WS_SMALL) + SM_NF) + 2 * lane;
    const bf16_t* xb = WSP(const bf16_t, WS_XB);
#pragma unroll 1
    for (int row = gw; row < MREAL; row += NGW) {
        const float rs = ss_rs(ss, row); f32x4* o = (f32x4*)(p.out + O_Y + (size_t)row * DM) + 2 * lane; const u32x4* xi = (const u32x4*)(xb + (size_t)row * DM) + lane;
#pragma unroll
        for (int j = 0; j < 2; ++j) { const u32x4 w = xi[64 * j]; const f32x4 g0 = nf[128 * j], g1 = nf[128 * j + 1];
            o[128 * j] = (f32x4){__uint_as_float(w.x << 16) * rs * g0[0], __uint_as_float(w.x & 0xffff0000u) * rs * g0[1], __uint_as_float(w.y << 16) * rs * g0[2], __uint_as_float(w.y & 0xffff0000u) * rs * g0[3]};
            o[128 * j + 1] = (f32x4){__uint_as_float(w.z << 16) * rs * g1[0], __uint_as_float(w.z & 0xffff0000u) * rs * g1[1], __uint_as_float(w.w << 16) * rs * g1[2], __uint_as_float(w.w & 0xffff0000u) * rs * g1[3]}; }
    }
}

template <int KIND>
__device__ __forceinline__ void slab_gemm(const Params& p, LAS unsigned char* lds, const bf16_t* A, const bf16_t* Bt, int K, int N,
                                          const float* xin_s, float* xout_s, bf16_t* xb, float* ss, bf16_t* hid) {
    int tid_ = threadIdx.x; asm volatile("" : "+v"(tid_));
    const int tid = tid_, wid = __builtin_amdgcn_readfirstlane(tid >> 6), lane = tid & 63, l15 = lane & 15, g = lane >> 4;
    const int npieces = 8 * (N / 64), kw = K / 8;
#pragma unroll 1
    for (int pc = blockIdx.x; pc < npieces; pc += gridDim.x) {
        const int rt = pc & 7, cg = pc >> 3;
        f32x4 acc[4];
#pragma unroll
        for (int ct = 0; ct < 4; ++ct) acc[ct] = (f32x4){0.f, 0.f, 0.f, 0.f};
        const bf16_t* ap = A + (size_t)(MP + rt * 16 + l15) * K + wid * kw + 8 * g;
        const bf16_t* bp = Bt + (size_t)(cg * 64 + l15) * K + wid * kw + 8 * g;
#pragma unroll 4
        for (int ks = 0; ks < kw / 32; ++ks) {
            const bf16x8 x = *(const bf16x8*)(ap + 32 * ks);
#pragma unroll
            for (int ct = 0; ct < 4; ++ct) { const bf16x8 y = *(const bf16x8*)(bp + (size_t)ct * 16 * K + 32 * ks); acc[ct] = mma16(x, y, acc[ct]); }
        }
        LAS f32x4* part = (LAS f32x4*)lds;
#pragma unroll
        for (int ct = 0; ct < 4; ++ct) part[(wid * 4 + ct) * 64 + lane] = acc[ct];
        __syncthreads();
        const int r = 2 * wid + (lane >> 5), c = 2 * (lane & 31), gg = r >> 2, j = r & 3;
        float v0 = 0.f, v1 = 0.f;
#pragma unroll
        for (int w = 0; w < 8; ++w) { const LAS float* pp = (const LAS float*)lds + ((w * 4 + (c >> 4)) * 64 + 16 * gg + (c & 15)) * 4 + j; v0 += pp[0]; v1 += pp[4]; }
        const int row = MP + rt * 16 + r, col = cg * 64 + c;
        if (KIND == 0) {
            const size_t off = (size_t)(rt * 16 + r) * DM + col;
            float r0, r1;
            if (xin_s) { r0 = xin_s[off]; r1 = xin_s[off + 1]; }
            else { const unsigned xw = *(const unsigned*)(xb + (size_t)row * DM + col); r0 = __uint_as_float(xw << 16); r1 = __uint_as_float(xw & 0xffff0000u); }
            const float o0 = r0 + v0, o1 = r1 + v1;
            if (xout_s) { xout_s[off] = o0; xout_s[off + 1] = o1; }
            if (xb) *(unsigned*)(xb + (size_t)row * DM + col) = cvt_pk_bf16(o0, o1);
            float sq = o0 * o0 + o1 * o1;
#pragma unroll
            for (int o = 1; o < 32; o <<= 1) sq += __shfl_xor(sq, o);
            if ((lane & 31) == 0) ss[(size_t)row * 16 + cg] = sq;
        } else if (KIND == 1) {
            const float rs = ss_rs(ss, row), a0 = fmaxf(v0 * rs, 0.f), a1 = fmaxf(v1 * rs, 0.f);
            *(unsigned*)(hid + (size_t)row * DFF + col) = cvt_pk_bf16(a0 * a0, a1 * a1);
        } else {
            const int l = (int)(size_t)xin_s;
            const int sb = rt, st = r, pos = SEQ + st;
            const float rs = ss_rs(ss, row), a0 = v0 * rs, a1 = v1 * rs;
            if (col < 768) {
                bf16_t* dst = col < 256 ? WSP(bf16_t, WS_UA) : (col < 512 ? WSP(bf16_t, WS_GA) : WSP(bf16_t, WS_UB)); const int cc = col & 255;
                *(unsigned*)(dst + (size_t)row * 256 + cc) = cvt_pk_bf16(a0, a1);
                if (col < 256 && st >= SS - 3) { float* o = p.out + O_CONVS + ((size_t)(l * SB + sb) * 3 + (st - (SS - 3))) * 256 + cc; o[0] = a0; o[1] = a1; }
            } else if (col < 1408) {
                const int jp = (col & 63) >> 1; const float* rp = WSP(const float, WS_ROPE) + ((size_t)pos * 32 + jp) * 2;
                const float cs = rp[0], sn = rp[1], o0 = a0 * cs - a1 * sn, o1 = a1 * cs + a0 * sn;
                if (col < 1280) *(unsigned*)(WSP(bf16_t, WS_Q) + (size_t)row * 512 + (col - 768)) = cvt_pk_bf16(o0 * 0.125f, o1 * 0.125f);
                else { const int kc = col - 1280, kvh = kc >> 6;
                    *(unsigned*)(WSP(bf16_t, WS_KBS) + ((size_t)(l * SB + sb) * 144 + 128 + st) * 128 + kc) = cvt_pk_bf16(o0, o1);
                    float* o = p.out + O_KS + (((size_t)(l * SB + sb) * SS + st) * 2 + kvh) * 64 + jp; o[0] = o0; o[32] = o1; }
            } else {
                const int vc = col - 1408, kvh = vc >> 6, d = vc & 63;
                bf16_t* vt = WSP(bf16_t, WS_VTS) + ((size_t)(l * SB + sb) * 128 + vc) * 144 + 128 + st; vt[0] = f2bf(a0); vt[144] = f2bf(a1);
                float* o = p.out + O_VS + (((size_t)(l * SB + sb) * SS + st) * 2 + kvh) * 64 + d; o[0] = a0; o[1] = a1;
            }
        }
        __syncthreads();
    }
}

#define XB_TMO      128
#define XB_XCNT(j)  (256  + 64 * (j))
#define XB_XSUB(j)  (1280 + 64 * (j))
#define XB_XGEN(j)  (2304 + 64 * (j))
#define XB_TOP      3328
#define XB_TOPGEN   3392
#define XCD_BAR_WORDS 3456
#define XB_SPIN_CAP (1u << 18)

__device__ __forceinline__ unsigned xb_ld(unsigned* p)              { return __hip_atomic_load(p, __ATOMIC_RELAXED, __HIP_MEMORY_SCOPE_AGENT); }
__device__ __forceinline__ unsigned xb_add(unsigned* p, unsigned v) { return __hip_atomic_fetch_add(p, v, __ATOMIC_RELAXED, __HIP_MEMORY_SCOPE_AGENT); }
__device__ __forceinline__ unsigned xb_xcc_id() { return (unsigned)__builtin_amdgcn_s_getreg((3 << 11) | 20) & 0xFu; }
#define XB_SPIN(cond, bar) do { unsigned _sp = 0; while (cond) { __builtin_amdgcn_s_sleep(1); \
    if ((++_sp & 255u) == 0u) { if (xb_ld(&(bar)[XB_TMO])) break; if (_sp > XB_SPIN_CAP) { atomicAdd(&(bar)[XB_TMO], 1u); break; } } } } while (0)

struct XcdBarrier {
    unsigned* bar; unsigned x;
    volatile LAS unsigned* st;
};

__device__ __forceinline__ XcdBarrier xcd_barrier_post(unsigned* bar, volatile LAS unsigned* st) {
    XcdBarrier b; b.bar = bar; b.x = xb_xcc_id(); b.st = st;
    if (threadIdx.x == 0) (void)xb_add(&bar[XB_XCNT(b.x)], 1u);
    return b;
}
__device__ __forceinline__ void xcd_barrier_complete(unsigned* bar, unsigned x, unsigned& nloc, unsigned& nx) {
    const unsigned G = gridDim.x * gridDim.y * gridDim.z;
    unsigned sum, cnt, mine, sp = 0u;
    for (;;) {
        sum = 0u; cnt = 0u; mine = 0u;
#pragma unroll
        for (unsigned j = 0; j < 16; ++j) { const unsigned c = xb_ld(&bar[XB_XCNT(j)]); sum += c; cnt += (c > 0u) ? 1u : 0u; mine = (j == x) ? c : mine; }
        if (sum == G) break;
        __builtin_amdgcn_s_sleep(1);
        if ((++sp & 255u) == 0u) { if (xb_ld(&bar[XB_TMO])) break; if (sp > XB_SPIN_CAP) { atomicAdd(&bar[XB_TMO], 1u); break; } }
    }
    nloc = mine > 0u ? mine : 1u; nx = cnt > 0u ? cnt : 1u;
}

__device__ __forceinline__ void xcd_barrier(const XcdBarrier& b) {
    asm volatile("s_waitcnt vmcnt(0)" ::: "memory");
    __syncthreads();
    if (threadIdx.x == 0) {
        unsigned* bar = b.bar;
        __builtin_amdgcn_s_waitcnt(0);
        unsigned nloc = b.st[0], nx = b.st[1];
        if (nloc == 0u) { xcd_barrier_complete(bar, b.x, nloc, nx); b.st[0] = nloc; b.st[1] = nx; }
        const unsigned old = xb_add(&bar[XB_XSUB(b.x)], 1u);
        const unsigned gen = old / nloc;
        if (old + 1u == (gen + 1u) * nloc) {
            __builtin_amdgcn_fence(__ATOMIC_RELEASE, "agent");
            asm volatile("s_waitcnt vmcnt(0)" ::: "memory");
            const unsigned og = xb_add(&bar[XB_TOP], 1u);
            const unsigned tg = og / nx;
            if (og + 1u == (tg + 1u) * nx) xb_add(&bar[XB_TOPGEN], 1u);
            else XB_SPIN(xb_ld(&bar[XB_TOPGEN]) == tg, bar);
            __builtin_amdgcn_fence(__ATOMIC_ACQUIRE, "agent");
            xb_add(&bar[XB_XGEN(b.x)], 1u);
            asm volatile("s_waitcnt vmcnt(0)" ::: "memory");
        } else {
            XB_SPIN(xb_ld(&bar[XB_XGEN(b.x)]) == gen, bar);
            __builtin_amdgcn_fence(__ATOMIC_ACQUIRE, "agent");
            asm volatile("s_waitcnt vmcnt(0)" ::: "memory");
        }
    }
    __syncthreads();
}

#define GSYNC_CG() do { asm volatile("s_waitcnt vmcnt(0) lgkmcnt(0)" ::: "memory"); grid.sync(); __builtin_amdgcn_fence(__ATOMIC_ACQUIRE, "agent"); asm volatile("s_waitcnt vmcnt(0)" ::: "memory"); } while (0)
#define GSYNC() do { XcdBarrier xb_; xb_.bar = (unsigned*)(p.ws + WS_CTL); xb_.x = xb_xcc_id(); xb_.st = (volatile LAS unsigned*)(lds + L_MISC); xcd_barrier(xb_); } while (0)
__global__ void __launch_bounds__(NTHR, 2) fwd_kernel(Params p) {
    extern __shared__ __attribute__((aligned(16))) unsigned char lds_raw[];
    LAS unsigned char* lds = (LAS unsigned char*)lds_raw;
    cg::grid_group grid = cg::this_grid();
    const int G = gridDim.x, cid = blockIdx.x;
    volatile LAS unsigned* misc = (volatile LAS unsigned*)(lds + L_MISC);
    if (threadIdx.x < 2) misc[threadIdx.x] = 0u;
    if (threadIdx.x < 33) ((LAS unsigned long long*)(lds + L_PTAB))[threadIdx.x] = ((const unsigned long long*)__builtin_amdgcn_kernarg_segment_ptr())[threadIdx.x];
    __syncthreads();
    (void)xcd_barrier_post((unsigned*)(p.ws + WS_CTL), misc);
#ifndef EN
#define EN 0xff
#endif
#ifndef DUP
#define DUP 0
#endif
#define REPS(bit) (((DUP) & (bit)) && l == 0 ? 2 : 1)
#ifndef DUPP
#define DUPP 1
#endif
#pragma unroll 1
    for (int rp = 0; rp < DUPP; ++rp) { if (EN & 1) prologue(p, lds); __syncthreads(); }
#ifdef NOCG
    if (gridDim.y == 0x7fffffffu)
#endif
    GSYNC_CG();
#ifdef NOCG
    GSYNC();
#endif
#pragma unroll 1
    for (int l = 0; l < DEPTH; ++l) {
        if (EN & 2) {
            pg8::Gemm gm{WSP(const bf16_t, WS_XB), WSP(const bf16_t, WS_WIN) + (size_t)l * DIN * DM, MP, DIN, DM}; pg8::StaticOrder S; S.init(MP, DIN, G, cid);
            EpiIn E{p.ws, p.out, l};
            pg8::gemm_phase<EpiIn, pg8::StaticOrder, true, true>(lds, gm, S, E);
            slab_gemm<2>(p, lds, WSP(const bf16_t, WS_XB), WSP(const bf16_t, WS_WIN) + (size_t)l * DIN * DM, DM, DIN, (const float*)(size_t)l, nullptr, nullptr, WSP(float, WS_SS), nullptr);
        }
        GSYNC();
        if (EN & 4) mixer_pass(p, l, 0, lds);
        GSYNC();
        if (EN & 8) mixer_pass(p, l, 1, lds);
        GSYNC();
        if (EN & 16) {
            pg8::Gemm gm{WSP(const bf16_t, WS_MIX), WSP(const bf16_t, WS_WOUT) + (size_t)l * DM * DM, MP, DM, DM}; pg8::StaticOrder S; S.init(MP, DM, G, cid);
            EpiResB E{WSP(bf16_t, WS_XB), WSP(float, WS_SS)};
            pg8::gemm_phase<EpiResB, pg8::StaticOrder, true, true>(lds, gm, S, E);
            slab_gemm<0>(p, lds, WSP(const bf16_t, WS_MIX), WSP(const bf16_t, WS_WOUT) + (size_t)l * DM * DM, DM, DM, nullptr, nullptr, WSP(bf16_t, WS_XB), WSP(float, WS_SS), nullptr);
        }
        GSYNC();
        if (EN & 32) {
            pg8::Gemm gm{WSP(const bf16_t, WS_XB), WSP(const bf16_t, WS_WUP) + (size_t)l * DFF * DM, MP, DFF, DM}; pg8::StaticOrder S; S.init(MP, DFF, G, cid);
            EpiUp E{WSP(const float, WS_SS), WSP(bf16_t, WS_HID)};
            pg8::gemm_phase<EpiUp, pg8::StaticOrder, true, true>(lds, gm, S, E);
            slab_gemm<1>(p, lds, WSP(const bf16_t, WS_XB), WSP(const bf16_t, WS_WUP) + (size_t)l * DFF * DM, DM, DFF, nullptr, nullptr, nullptr, WSP(float, WS_SS), WSP(bf16_t, WS_HID));
        }
        GSYNC();
        if (EN & 64) {
            pg8::Gemm gm{WSP(const bf16_t, WS_HID), WSP(const bf16_t, WS_WDN) + (size_t)l * DM * DFF, MP, DM, DFF}; pg8::StaticOrder S; S.init(MP, DM, G, cid);
            EpiResB E{WSP(bf16_t, WS_XB), WSP(float, WS_SS)};
            pg8::gemm_phase<EpiResB, pg8::StaticOrder, true, true>(lds, gm, S, E);
            slab_gemm<0>(p, lds, WSP(const bf16_t, WS_HID), WSP(const bf16_t, WS_WDN) + (size_t)l * DM * DFF, DFF, DM, nullptr, nullptr, WSP(bf16_t, WS_XB), WSP(float, WS_SS), nullptr);
        }
        GSYNC();
    }
    if (EN & 128) final_norm(p);
}

extern "C" void kernel_launch(void* const* d_in, const int* in_sizes, int n_in, void* d_out, int out_size, void* d_ws, size_t ws_size, hipStream_t stream) {
    static int grid = 0;
    if (grid == 0) {
        if (n_in != 33 || (size_t)out_size != O_END || ws_size < WS_TOTAL) { fprintf(stderr, "kernel_launch: unexpected shapes (n_in %d out %d ws %zu)\n", n_in, out_size, ws_size); grid = -1; return; }
        int dev = 0, cus = 0, per = 0;
        if (hipGetDevice(&dev) != hipSuccess || hipDeviceGetAttribute(&cus, hipDeviceAttributeMultiprocessorCount, dev) != hipSuccess) { grid = -1; return; }
        if (hipFuncSetAttribute((const void*)fwd_kernel, hipFuncAttributeMaxDynamicSharedMemorySize, LDS_BYTES) != hipSuccess) { fprintf(stderr, "kernel_launch: hipFuncSetAttribute failed\n"); grid = -1; return; }
        if (hipOccupancyMaxActiveBlocksPerMultiprocessor(&per, (const void*)fwd_kernel, NTHR, LDS_BYTES) != hipSuccess || per < 1) { fprintf(stderr, "kernel_launch: occupancy query says %d\n", per); per = 1; }
        (void)hipGetLastError();
        grid = cus;
    }
    if (grid < 0) return;
    if (hipMemsetAsync((char*)d_ws + WS_CTL, 0, CTL_BYTES, stream) != hipSuccess) { fprintf(stderr, "kernel_launch: hipMemsetAsync failed\n"); return; }
    Params p{};
    for (int i = 0; i < 33; ++i) p.in[i] = (const float*)d_in[i];
    p.out = (float*)d_out; p.ws = (unsigned char*)d_ws;
    void* args[] = {&p};
    hipError_t e = hipLaunchCooperativeKernel((const void*)fwd_kernel, dim3(grid), dim3(NTHR), args, LDS_BYTES, stream);
    if (e != hipSuccess) fprintf(stderr, "kernel_launch: cooperative launch failed: %s (grid %d)\n", hipGetErrorString(e), grid);
}
```

```cpp
#define NOCG 1
#include <hip/hip_runtime.h>
#include <hip/hip_cooperative_groups.h>
#include <cstdio>
#include <cstdint>
namespace cg = cooperative_groups;
namespace pg8 {
#define PG8_LAS __attribute__((address_space(3)))
typedef unsigned short bf16_t;
typedef short bf16x8 __attribute__((ext_vector_type(8)));
typedef float f32x4 __attribute__((ext_vector_type(4)));
typedef unsigned u32x4 __attribute__((ext_vector_type(4)));
constexpr int BM = 256, BK = 64, HALF = 128, HTB = HALF * BK * 2  , STAGE_BYTES = 8 * HTB, NXCD = 8, WGM = 8;

__host__ __device__ __forceinline__ int lds_byte(int r, int c) { const int st = (r >> 4) * 2 + (c >> 5), rr = r & 15, cc = c & 31, ob = rr * 64 + cc * 2; return st * 1024 + (ob ^ (((ob >> 9) & 1) << 5)); }
__host__ __device__ __forceinline__ void stage_rc(int b, int& R, int& C) { const int st = b / 1024, sb = b % 1024, swz = sb ^ (((sb >> 9) & 1) << 5); R = (st >> 1) * 16 + swz / 64; C = (st & 1) * 32 + (swz % 64) / 2; }
__host__ __device__ __forceinline__ int perm32(int rho) { const int n = rho >> 4, i = rho & 15; return 8 * (i >> 2) + 4 * n + (i & 3); }

struct Unit { int pm, pn; };
struct Gemm { const bf16_t* A; const bf16_t* Bt; int M, N, K; };

struct StaticOrder {
    int nM, nN, nwg, G, c;
    __host__ __device__ void init(int M, int N, int G_, int c_) { nM = M / BM; nN = N / BM; nwg = nM * nN; G = G_; c = c_; }
    __host__ __device__ bool next(int i, Unit& u) const {
        const long L = (long)i * G + c; if (L >= nwg) return false;
        int wgid = (int)L; { const int q = nwg / NXCD, r = nwg % NXCD, xcd = wgid % NXCD, off = wgid / NXCD; wgid = (xcd < r ? xcd * (q + 1) : r * (q + 1) + (xcd - r) * q) + off; }
        const int nig = WGM * nN, gid = wgid / nig, fm = gid * WGM, gsz = (nM - fm) < WGM ? (nM - fm) : WGM;
        u.pm = fm + ((wgid % nig) % gsz); u.pn = (wgid % nig) / gsz; return true;
    }
    __device__ __forceinline__ void a_ready(const Unit&) const {}
    __device__ __forceinline__ void done(const Unit&) const {}
};

__device__ __forceinline__ unsigned cvt_pk_bf16(float lo, float hi) { unsigned r; asm volatile("v_cvt_pk_bf16_f32 %0, %1, %2" : "=v"(r) : "v"(lo), "v"(hi)); return r; }
typedef float f32x2 __attribute__((ext_vector_type(2)));
template <class Epi, class Sched, bool ALIGN_EPI = false, bool SP2 = false>
__device__ __forceinline__ void gemm_phase(PG8_LAS unsigned char* lds, const Gemm g, const Sched& S, const Epi& E) {
    int tid_ = threadIdx.x; asm volatile("" : "+v"(tid_));
    const int tid = tid_, wid = __builtin_amdgcn_readfirstlane(tid >> 6), lane = tid & 63, wr = wid >> 2, wc = wid & 3, fr = lane & 15, fq = lane >> 4;
    const int K = g.K, nt = K / BK;
    unsigned voffA[2], voffB[2];
#pragma unroll
    for (int i = 0; i < 2; ++i) { int R, C; stage_rc(tid * 16 + i * 8192, R, C); const int Rb = Epi::PERM ? ((R & ~31) + perm32(R & 31)) : R;
        voffA[i] = (unsigned)(R * K + C) * 2u; voffB[i] = (unsigned)(Rb * K + C) * 2u; }
    const size_t kstep = (size_t)(BK * 2);
    const size_t hstep = (size_t)HALF * K * 2;
    const size_t tstep = 2 * hstep;
    const unsigned ldsw = (unsigned)wid * 1024u;
    const int aoff = lds_byte(wr * 64 + fr, fq * 8), boff = lds_byte(wc * 32 + fr, fq * 8);
#define PG8_SA(b, h) (((b) * 2 + (h)) * HTB)
#define PG8_SB(b, h) ((4 + (b) * 2 + (h)) * HTB)
#define PG8_STAGE(bufoff, gbase, voff) do { _Pragma("unroll") for (int _i = 0; _i < 2; ++_i) \
        __builtin_amdgcn_global_load_lds((const unsigned*)((const char*)(gbase) + (voff)[_i]), (PG8_LAS unsigned*)(lds + (bufoff) + ldsw + _i * 8192), 16, 0, 0); } while (0)
#define PG8_LDA(dst, b, h) do { _Pragma("unroll") for (int m = 0; m < 4; ++m) _Pragma("unroll") for (int k = 0; k < 2; ++k) dst[m][k] = *(const PG8_LAS bf16x8*)(lds + PG8_SA(b, h) + aoff + m * 2048 + k * 1024); } while (0)
#define PG8_LDB(dst, b, h) do { _Pragma("unroll") for (int n = 0; n < 2; ++n) _Pragma("unroll") for (int k = 0; k < 2; ++k) dst[n][k] = *(const PG8_LAS bf16x8*)(lds + PG8_SB(b, h) + boff + n * 2048 + k * 1024); } while (0)
#define PG8_MMA(ai, bj, At, Bt) do { __builtin_amdgcn_s_setprio(1); _Pragma("unroll") for (int m = 0; m < 4; ++m) _Pragma("unroll") for (int n = 0; n < 2; ++n) _Pragma("unroll") for (int k = 0; k < 2; ++k) \
        acc[ai][bj][m][n] = __builtin_amdgcn_mfma_f32_16x16x32_bf16(Bt[n][k], At[m][k], acc[ai][bj][m][n], 0, 0, 0); __builtin_amdgcn_s_setprio(0); } while (0)
#define PG8_WAIT_V(n) asm volatile("s_waitcnt vmcnt(" #n ")" ::: "memory")
#define PG8_WAIT_L(n) asm volatile("s_waitcnt lgkmcnt(" #n ")" ::: "memory")
#define PG8_BAR __builtin_amdgcn_s_barrier()
#define PG8_SCHED __builtin_amdgcn_sched_barrier(0)
    Unit cur, nxt; int ui = 0;
    if (!S.next(0, cur)) return;
    f32x4 acc[2][2][4][2];
#pragma unroll
    for (int a = 0; a < 2; ++a)
#pragma unroll
        for (int b = 0; b < 2; ++b)
#pragma unroll
            for (int m = 0; m < 4; ++m)
#pragma unroll
                for (int n = 0; n < 2; ++n) acc[a][b][m][n] = (f32x4){0.f, 0.f, 0.f, 0.f};
    bf16x8 At[4][2], B0[2][2], B1[2][2];
    const char* cA = (const char*)g.A + (size_t)cur.pm * tstep; const char* cB = (const char*)g.Bt + (size_t)cur.pn * tstep;
    S.a_ready(cur);
    if constexpr (SP2) {
        PG8_STAGE(PG8_SB(0, 0), cB, voffB); PG8_STAGE(PG8_SB(0, 1), cB + hstep, voffB); PG8_STAGE(PG8_SA(0, 0), cA, voffA); PG8_STAGE(PG8_SA(0, 1), cA + hstep, voffA);
        if (wr == 1) PG8_BAR;
        PG8_WAIT_V(2); PG8_BAR;
        PG8_STAGE(PG8_SB(1, 0), cB + kstep, voffB); PG8_STAGE(PG8_SA(1, 0), cA + kstep, voffA); PG8_STAGE(PG8_SB(1, 1), cB + hstep + kstep, voffB);
        PG8_WAIT_V(6); PG8_BAR;
    } else {
        PG8_STAGE(PG8_SB(0, 0), cB, voffB); PG8_STAGE(PG8_SA(0, 0), cA, voffA); PG8_STAGE(PG8_SB(0, 1), cB + hstep, voffB); PG8_STAGE(PG8_SA(0, 1), cA + hstep, voffA);
        if (wr == 1) PG8_BAR;
        PG8_WAIT_V(4); PG8_BAR;
        PG8_STAGE(PG8_SB(1, 0), cB + kstep, voffB); PG8_STAGE(PG8_SA(1, 0), cA + kstep, voffA); PG8_STAGE(PG8_SB(1, 1), cB + hstep + kstep, voffB);
        PG8_WAIT_V(6); PG8_BAR;
    }
    for (;;) {
        const bool has_next = S.next(ui + 1, nxt);
        const char* nA = has_next ? (const char*)g.A + (size_t)nxt.pm * tstep : cA; const char* nB = has_next ? (const char*)g.Bt + (size_t)nxt.pn * tstep : cB;
        for (int t = 0; t < nt; t += 2) {
            const bool last = (t == nt - 2);
            const char* a1 = cA + (size_t)(t + 1) * kstep;
            const char* a2 = last ? nA : cA + (size_t)(t + 2) * kstep; const char* b2 = last ? nB : cB + (size_t)(t + 2) * kstep;
            const char* a3 = a2 + kstep; const char* b3 = b2 + kstep;
            if (last && has_next) S.a_ready(nxt);
            if constexpr (SP2) {
            PG8_LDB(B0, 0, 0); PG8_LDB(B1, 0, 1); PG8_SCHED; PG8_LDA(At, 0, 0); PG8_STAGE(PG8_SA(1, 1), a1 + hstep, voffA);
            PG8_WAIT_V(8); PG8_WAIT_L(0); PG8_BAR; PG8_MMA(0, 0, At, B0); PG8_MMA(0, 1, At, B1); PG8_BAR; PG8_SCHED;
            PG8_LDA(At, 0, 1); PG8_STAGE(PG8_SB(0, 0), b2, voffB); PG8_STAGE(PG8_SB(0, 1), b2 + hstep, voffB); PG8_STAGE(PG8_SA(0, 0), a2, voffA);
            PG8_WAIT_V(8); PG8_WAIT_L(0); PG8_BAR; PG8_MMA(1, 0, At, B0); PG8_MMA(1, 1, At, B1); PG8_BAR; PG8_SCHED;
            PG8_LDB(B0, 1, 0); PG8_LDB(B1, 1, 1); PG8_SCHED; PG8_LDA(At, 1, 0); PG8_STAGE(PG8_SA(0, 1), a2 + hstep, voffA);
            PG8_WAIT_V(8); PG8_WAIT_L(0); PG8_BAR; PG8_MMA(0, 0, At, B0); PG8_MMA(0, 1, At, B1); PG8_BAR; PG8_SCHED;
            PG8_LDA(At, 1, 1); PG8_STAGE(PG8_SB(1, 0), b3, voffB); PG8_STAGE(PG8_SB(1, 1), b3 + hstep, voffB); PG8_STAGE(PG8_SA(1, 0), a3, voffA);
            PG8_WAIT_V(8); PG8_WAIT_L(0); PG8_BAR; PG8_MMA(1, 0, At, B0); PG8_MMA(1, 1, At, B1); PG8_BAR; PG8_SCHED;
            } else {
            PG8_LDB(B0, 0, 0); PG8_SCHED; PG8_LDA(At, 0, 0); PG8_STAGE(PG8_SA(1, 1), a1 + hstep, voffA);
            PG8_WAIT_L(8); PG8_BAR; PG8_WAIT_L(0); PG8_MMA(0, 0, At, B0); PG8_BAR; PG8_SCHED;
            PG8_LDB(B1, 0, 1); PG8_STAGE(PG8_SB(0, 0), b2, voffB);
            PG8_BAR; PG8_WAIT_L(0); PG8_MMA(0, 1, At, B1); PG8_BAR;
            PG8_LDA(At, 0, 1); PG8_STAGE(PG8_SA(0, 0), a2, voffA);
            PG8_BAR; PG8_WAIT_L(0); PG8_MMA(1, 0, At, B0); PG8_BAR; PG8_SCHED;
            PG8_STAGE(PG8_SB(0, 1), b2 + hstep, voffB);
            PG8_WAIT_V(6); PG8_BAR; PG8_MMA(1, 1, At, B1); PG8_BAR;
            PG8_LDB(B0, 1, 0); PG8_SCHED; PG8_LDA(At, 1, 0); PG8_STAGE(PG8_SA(0, 1), a2 + hstep, voffA);
            PG8_WAIT_L(8); PG8_BAR; PG8_WAIT_L(0); PG8_MMA(0, 0, At, B0); PG8_BAR; PG8_SCHED;
            PG8_LDB(B1, 1, 1); PG8_STAGE(PG8_SB(1, 0), b3, voffB);
            PG8_BAR; PG8_WAIT_L(0); PG8_MMA(0, 1, At, B1); PG8_BAR;
            PG8_LDA(At, 1, 1); PG8_STAGE(PG8_SA(1, 0), a3, voffA);
            PG8_BAR; PG8_WAIT_L(0); PG8_MMA(1, 0, At, B0); PG8_BAR; PG8_SCHED;
            PG8_STAGE(PG8_SB(1, 1), b3 + hstep, voffB);
            PG8_WAIT_V(6); PG8_BAR; PG8_MMA(1, 1, At, B1); PG8_BAR;
            }
        }
        if constexpr (ALIGN_EPI) { if (wr == 0) PG8_BAR; }
        if constexpr (!Epi::AFTER_DRAIN) { E(acc, cur, wr, wc, fr, fq); S.done(cur); }
        if (!has_next) break;
#pragma unroll
        for (int a = 0; a < 2; ++a)
#pragma unroll
            for (int b = 0; b < 2; ++b)
#pragma unroll
                for (int m = 0; m < 4; ++m)
#pragma unroll
                    for (int n = 0; n < 2; ++n) acc[a][b][m][n] = (f32x4){0.f, 0.f, 0.f, 0.f};
        cur = nxt; cA = nA; cB = nB; ++ui;
        if constexpr (ALIGN_EPI) { if (wr == 1) PG8_BAR; }
    }
    PG8_WAIT_V(0);
    if constexpr (!ALIGN_EPI) { if (wr == 0) PG8_BAR; }
    PG8_BAR;
    if constexpr (Epi::AFTER_DRAIN) { E.fused(acc, cur, wr, wc, fr, fq, lds, wid, lane); S.done(cur); }
#undef PG8_SA
#undef PG8_SB
#undef PG8_STAGE
#undef PG8_LDA
#undef PG8_LDB
#undef PG8_MMA
#undef PG8_WAIT_V
#undef PG8_WAIT_L
#undef PG8_BAR
#undef PG8_SCHED
}
}

using pg8::bf16_t; using pg8::bf16x8; using pg8::f32x4; using pg8::u32x4; using pg8::cvt_pk_bf16;
typedef short bf16x4 __attribute__((ext_vector_type(4)));
typedef unsigned u32x2 __attribute__((ext_vector_type(2)));
#define LAS __attribute__((address_space(3)))

constexpr int DM = 1024, NB = 16, SEQ = 4096, DEPTH = 2, SB = 8, SS = 16;
constexpr int MP = NB * SEQ, MS = SB * SS, MREAL = MP + MS, MPAD = 65792;
constexpr int DIN = 1536, DFF = 4096, NPOS = SEQ + SS;
constexpr float EPS = 1e-6f;
constexpr int NTHR = 512, NWAVES = 8;
constexpr int LDS_BYTES = 147456 + 512, L_MISC = 147456, L_PTAB = 147456 + 64;

constexpr size_t O_Y = 0;
constexpr size_t O_CONVP = (size_t)MREAL * DM;
constexpr size_t O_LRUP = O_CONVP + (size_t)DEPTH * NB * 3 * 256;
constexpr size_t O_SREP = O_LRUP + (size_t)DEPTH * NB * 256;
constexpr size_t O_SIMP = O_SREP + (size_t)DEPTH * NB * 1024;
constexpr size_t O_KP = O_SIMP + (size_t)DEPTH * NB * 1024;
constexpr size_t O_VP = O_KP + (size_t)DEPTH * NB * 128 * 128;
constexpr size_t O_CONVS = O_VP + (size_t)DEPTH * NB * 128 * 128;
constexpr size_t O_LRUS = O_CONVS + (size_t)DEPTH * SB * 3 * 256;
constexpr size_t O_SRES = O_LRUS + (size_t)DEPTH * SB * 256;
constexpr size_t O_SIMS = O_SRES + (size_t)DEPTH * SB * 1024;
constexpr size_t O_KS = O_SIMS + (size_t)DEPTH * SB * 1024;
constexpr size_t O_VS = O_KS + (size_t)DEPTH * SB * 16 * 128;
constexpr size_t O_END = O_VS + (size_t)DEPTH * SB * 16 * 128;
static_assert(O_END == 68501504, "d_out map");

constexpr size_t WS_WIN = 0;
constexpr size_t WS_WOUT = WS_WIN + (size_t)DEPTH * DIN * DM * 2;
constexpr size_t WS_WUP = WS_WOUT + (size_t)DEPTH * DM * DM * 2;
constexpr size_t WS_WDN = WS_WUP + (size_t)DEPTH * DFF * DM * 2;
constexpr size_t WS_ROPE = WS_WDN + (size_t)DEPTH * DM * DFF * 2;
constexpr size_t WS_GATE = WS_ROPE + (size_t)NPOS * 32 * 8;
constexpr size_t WS_SP = WS_GATE + (size_t)DEPTH * 2 * 4 * 64 * 64 * 2;
constexpr size_t WS_ABAR = WS_SP + (size_t)DEPTH * 256 * 4;
constexpr size_t WS_BBM = WS_ABAR + (size_t)DEPTH * 16 * 64 * 4 * 4;
constexpr size_t WS_CMT = WS_BBM + (size_t)DEPTH * 16 * 128 * 16 * 2;
constexpr size_t WS_WGT = WS_CMT + (size_t)DEPTH * 16 * 16 * 128 * 2;
constexpr size_t WS_KBS = WS_WGT + (size_t)DEPTH * 256 * 256 * 2;
constexpr size_t WS_VTS = WS_KBS + (size_t)DEPTH * SB * 144 * 128 * 2;
constexpr size_t WS_SMALL = WS_VTS + (size_t)DEPTH * SB * 128 * 144 * 2;
constexpr int SM_CCONV = 0, SM_SLRU = SM_CCONV + DEPTH * SB * 3 * 256, SM_SSRE = SM_SLRU + DEPTH * SB * 256, SM_SSIM = SM_SSRE + DEPTH * SB * 1024, SM_CW = SM_SSIM + DEPTH * SB * 1024,
              SM_CB = SM_CW + DEPTH * 4 * 256, SM_BRG = SM_CB + DEPTH * 256, SM_BIG = SM_BRG + DEPTH * 256, SM_SD = SM_BIG + DEPTH * 256, SM_BGLU = SM_SD + DEPTH * 256,
              SM_SINK = SM_BGLU + DEPTH * 256, SM_NF = SM_SINK + 64, SM_END = SM_NF + DM;
constexpr size_t WS_SS = WS_SMALL + (size_t)((SM_END * 4 + 255) / 256) * 256;
constexpr size_t WS_SUMA = WS_SS + (size_t)MPAD * 16 * 4;
constexpr size_t WS_SUMB = WS_SUMA + (size_t)NB * 64 * 256 * 4;
constexpr size_t WS_SUMS = WS_SUMB + (size_t)NB * 64 * 256 * 4;
constexpr size_t WS_FOLD = WS_SUMS + (size_t)NB * 64 * 16 * 128 * 4;
constexpr size_t WS_XB = WS_FOLD + (size_t)320 * 16 * 128 * 4;
constexpr size_t WS_XRES = WS_XB + (size_t)MPAD * DM * 2;
constexpr size_t WS_BIG = WS_XRES + (size_t)MPAD * DM * 4;
constexpr size_t WS_UA = WS_BIG;
constexpr size_t WS_GA = WS_UA + (size_t)MPAD * 256 * 2;
constexpr size_t WS_UB = WS_GA + (size_t)MPAD * 256 * 2;
constexpr size_t WS_Q = WS_UB + (size_t)MPAD * 256 * 2;
constexpr size_t WS_KBP = WS_Q + (size_t)MPAD * 512 * 2;
constexpr size_t WS_VTP = WS_KBP + (size_t)MP * 128 * 2;
constexpr size_t WS_MIX = WS_VTP + (size_t)NB * 128 * SEQ * 2;
constexpr size_t WS_MIXEND = WS_MIX + (size_t)MPAD * DM * 2;
constexpr size_t WS_HID = WS_BIG;
constexpr size_t WS_END = WS_BIG + (size_t)MPAD * DFF * 2;
constexpr size_t WS_CTL = WS_END, CTL_BYTES = 16384;
constexpr size_t WS_TOTAL = WS_CTL + CTL_BYTES;
static_assert(WS_MIXEND <= WS_END && WS_TOTAL <= (size_t)1 << 30, "d_ws map");

struct Params { const float* in[33]; float* out; unsigned char* ws; };
enum { I_XP = 0, I_XS, I_CCONV, I_SLRU, I_SSRE, I_SSIM, I_CK, I_CV, I_N1, I_WIN, I_CW, I_CB, I_WRG, I_BRG, I_WIG, I_BIG_, I_LAM,
       I_ARE, I_AIM, I_BRE, I_BIM, I_CRE, I_CIM, I_SD, I_LDT, I_WGLU, I_BGLU, I_SINK, I_WOUT, I_N2, I_WUP, I_WDN, I_NF };

__device__ __forceinline__ float bf2f(short v) { return __uint_as_float(((unsigned)(unsigned short)v) << 16); }
__device__ __forceinline__ bf16_t f2bf(float v) { return (bf16_t)(cvt_pk_bf16(v, 0.f) & 0xffffu); }
__device__ __forceinline__ float sigmoidf_(float x) { return __builtin_amdgcn_rcpf(1.f + __expf(-x)); }
__device__ __forceinline__ float gelu_tanh(float x) { const float u = 1.5957691216f * (x + 0.044715f * x * x * x); return x * __builtin_amdgcn_rcpf(1.f + __expf(-u)); }
__device__ __forceinline__ f32x4 mma16(bf16x8 x, bf16x8 y, f32x4 acc) { return __builtin_amdgcn_mfma_f32_16x16x32_bf16(x, y, acc, 0, 0, 0); }
__device__ __forceinline__ float wave_sum(float v) {
#pragma unroll
    for (int o = 1; o < 64; o <<= 1) v += __shfl_xor(v, o);
    return v;
}
__device__ __forceinline__ void store8(bf16_t* dst, const float (&v)[8]) {
    u32x4 w; w.x = cvt_pk_bf16(v[0], v[1]); w.y = cvt_pk_bf16(v[2], v[3]); w.z = cvt_pk_bf16(v[4], v[5]); w.w = cvt_pk_bf16(v[6], v[7]);
    *(u32x4*)dst = w;
}
__device__ __forceinline__ float ss_rs(const float* ss, int row) {
    const f32x4* s4 = (const f32x4*)(ss + (size_t)row * 16);
    const f32x4 a = s4[0], b = s4[1], c = s4[2], d = s4[3];
    const float tot = (((a[0] + a[1]) + (a[2] + a[3])) + ((b[0] + b[1]) + (b[2] + b[3]))) + (((c[0] + c[1]) + (c[2] + c[3])) + ((d[0] + d[1]) + (d[2] + d[3])));
    return __builtin_amdgcn_rsqf(tot * (1.f / 1024.f) + EPS);
}
__device__ __forceinline__ void rope8(float (&v)[8], const float* rope, int pos, int jp) {
    const f32x4* r = (const f32x4*)(rope + ((size_t)pos * 32 + jp) * 2);
    const f32x4 a = r[0], b = r[1];
    float x1, x2;
    x1 = v[0]; x2 = v[1]; v[0] = x1 * a[0] - x2 * a[1]; v[1] = x2 * a[0] + x1 * a[1];
    x1 = v[2]; x2 = v[3]; v[2] = x1 * a[2] - x2 * a[3]; v[3] = x2 * a[2] + x1 * a[3];
    x1 = v[4]; x2 = v[5]; v[4] = x1 * b[0] - x2 * b[1]; v[5] = x2 * b[0] + x1 * b[1];
    x1 = v[6]; x2 = v[7]; v[6] = x1 * b[2] - x2 * b[3]; v[7] = x2 * b[2] + x1 * b[3];
}

__device__ __forceinline__ void rs8(float (&rsv)[2][4], const float* ss, int rowbase, int fq) {
    f32x4 part[2][4];
#pragma unroll
    for (int ai = 0; ai < 2; ++ai)
#pragma unroll
        for (int m = 0; m < 4; ++m) { const int row = rowbase + ai * 128 + m * 16;
            part[ai][m] = (f32x4){0.f, 0.f, 0.f, 0.f};
            if (row < MREAL) part[ai][m] = *(const f32x4*)(ss + (size_t)row * 16 + 4 * fq); }
#pragma unroll
    for (int ai = 0; ai < 2; ++ai)
#pragma unroll
        for (int m = 0; m < 4; ++m) { float t = (part[ai][m][0] + part[ai][m][1]) + (part[ai][m][2] + part[ai][m][3]);
            t += __shfl_xor(t, 16); t += __shfl_xor(t, 32);
            rsv[ai][m] = __builtin_amdgcn_rsqf(t * (1.f / 1024.f) + EPS); }
}

struct EpiIn {
    static constexpr bool PERM = true, AFTER_DRAIN = false;
    unsigned char* ws; float* out; int l;
    __device__ __forceinline__ void operator()(const f32x4 (&acc)[2][2][4][2], const pg8::Unit& u, int wr, int wc, int fr, int fq) const {
        asm volatile("" : "+v"(fr), "+v"(fq)); asm volatile("" : "+s"(wr), "+s"(wc));
        const int pn = u.pn;
        const float* ss = (const float*)(ws + WS_SS); const float* rope = (const float*)(ws + WS_ROPE);
        bf16_t* ua = (bf16_t*)(ws + WS_UA); bf16_t* ga = (bf16_t*)(ws + WS_GA); bf16_t* ub = (bf16_t*)(ws + WS_UB); bf16_t* q = (bf16_t*)(ws + WS_Q);
        bf16_t* kbp = (bf16_t*)(ws + WS_KBP); bf16_t* vtp = (bf16_t*)(ws + WS_VTP);
        bf16_t* kbs = (bf16_t*)(ws + WS_KBS) + (size_t)l * SB * 144 * 128; bf16_t* vts = (bf16_t*)(ws + WS_VTS) + (size_t)l * SB * 128 * 144;
        float* conv_p = out + O_CONVP + (size_t)l * NB * 3 * 256; float* conv_s = out + O_CONVS + (size_t)l * SB * 3 * 256;
        float* k_p = out + O_KP + (size_t)l * NB * 128 * 128; float* v_p = out + O_VP + (size_t)l * NB * 128 * 128;
        float* k_s = out + O_KS + (size_t)l * SB * 16 * 128; float* v_s = out + O_VS + (size_t)l * SB * 16 * 128;
        float rsv[2][4]; rs8(rsv, ss, u.pm * 256 + wr * 64 + fr, fq);
#pragma unroll
        for (int ai = 0; ai < 2; ++ai)
#pragma unroll
            for (int m = 0; m < 4; ++m) {
                const int row = u.pm * 256 + ai * 128 + wr * 64 + m * 16 + fr;
                if (row < MREAL) {
                    const float rs = rsv[ai][m];
                    const bool smp = row >= MP;
                    const int b = smp ? (row - MP) >> 4 : row >> 12, t = smp ? (row - MP) & 15 : row & 4095, pos = smp ? SEQ + t : t;
#pragma unroll
                    for (int bj = 0; bj < 2; ++bj) {
                        const int c0 = bj * 128 + wc * 32 + fq * 8;
                        float v[8];
#pragma unroll
                        for (int e = 0; e < 4; ++e) { v[e] = acc[ai][bj][m][0][e] * rs; v[4 + e] = acc[ai][bj][m][1][e] * rs; }
                        if (pn <= 2) {
                            bf16_t* dst = (pn == 0 ? ua : (pn == 1 ? ga : ub)) + (size_t)row * 256 + c0;
                            store8(dst, v);
                            if (pn == 0) {
                                const int tt = smp ? t - (SS - 3) : t - (SEQ - 3);
                                if (tt >= 0) { float* o = (smp ? conv_s : conv_p) + (size_t)(b * 3 + tt) * 256 + c0;
                                    *(f32x4*)o = (f32x4){v[0], v[1], v[2], v[3]}; *(f32x4*)(o + 4) = (f32x4){v[4], v[5], v[6], v[7]}; }
                            }
                        } else if (pn <= 4) {
                            rope8(v, rope, pos, (c0 & 63) >> 1);
#pragma unroll
                            for (int e = 0; e < 8; ++e) v[e] *= 0.125f;
                            store8(q + (size_t)row * 512 + (pn - 3) * 256 + c0, v);
                        } else if (bj == 0) {
                            const int kvh = c0 >> 6, jp = (c0 & 63) >> 1;
                            rope8(v, rope, pos, jp);
                            bf16_t* dst = smp ? kbs + (size_t)(b * 144 + 128 + t) * 128 + c0 : kbp + (size_t)row * 128 + c0;
                            store8(dst, v);
                            const int tt = smp ? t : t - (SEQ - 128);
                            if (tt >= 0) { float* o = (smp ? k_s + ((size_t)(b * SS + tt) * 2 + kvh) * 64 : k_p + ((size_t)(b * 128 + tt) * 2 + kvh) * 64) + jp;
                                *(f32x4*)o = (f32x4){v[0], v[2], v[4], v[6]}; *(f32x4*)(o + 32) = (f32x4){v[1], v[3], v[5], v[7]}; }
                        } else {
                            const int cv = c0 - 128, kvh = cv >> 6, d0 = cv & 63;
                            if (!smp) { bf16_t* dst = vtp + (size_t)(b * 128 + cv) * SEQ + t;
#pragma unroll
                                for (int e = 0; e < 8; ++e) dst[(size_t)e * SEQ] = f2bf(v[e]);
                            } else { bf16_t* dst = vts + (size_t)(b * 128 + cv) * 144 + 128 + t;
#pragma unroll
                                for (int e = 0; e < 8; ++e) dst[e * 144] = f2bf(v[e]); }
                            const int tt = smp ? t : t - (SEQ - 128);
                            if (tt >= 0) { float* o = (smp ? v_s + ((size_t)(b * SS + tt) * 2 + kvh) * 64 : v_p + ((size_t)(b * 128 + tt) * 2 + kvh) * 64) + d0;
                                *(f32x4*)o = (f32x4){v[0], v[1], v[2], v[3]}; *(f32x4*)(o + 4) = (f32x4){v[4], v[5], v[6], v[7]}; }
                        }
                    }
                }
                asm volatile("" ::: "memory");
            }
    }
};

struct EpiRes {
    static constexpr bool PERM = true, AFTER_DRAIN = false;
    const __attribute__((address_space(1))) float *xin_p, *xin_s;
    float *xout_p, *xout_s; bf16_t* xb; float* ss;
    __device__ __forceinline__ void operator()(const f32x4 (&acc)[2][2][4][2], const pg8::Unit& u, int wr, int wc, int fr, int fq) const {
        asm volatile("" : "+v"(fr), "+v"(fq)); asm volatile("" : "+s"(wr), "+s"(wc));
        const int pn = u.pn;
#pragma unroll
        for (int ai = 0; ai < 2; ++ai)
#pragma unroll
            for (int m = 0; m < 4; ++m) {
                const int row = u.pm * 256 + ai * 128 + wr * 64 + m * 16 + fr;
                const bool valid = row < MREAL;
                float sq = 0.f;
                if (valid) {
                    const size_t ro = row < MP ? (size_t)row * DM : (size_t)(row - MP) * DM;
                    const __attribute__((address_space(1))) float* xi = (row < MP ? xin_p : xin_s) + ro; float* xo = (row < MP ? xout_p : xout_s) + ro;
#pragma unroll
                    for (int bj = 0; bj < 2; ++bj) {
                        const int c = pn * 256 + bj * 128 + wc * 32 + fq * 8;
                        const f32x4 a0 = *(const __attribute__((address_space(1))) f32x4*)(xi + c) + acc[ai][bj][m][0], a1 = *(const __attribute__((address_space(1))) f32x4*)(xi + c + 4) + acc[ai][bj][m][1];
                        if (xout_p) { *(f32x4*)(xo + c) = a0; *(f32x4*)(xo + c + 4) = a1; }
                        sq += ((a0[0] * a0[0] + a0[1] * a0[1]) + (a0[2] * a0[2] + a0[3] * a0[3])) + ((a1[0] * a1[0] + a1[1] * a1[1]) + (a1[2] * a1[2] + a1[3] * a1[3]));
                        if (xb) { u32x4 w; w.x = cvt_pk_bf16(a0[0], a0[1]); w.y = cvt_pk_bf16(a0[2], a0[3]); w.z = cvt_pk_bf16(a1[0], a1[1]); w.w = cvt_pk_bf16(a1[2], a1[3]);
                            *(u32x4*)(xb + (size_t)row * DM + c) = w; }
                    }
                }
                sq += __shfl_xor(sq, 16); sq += __shfl_xor(sq, 32);
                if (valid && fq == 0) ss[(size_t)row * 16 + pn * 4 + wc] = sq;
            }
    }
};

struct EpiResB {
    static constexpr bool PERM = true, AFTER_DRAIN = false;
    bf16_t* xb; float* ss;
    __device__ __forceinline__ void operator()(const f32x4 (&acc)[2][2][4][2], const pg8::Unit& u, int wr, int wc, int fr, int fq) const {
        asm volatile("" : "+v"(fr), "+v"(fq)); asm volatile("" : "+s"(wr), "+s"(wc));
        const int pn = u.pn;
#pragma unroll
        for (int ai = 0; ai < 2; ++ai)
#pragma unroll
            for (int m = 0; m < 4; ++m) {
                const int row = u.pm * 256 + ai * 128 + wr * 64 + m * 16 + fr;
                const bool valid = row < MREAL;
                float sq = 0.f;
                if (valid) {
#pragma unroll
                    for (int bj = 0; bj < 2; ++bj) {
                        const int c = pn * 256 + bj * 128 + wc * 32 + fq * 8;
                        u32x4* px = (u32x4*)(xb + (size_t)row * DM + c);
                        const u32x4 xw = *px;
                        const f32x4 x0 = {__uint_as_float(xw.x << 16), __uint_as_float(xw.x & 0xffff0000u), __uint_as_float(xw.y << 16), __uint_as_float(xw.y & 0xffff0000u)};
                        const f32x4 x1 = {__uint_as_float(xw.z << 16), __uint_as_float(xw.z & 0xffff0000u), __uint_as_float(xw.w << 16), __uint_as_float(xw.w & 0xffff0000u)};
                        const f32x4 a0 = x0 + acc[ai][bj][m][0], a1 = x1 + acc[ai][bj][m][1];
                        sq += ((a0[0] * a0[0] + a0[1] * a0[1]) + (a0[2] * a0[2] + a0[3] * a0[3])) + ((a1[0] * a1[0] + a1[1] * a1[1]) + (a1[2] * a1[2] + a1[3] * a1[3]));
                        u32x4 w; w.x = cvt_pk_bf16(a0[0], a0[1]); w.y = cvt_pk_bf16(a0[2], a0[3]); w.z = cvt_pk_bf16(a1[0], a1[1]); w.w = cvt_pk_bf16(a1[2], a1[3]);
                        *px = w;
                    }
                }
                sq += __shfl_xor(sq, 16); sq += __shfl_xor(sq, 32);
                if (valid && fq == 0) ss[(size_t)row * 16 + pn * 4 + wc] = sq;
            }
    }
};

struct EpiUp {
    static constexpr bool PERM = true, AFTER_DRAIN = false;
    const float* ss; bf16_t* hid;
    __device__ __forceinline__ void operator()(const f32x4 (&acc)[2][2][4][2], const pg8::Unit& u, int wr, int wc, int fr, int fq) const {
        asm volatile("" : "+v"(fr), "+v"(fq)); asm volatile("" : "+s"(wr), "+s"(wc));
        float rsv[2][4]; rs8(rsv, ss, u.pm * 256 + wr * 64 + fr, fq);
#pragma unroll
        for (int ai = 0; ai < 2; ++ai)
#pragma unroll
            for (int m = 0; m < 4; ++m) {
                const int row = u.pm * 256 + ai * 128 + wr * 64 + m * 16 + fr;
                if (row < MREAL) {
                    const float rs = rsv[ai][m];
#pragma unroll
                    for (int bj = 0; bj < 2; ++bj) {
                        const int c = u.pn * 256 + bj * 128 + wc * 32 + fq * 8;
                        float v[8];
#pragma unroll
                        for (int e = 0; e < 4; ++e) { float a = fmaxf(acc[ai][bj][m][0][e] * rs, 0.f), b = fmaxf(acc[ai][bj][m][1][e] * rs, 0.f); v[e] = a * a; v[4 + e] = b * b; }
                        store8(hid + (size_t)row * DFF + c, v);
                    }
                }
            }
    }
};

#define WSP(T, off) ((T*)(p.ws + (off)))
#define INP(i) ((const float*)(((const LAS unsigned long long*)(lds + L_PTAB))[i]))
#define LDS_WAIT() asm volatile("s_waitcnt lgkmcnt(0)" ::: "memory")

__device__ __forceinline__ void sincos_d(double x, double& s, double& c) {
    const double TWO_PI = 6.283185307179586476925;
    const double k = rint(x / TWO_PI), r = x - k * TWO_PI, r2 = r * r;
    double ps = 1.0, pc = 1.0;
#pragma unroll
    for (int n = 15; n >= 1; --n) { ps = 1.0 - r2 / ((2.0 * n) * (2.0 * n + 1.0)) * ps; pc = 1.0 - r2 / ((2.0 * n - 1.0) * (2.0 * n)) * pc; }
    s = r * ps; c = pc;
}

template <int MODE>
__device__ __forceinline__ void transpose_item(const float* W, const float* gain, int K, int N, bf16_t* WT, LAS float* scr, int item, int lane) {
    const int nblk = N / 32, kb = item / nblk, nb = item % nblk, k0 = 64 * kb, n0 = 32 * nb;
    float wv[32];
#pragma unroll
    for (int i = 0; i < 32; ++i) wv[i] = W[(size_t)(k0 + 2 * i + (lane >> 5)) * N + n0 + (lane & 31)];
    if (gain) {
#pragma unroll
        for (int i = 0; i < 32; ++i) wv[i] *= gain[k0 + 2 * i + (lane >> 5)];
    }
#pragma unroll
    for (int i = 0; i < 32; ++i) scr[(2 * i + (lane >> 5)) * 33 + (lane & 31)] = wv[i];
    LDS_WAIT();
    const int c = lane & 7;
#pragma unroll
    for (int j = 0; j < 4; ++j) { const int n = (lane >> 3) + 8 * j; const LAS float* s = scr + (8 * c) * 33 + n;
        u32x4 o; o.x = cvt_pk_bf16(s[0 * 33], s[1 * 33]); o.y = cvt_pk_bf16(s[2 * 33], s[3 * 33]); o.z = cvt_pk_bf16(s[4 * 33], s[5 * 33]); o.w = cvt_pk_bf16(s[6 * 33], s[7 * 33]);
        int nn = n0 + n;
        if (MODE == 1 && nn >= 768 && nn < 1408) { const int r = nn - 768, d = r & 63; nn = 768 + (r & ~63) + 2 * (d & 31) + (d >> 5); }
        *(u32x4*)(WT + (size_t)nn * K + k0 + 8 * c) = o; }
    LDS_WAIT();
}

__device__ __forceinline__ void prologue(const Params& p, LAS unsigned char* lds) {
    const int tid = threadIdx.x, lane = tid & 63, wave = tid >> 6;
    const int gw = blockIdx.x * NWAVES + wave, NGW = gridDim.x * NWAVES, gt = blockIdx.x * NTHR + tid, NGT = gridDim.x * NTHR;
    LAS float* scr = (LAS float*)(lds + wave * 16384);
#pragma unroll 1
    for (int ph = 0; ph < 2; ++ph) {
      if (((ph ^ wave) & 1) == 0) {
    constexpr int I_IN = 16 * 48, I_OUT = 16 * 32, I_UP = 16 * 128, I_DN = 64 * 32, I_L = I_IN + I_OUT + I_UP + I_DN;
    for (int it = gw; it < DEPTH * I_L; it += NGW) {
        const int l = it / I_L; int r = it % I_L;
        if (r < I_IN) { transpose_item<1>(INP(I_WIN) + (size_t)l * DM * DIN, INP(I_N1) + l * DM, DM, DIN, WSP(bf16_t, WS_WIN) + (size_t)l * DIN * DM, scr, r, lane); continue; } r -= I_IN;
        if (r < I_OUT) { transpose_item<0>(INP(I_WOUT) + (size_t)l * DM * DM, nullptr, DM, DM, WSP(bf16_t, WS_WOUT) + (size_t)l * DM * DM, scr, r, lane); continue; } r -= I_OUT;
        if (r < I_UP) { transpose_item<0>(INP(I_WUP) + (size_t)l * DM * DFF, INP(I_N2) + l * DM, DM, DFF, WSP(bf16_t, WS_WUP) + (size_t)l * DFF * DM, scr, r, lane); continue; } r -= I_UP;
        transpose_item<0>(INP(I_WDN) + (size_t)l * DFF * DM, nullptr, DFF, DM, WSP(bf16_t, WS_WDN) + (size_t)l * DM * DFF, scr, r, lane);
    }
      } else {
    {
        bf16_t* xb = WSP(bf16_t, WS_XB); float* ss = WSP(float, WS_SS);
        static_assert(MPAD % 4 == 0 && MREAL % 4 == 0 && MP % 4 == 0, "row groups of 4");
#pragma unroll 1
        for (int row0 = gw * 4; row0 < MPAD; row0 += NGW * 4) {
            f32x4 v[4][4];
            if (row0 < MREAL) {
                const float* xbase = row0 < MP ? INP(I_XP) + (size_t)row0 * DM : INP(I_XS) + (size_t)(row0 - MP) * DM;
#pragma unroll
                for (int r = 0; r < 4; ++r)
#pragma unroll
                    for (int j = 0; j < 4; ++j) v[r][j] = ((const f32x4*)(xbase + (size_t)r * DM) + lane)[64 * j];
            } else {
#pragma unroll
                for (int r = 0; r < 4; ++r)
#pragma unroll
                    for (int j = 0; j < 4; ++j) v[r][j] = (f32x4){0.f, 0.f, 0.f, 0.f};
            }
#pragma unroll
            for (int r = 0; r < 4; ++r) {
                float sq = 0.f;
#pragma unroll
                for (int j = 0; j < 4; ++j) sq += (v[r][j][0] * v[r][j][0] + v[r][j][1] * v[r][j][1]) + (v[r][j][2] * v[r][j][2] + v[r][j][3] * v[r][j][3]);
                const float tot = wave_sum(sq);
                unsigned long long* o8 = (unsigned long long*)(xb + (size_t)(row0 + r) * DM) + lane;
#pragma unroll
                for (int j = 0; j < 4; ++j) o8[64 * j] = (unsigned long long)cvt_pk_bf16(v[r][j][0], v[r][j][1]) | ((unsigned long long)cvt_pk_bf16(v[r][j][2], v[r][j][3]) << 32);
                if (lane < 16) ss[(size_t)(row0 + r) * 16 + lane] = lane == 0 ? tot : 0.f;
            }
        }
    }
      }
    }
    { float* sm = WSP(float, WS_SMALL);
#define CPY(I, OFF, N) for (int idx = gt; idx < (N); idx += NGT) sm[(OFF) + idx] = INP(I)[idx];
      CPY(I_CCONV, SM_CCONV, DEPTH * SB * 3 * 256) CPY(I_SLRU, SM_SLRU, DEPTH * SB * 256) CPY(I_SSRE, SM_SSRE, DEPTH * SB * 1024) CPY(I_SSIM, SM_SSIM, DEPTH * SB * 1024)
      CPY(I_CW, SM_CW, DEPTH * 4 * 256) CPY(I_CB, SM_CB, DEPTH * 256) CPY(I_BRG, SM_BRG, DEPTH * 256) CPY(I_BIG_, SM_BIG, DEPTH * 256) CPY(I_SD, SM_SD, DEPTH * 256)
      CPY(I_BGLU, SM_BGLU, DEPTH * 256) CPY(I_SINK, SM_SINK, DEPTH * 8) CPY(I_NF, SM_NF, DM)
#undef CPY
    }
    { float* rope = WSP(float, WS_ROPE);
      for (int idx = gt; idx < NPOS * 32; idx += NGT) { const int pos = idx >> 5, j = idx & 31;
          const float invf = (float)exp(-(double)j * (9.210340371976184 / 32.0)); double s, c; sincos_d((double)pos * (double)invf, s, c);
          rope[2 * idx] = (float)c; rope[2 * idx + 1] = (float)s; } }
    { bf16_t* gate = WSP(bf16_t, WS_GATE);
      for (int idx = gt; idx < DEPTH * 2 * 4 * 64 * 64; idx += NGT) { const int k = idx & 63, n = (idx >> 6) & 63, h = (idx >> 12) & 3, gt_ = (idx >> 14) & 1, l = idx >> 15;
          gate[idx] = f2bf((gt_ ? INP(I_WIG) : INP(I_WRG))[((size_t)(l * 4 + h) * 64 + k) * 64 + n]); } }
    { float* sp = WSP(float, WS_SP);
      for (int idx = gt; idx < DEPTH * 256; idx += NGT) sp[idx] = (float)log1p(exp(-(double)INP(I_LAM)[idx])); }
    { float* abar = WSP(float, WS_ABAR); bf16_t* bbm = WSP(bf16_t, WS_BBM);
      for (int idx = gt; idx < DEPTH * 16 * 64; idx += NGT) { const int lg = idx >> 6, pp = idx & 63;
          const double dt = exp((double)INP(I_LDT)[lg]), lr = (double)INP(I_ARE)[idx], li = (double)INP(I_AIM)[idx], mag = exp(lr * dt);
          double sn, cs; sincos_d(li * dt, sn, cs);
          const double ar = mag * cs, ai = mag * sn, den = lr * lr + li * li, nr = ar - 1.0, fr = (nr * lr + ai * li) / den, fi = (ai * lr - nr * li) / den;
          double xr = ar, xi = ai;
#pragma unroll
          for (int q = 0; q < 6; ++q) { const double t = xr * xr - xi * xi; xi = 2.0 * xr * xi; xr = t; }
          *(f32x4*)(abar + (size_t)idx * 4) = (f32x4){(float)ar, (float)ai, (float)xr, (float)xi};
          for (int c = 0; c < 16; ++c) { const double br = (double)INP(I_BRE)[(size_t)idx * 16 + c], bi = (double)INP(I_BIM)[(size_t)idx * 16 + c];
              bbm[((size_t)lg * 128 + pp) * 16 + c] = f2bf((float)(fr * br - fi * bi)); bbm[((size_t)lg * 128 + 64 + pp) * 16 + c] = f2bf((float)(fr * bi + fi * br)); } } }
    { bf16_t* cmt = WSP(bf16_t, WS_CMT);
      for (int idx = gt; idx < DEPTH * 16 * 16 * 128; idx += NGT) { const int k = idx & 127, lgc = idx >> 7;
          cmt[idx] = f2bf(k < 64 ? INP(I_CRE)[(size_t)lgc * 64 + k] : -INP(I_CIM)[(size_t)lgc * 64 + k - 64]); } }
    { bf16_t* wgt = WSP(bf16_t, WS_WGT);
      for (int idx = gt; idx < DEPTH * 65536; idx += NGT) { const int k = idx & 255, n = (idx >> 8) & 255, l = idx >> 16;
          wgt[idx] = f2bf(INP(I_WGLU)[((size_t)l * 256 + k) * 256 + n]); } }
    { bf16_t* kbs = WSP(bf16_t, WS_KBS); bf16_t* vts = WSP(bf16_t, WS_VTS);
      for (int idx = gt; idx < DEPTH * SB * 128 * 128; idx += NGT) { const int col = idx & 127, i = (idx >> 7) & 127, lb = idx >> 14;
          const int kvh = col >> 6, ph = col & 63, d = (ph >> 1) + 32 * (ph & 1);
          kbs[((size_t)lb * 144 + i) * 128 + col] = f2bf(INP(I_CK)[(((size_t)lb * 128 + i) * 2 + kvh) * 64 + d]);
          vts[((size_t)lb * 128 + col) * 144 + i] = f2bf(INP(I_CV)[((size_t)lb * 128 + i) * 128 + col]); } }
}

constexpr int L_AL = 0, L_BL = 33792;
constexpr int L_BU = 0;
constexpr int L_UA = 67584;
constexpr int L_SL = 67584;
constexpr int L_UZ = 103424;
constexpr int L_PAR = 137216;
constexpr int L_KL = 0, L_VL = 52224;
constexpr int UP = 264;
constexpr int P_CW = 0, P_CB = 1024, P_BRG = 1280, P_BIG = 1536, P_SP = 1792, P_SD = 2048, P_BGLU = 2304;
static_assert(L_PAR + 2560 * 4 <= L_MISC && L_UA + 67 * UP * 2 <= L_UZ && L_UZ + 64 * UP * 2 <= L_PAR && L_VL + 128 * 400 <= L_UZ, "mixer LDS map");

template <int NT, bool SMP>
__device__ __forceinline__ void stage_uab(const Params& p, int l, int b, int c, LAS unsigned char* lds) {
    int tid_ = threadIdx.x; asm volatile("" : "+v"(tid_));
    const int tid = tid_;
    const bf16_t* ua = WSP(const bf16_t, WS_UA); const bf16_t* ub = WSP(const bf16_t, WS_UB);
    const size_t seq0 = SMP ? (size_t)MP + b * SS : (size_t)b * SEQ;
    const int ts0 = SMP ? 0 : c * 64;
    constexpr int NR = NT * 16 + 3, NIA = (NR * 32 + NTHR - 1) / NTHR, NIB = (NT * 16 * 32 + NTHR - 1) / NTHR;
    u32x4 va[NIA], vb[NIB];
#pragma unroll
    for (int i = 0; i < NIA; ++i) { const int idx = tid + i * NTHR, r = idx >> 5, ck = idx & 31, ts = ts0 - 3 + r;
        va[i] = (u32x4){0u, 0u, 0u, 0u};
        if (idx < NR * 32) {
            if (ts >= 0) va[i] = *(const u32x4*)(ua + (seq0 + ts) * 256 + 8 * ck);
            else if (SMP) { const float* h = WSP(const float, WS_SMALL) + SM_CCONV + ((size_t)(l * SB + b) * 3 + (3 + ts)) * 256 + 8 * ck;
                const f32x4 x = *(const f32x4*)h, y = *(const f32x4*)(h + 4);
                va[i] = (u32x4){cvt_pk_bf16(x[0], x[1]), cvt_pk_bf16(x[2], x[3]), cvt_pk_bf16(y[0], y[1]), cvt_pk_bf16(y[2], y[3])}; }
        } }
#pragma unroll
    for (int i = 0; i < NIB; ++i) { const int idx = tid + i * NTHR, t = idx >> 5, ck = idx & 31;
        vb[i] = (u32x4){0u, 0u, 0u, 0u};
        if (idx < NT * 16 * 32) vb[i] = *(const u32x4*)(ub + (seq0 + ts0 + t) * 256 + 8 * ck); }
#pragma unroll
    for (int i = 0; i < NIA; ++i) { const int idx = tid + i * NTHR, r = idx >> 5, ck = idx & 31;
        if (idx < NR * 32) *(LAS u32x4*)(lds + L_UA + r * (UP * 2) + ck * 16) = va[i]; }
#pragma unroll
    for (int i = 0; i < NIB; ++i) { const int idx = tid + i * NTHR, t = idx >> 5, ck = idx & 31;
        if (idx < NT * 16 * 32) *(LAS u32x4*)(lds + L_UZ + t * (UP * 2) + ck * 16) = vb[i]; }
}

template <int NV>
__device__ __forceinline__ void conv_lds(float (&xc)[NV], const LAS bf16_t* uaL, const LAS float* par, int tl, int ch) {
#pragma unroll
    for (int e = 0; e < NV; e += 4) { const f32x4 cb = *(const LAS f32x4*)(par + P_CB + ch + e); xc[e] = cb[0]; xc[e + 1] = cb[1]; xc[e + 2] = cb[2]; xc[e + 3] = cb[3]; }
#pragma unroll
    for (int j = 0; j < 4; ++j) {
        float w[NV];
#pragma unroll
        for (int e = 0; e < NV; e += 4) { const f32x4 cw = *(const LAS f32x4*)(par + P_CW + j * 256 + ch + e); w[e] = cw[0]; w[e + 1] = cw[1]; w[e + 2] = cw[2]; w[e + 3] = cw[3]; }
        const LAS bf16_t* src = uaL + (tl + j) * UP + ch;
        if constexpr (NV == 8) { const bf16x8 v = *(const LAS bf16x8*)src;
#pragma unroll
            for (int e = 0; e < 8; ++e) xc[e] += bf2f(v[e]) * w[e];
        } else { const bf16x4 v = *(const LAS bf16x4*)src;
#pragma unroll
            for (int e = 0; e < 4; ++e) xc[e] += bf2f(v[e]) * w[e]; }
    }
}

template <int NT, bool SMP>
__device__ __forceinline__ void lru_item(const Params& p, int l, int b, int c, int pass, LAS unsigned char* lds, float& hfold, int cprev) {
    constexpr int HT = NT >= 2 ? 2 : 1, NH = NT / HT, TS = HT * 16 + 1, NPF = HT * 16 * 128 / NTHR;
    LAS float* aL = (LAS float*)(lds + L_AL); LAS float* bL = (LAS float*)(lds + L_BL);
    const LAS bf16_t* uaL = (const LAS bf16_t*)(lds + L_UA); const LAS float* par = (const LAS float*)(lds + L_PAR);
    int tid_ = threadIdx.x; asm volatile("" : "+v"(tid_));
    const int tid = tid_, wid = __builtin_amdgcn_readfirstlane(tid >> 6), lane = tid & 63, l15 = lane & 15, g = lane >> 4, h = wid >> 1, nh = wid & 1;
    const bf16_t* ga = WSP(const bf16_t, WS_GA); bf16_t* mix = WSP(bf16_t, WS_MIX);
    const size_t row0 = SMP ? (size_t)MP + b * SS : (size_t)b * SEQ + c * 64;
    const bf16_t* gwt = WSP(const bf16_t, WS_GATE) + (size_t)l * 2 * 4 * 4096;
    bf16x8 xr[2][2], xi[2][2];
#pragma unroll
    for (int nt2 = 0; nt2 < 2; ++nt2)
#pragma unroll
        for (int ks = 0; ks < 2; ++ks) { const int n = 32 * nh + 16 * nt2 + l15;
            xr[nt2][ks] = *(const bf16x8*)(gwt + ((size_t)(0 * 4 + h) * 64 + n) * 64 + 32 * ks + 8 * g);
            xi[nt2][ks] = *(const bf16x8*)(gwt + ((size_t)(1 * 4 + h) * 64 + n) * 64 + 32 * ks + 8 * g); }
    float fA[16], fB[16], hsm = 0.f;
#pragma unroll
    for (int i = 0; i < 16; ++i) { fA[i] = 1.f; fB[i] = 0.f; }
    if (tid < 256) {
        if (SMP) hsm = WSP(const float, WS_SMALL)[SM_SLRU + (size_t)(l * SB + b) * 256 + tid];
        else if (pass == 1) {
            const float* sA = WSP(const float, WS_SUMA) + (size_t)b * 64 * 256 + tid; const float* sB = WSP(const float, WS_SUMB) + (size_t)b * 64 * 256 + tid;
#pragma unroll
            for (int i = 0; i < 16; ++i) { const int cc = cprev + i < 63 ? cprev + i : 63; fA[i] = sA[cc * 256]; fB[i] = sB[cc * 256]; }
        }
    }
    {
        const int cgp = tid & 31, t0 = NT * (tid >> 5);
        float w[4][8], xc[NT][8];
#pragma unroll
        for (int j = 0; j < 4; ++j)
#pragma unroll
            for (int e = 0; e < 8; e += 4) { const f32x4 cw = *(const LAS f32x4*)(par + P_CW + j * 256 + 8 * cgp + e); w[j][e] = cw[0]; w[j][e + 1] = cw[1]; w[j][e + 2] = cw[2]; w[j][e + 3] = cw[3]; }
#pragma unroll
        for (int e = 0; e < 8; e += 4) { const f32x4 cb = *(const LAS f32x4*)(par + P_CB + 8 * cgp + e);
#pragma unroll
            for (int tk = 0; tk < NT; ++tk) { xc[tk][e] = cb[0]; xc[tk][e + 1] = cb[1]; xc[tk][e + 2] = cb[2]; xc[tk][e + 3] = cb[3]; } }
#pragma unroll
        for (int i = 0; i < NT + 3; ++i) { const bf16x8 v = *(const LAS bf16x8*)(uaL + (t0 + i) * UP + 8 * cgp);
#pragma unroll
            for (int tk = 0; tk < NT; ++tk) { const int j = i - tk; if (j >= 0 && j < 4) {
#pragma unroll
                for (int e = 0; e < 8; ++e) xc[tk][e] += bf2f(v[e]) * w[j][e]; } } }
        __syncthreads();
#pragma unroll
        for (int tk = 0; tk < NT; ++tk) { u32x4 o; o.x = cvt_pk_bf16(xc[tk][0], xc[tk][1]); o.y = cvt_pk_bf16(xc[tk][2], xc[tk][3]); o.z = cvt_pk_bf16(xc[tk][4], xc[tk][5]); o.w = cvt_pk_bf16(xc[tk][6], xc[tk][7]);
            *(LAS u32x4*)((LAS unsigned char*)(lds + L_UA) + ((t0 + tk) * UP + 8 * cgp) * 2) = o; }
        __syncthreads();
    }
    float hrun = 0.f, prun = 1.f;
    if (tid < 256) {
        if (SMP) hrun = hsm;
        else if (pass == 1) {
            float hf = hfold;
#pragma unroll
            for (int i = 0; i < 16; ++i) if (cprev + i < c) hf = fA[i] * hf + fB[i];
            hfold = hf; hrun = hf;
        }
    }
#pragma unroll 1
    for (int half = 0; half < NH; ++half) {
        unsigned gp[NPF];
        if (pass == 1) {
#pragma unroll
            for (int k = 0; k < NPF; ++k) { const int idx = tid + k * NTHR, t = idx >> 7, ch = 2 * (idx & 127); gp[k] = *(const unsigned*)(ga + (row0 + half * HT * 16 + t) * 256 + ch); }
        }
        f32x4 ar[2][HT], ai_[2][HT];
#pragma unroll
        for (int a = 0; a < 2; ++a)
#pragma unroll
            for (int t = 0; t < HT; ++t) { ar[a][t] = (f32x4){0.f, 0.f, 0.f, 0.f}; ai_[a][t] = (f32x4){0.f, 0.f, 0.f, 0.f}; }
#pragma unroll
        for (int tt = 0; tt < HT; ++tt) {
            const int tl = (half * HT + tt) * 16 + l15;
#pragma unroll
            for (int ks = 0; ks < 2; ++ks) {
                const bf16x8 y = *(const LAS bf16x8*)(uaL + tl * UP + 64 * h + 32 * ks + 8 * g);
#pragma unroll
                for (int nt2 = 0; nt2 < 2; ++nt2) { ar[nt2][tt] = mma16(xr[nt2][ks], y, ar[nt2][tt]); ai_[nt2][tt] = mma16(xi[nt2][ks], y, ai_[nt2][tt]); }
            }
        }
#pragma unroll
        for (int nt2 = 0; nt2 < 2; ++nt2)
#pragma unroll
            for (int tt = 0; tt < HT; ++tt) {
                const int tl = (half * HT + tt) * 16 + l15, ch0 = 64 * h + 32 * nh + 16 * nt2 + 4 * g;
                const bf16x4 xv = *(const LAS bf16x4*)(uaL + tl * UP + ch0);
                const f32x4 br4 = *(const LAS f32x4*)(par + P_BRG + ch0), bi4 = *(const LAS f32x4*)(par + P_BIG + ch0), sp4 = *(const LAS f32x4*)(par + P_SP + ch0);
#pragma unroll
                for (int j = 0; j < 4; ++j) { const int ch = ch0 + j;
                    const float r = sigmoidf_(ar[nt2][tt][j] + br4[j]), ig = sigmoidf_(ai_[nt2][tt][j] + bi4[j]);
                    const float la = -8.0f * r * sp4[j], a = __expf(la), x2 = 2.0f * la;
                    const float ser = -x2 * (1.0f + x2 * (0.5f + x2 * (0.16666667f + x2 * (0.041666668f + x2 * 0.008333334f))));
                    const float mult = __builtin_amdgcn_sqrtf(x2 > -0.25f ? ser : 1.0f - a * a);
                    aL[ch * TS + tt * 16 + l15] = a; bL[ch * TS + tt * 16 + l15] = mult * ig * bf2f(xv[j]); }
            }
        __syncthreads();
        if (tid < 256) {
#pragma unroll 8
            for (int t = 0; t < HT * 16; ++t) { const float a = aL[tid * TS + t]; hrun = a * hrun + bL[tid * TS + t]; prun *= a; bL[tid * TS + t] = hrun; }
        }
        __syncthreads();
        if (pass == 1) {
#pragma unroll
            for (int k = 0; k < NPF; ++k) { const int idx = tid + k * NTHR, t = idx >> 7, ch = 2 * (idx & 127); const size_t row = row0 + half * HT * 16 + t;
                const float h0 = bL[ch * TS + t], h1 = bL[(ch + 1) * TS + t];
                const float g0 = __uint_as_float(gp[k] << 16), g1 = __uint_as_float(gp[k] & 0xffff0000u);
                *(unsigned*)(mix + row * DM + ch) = cvt_pk_bf16(h0 * gelu_tanh(g0), h1 * gelu_tanh(g1)); }
        }
        __syncthreads();
    }
    if (tid < 256) {
        if (!SMP && pass == 0) { WSP(float, WS_SUMA)[((size_t)b * 64 + c) * 256 + tid] = prun; WSP(float, WS_SUMB)[((size_t)b * 64 + c) * 256 + tid] = hrun; }
        if (pass == 1) { if (SMP) p.out[O_LRUS + (size_t)(l * SB + b) * 256 + tid] = hrun; else if (c == 63) p.out[O_LRUP + (size_t)(l * NB + b) * 256 + tid] = hrun; }
    }
}

template <int NT, bool SMP>
__device__ __forceinline__ void s5_item(const Params& p, int l, int b, int c, int pass, LAS unsigned char* lds, int cprev) {
    const bool fin = SMP || pass == 1;
    int tid_ = threadIdx.x; asm volatile("" : "+v"(tid_));
    const int tid = tid_, wid = __builtin_amdgcn_readfirstlane(tid >> 6), lane = tid & 63, l15 = lane & 15, g = lane >> 4;
    LAS float* buL = (LAS float*)(lds + L_BU + wid * 8448);
    LAS bf16_t* sL = (LAS bf16_t*)(lds + L_SL + wid * 4352);
    LAS bf16_t* uz = (LAS bf16_t*)(lds + L_UZ);
    const LAS float* par = (const LAS float*)(lds + L_PAR);
    bf16_t* mix = WSP(bf16_t, WS_MIX);
    const size_t row0 = SMP ? (size_t)MP + b * SS : (size_t)b * SEQ + c * 64;
    const float* abar = WSP(const float, WS_ABAR); const bf16_t* bbm = WSP(const bf16_t, WS_BBM); const bf16_t* cmt = WSP(const bf16_t, WS_CMT);
    const bf16x8 z8 = {0, 0, 0, 0, 0, 0, 0, 0};
    float zf = 0.f; asm volatile("" : "+v"(zf));
#pragma unroll 1
    for (int gi = 0; gi < 2; ++gi) {
        const int grp = 2 * wid + gi, lg = l * 16 + grp;
        const f32x4 ab = *(const f32x4*)(abar + ((size_t)lg * 64 + lane) * 4);
        float sre = 0.f, sim = 0.f;
        if (SMP) { sre = WSP(const float, WS_SMALL)[SM_SSRE + ((size_t)(l * SB + b) * 16 + grp) * 64 + lane]; sim = WSP(const float, WS_SMALL)[SM_SSIM + ((size_t)(l * SB + b) * 16 + grp) * 64 + lane]; }
        else if (pass == 1) {
            float* fs = WSP(float, WS_FOLD) + ((size_t)blockIdx.x * 16 + grp) * 128 + lane;
            if (cprev > 0) { sre = fs[0]; sim = fs[64]; }
            const float* S = WSP(const float, WS_SUMS) + ((size_t)b * 64 * 16 + grp) * 128 + lane;
            float re[16], im[16];
#pragma unroll
            for (int i = 0; i < 16; ++i) { const int cc = cprev + i < 63 ? cprev + i : 63; re[i] = S[(size_t)cc * 2048]; im[i] = S[(size_t)cc * 2048 + 64]; }
#pragma unroll
            for (int i = 0; i < 16; ++i) if (cprev + i < c) { const float nre = ab[2] * sre - ab[3] * sim + re[i], nim = ab[2] * sim + ab[3] * sre + im[i]; sre = nre; sim = nim; }
            fs[0] = sre; fs[64] = sim;
        }
        bf16x8 ybb[8], ycm[4];
#pragma unroll
        for (int pt = 0; pt < 8; ++pt) ybb[pt] = g < 2 ? *(const bf16x8*)(bbm + ((size_t)lg * 128 + 16 * pt + l15) * 16 + 8 * g) : z8;
#pragma unroll
        for (int ks = 0; ks < 4; ++ks) ycm[ks] = *(const bf16x8*)(cmt + ((size_t)lg * 16 + l15) * 128 + 32 * ks + 8 * g);
        const float dd = par[P_SD + 16 * grp + l15];
#pragma unroll 1
        for (int tt = 0; tt < NT; ++tt) {
            const bf16x8 x = g < 2 ? *(const LAS bf16x8*)(uz + (tt * 16 + l15) * UP + 16 * grp + 8 * g) : z8;
            LAS bf16_t* buT = (LAS bf16_t*)buL;
#pragma unroll
            for (int pt = 0; pt < 8; ++pt) { const f32x4 a = mma16(x, ybb[pt], (f32x4){0.f, 0.f, 0.f, 0.f});
                u32x2 w; w.x = cvt_pk_bf16(a[0] + zf, a[1] + zf); w.y = cvt_pk_bf16(a[2] + zf, a[3] + zf);
                *(LAS u32x2*)(buT + (16 * pt + l15) * 24 + 4 * g) = w; }
            LDS_WAIT();
            {
                const u32x4 r0 = *(const LAS u32x4*)(buT + lane * 24), r1 = *(const LAS u32x4*)(buT + lane * 24 + 8);
                const u32x4 i0 = *(const LAS u32x4*)(buT + (64 + lane) * 24), i1 = *(const LAS u32x4*)(buT + (64 + lane) * 24 + 8);
                const unsigned rw[8] = {r0.x, r0.y, r0.z, r0.w, r1.x, r1.y, r1.z, r1.w}, iw[8] = {i0.x, i0.y, i0.z, i0.w, i1.x, i1.y, i1.z, i1.w};
#pragma unroll
                for (int t = 0; t < 16; ++t) {
                    const float re = (t & 1) ? __uint_as_float(rw[t >> 1] & 0xffff0000u) : __uint_as_float(rw[t >> 1] << 16);
                    const float im = (t & 1) ? __uint_as_float(iw[t >> 1] & 0xffff0000u) : __uint_as_float(iw[t >> 1] << 16);
                    const float nre = ab[0] * sre - ab[1] * sim + re, nim = ab[0] * sim + ab[1] * sre + im; sre = nre; sim = nim;
                    if (fin) { sL[t * 136 + lane] = f2bf(sre); sL[t * 136 + 64 + lane] = f2bf(sim); } }
            }
            LDS_WAIT();
            if (fin) {
                f32x4 y = {0.f, 0.f, 0.f, 0.f};
#pragma unroll
                for (int ks = 0; ks < 4; ++ks) { const bf16x8 xs = *(const LAS bf16x8*)(sL + l15 * 136 + 32 * ks + 8 * g); y = mma16(xs, ycm[ks], y); }
#pragma unroll
                for (int j = 0; j < 4; ++j) { const int t = tt * 16 + 4 * g + j, ch = 16 * grp + l15;
                    const float u = bf2f((short)uz[t * UP + ch]); uz[t * UP + ch] = f2bf(gelu_tanh(y[j] + dd * u)); }
            }
            LDS_WAIT();
        }
        if (!SMP && pass == 0) { float* S = WSP(float, WS_SUMS) + (((size_t)b * 64 + c) * 16 + grp) * 128; S[lane] = sre; S[64 + lane] = sim; }
        if (pass == 1) {
            if (SMP) { p.out[O_SRES + ((size_t)(l * SB + b) * 16 + grp) * 64 + lane] = sre; p.out[O_SIMS + ((size_t)(l * SB + b) * 16 + grp) * 64 + lane] = sim; }
            else if (c == 63) { p.out[O_SREP + ((size_t)(l * NB + b) * 16 + grp) * 64 + lane] = sre; p.out[O_SIMP + ((size_t)(l * NB + b) * 16 + grp) * 64 + lane] = sim; }
        }
    }
    if (fin) {
        __syncthreads();
        const bf16_t* wgt = WSP(const bf16_t, WS_WGT) + (size_t)l * 65536;
#pragma unroll 1
        for (int nt2 = 0; nt2 < 2; ++nt2) {
            bf16x8 yw[8];
#pragma unroll
            for (int ks = 0; ks < 8; ++ks) yw[ks] = *(const bf16x8*)(wgt + (size_t)(32 * wid + 16 * nt2 + l15) * 256 + 32 * ks + 8 * g);
            const float bg = par[P_BGLU + 32 * wid + 16 * nt2 + l15];
#pragma unroll 1
            for (int tt = 0; tt < NT; ++tt) {
                f32x4 a = {0.f, 0.f, 0.f, 0.f};
#pragma unroll
                for (int ks = 0; ks < 8; ++ks) { const bf16x8 xz = *(const LAS bf16x8*)(uz + (tt * 16 + l15) * UP + 32 * ks + 8 * g); a = mma16(xz, yw[ks], a); }
#pragma unroll
                for (int j = 0; j < 4; ++j) { const int t = tt * 16 + 4 * g + j, n = 32 * wid + 16 * nt2 + l15;
                    const float z = bf2f((short)uz[t * UP + n]); mix[(row0 + t) * DM + 256 + n] = f2bf(z * sigmoidf_(a[j] + bg)); }
            }
        }
    }
    __syncthreads();
}

template <int NQT, bool SMP>
__device__ __forceinline__ void attn_item(const Params& p, int l, int b, int c, LAS unsigned char* lds) {
    int tid_ = threadIdx.x; asm volatile("" : "+v"(tid_));
    const int tid = tid_, wid = __builtin_amdgcn_readfirstlane(tid >> 6), lane = tid & 63, l15 = lane & 15, g = lane >> 4, kvh = wid >> 2;
    const bf16_t* q = WSP(const bf16_t, WS_Q); bf16_t* mix = WSP(bf16_t, WS_MIX);
    const bf16_t* kbase; const bf16_t* vbase; size_t vstride, row0; int nkt;
    if (SMP) { kbase = WSP(const bf16_t, WS_KBS) + (size_t)(l * SB + b) * 144 * 128; vbase = WSP(const bf16_t, WS_VTS) + (size_t)(l * SB + b) * 128 * 144; vstride = 144; nkt = 9; row0 = (size_t)MP + b * SS; }
    else { const int c0 = c >= 2 ? c - 2 : 0; kbase = WSP(const bf16_t, WS_KBP) + ((size_t)b * SEQ + c0 * 64) * 128; vbase = WSP(const bf16_t, WS_VTP) + (size_t)b * 128 * SEQ + c0 * 64;
        vstride = SEQ; nkt = 4 * (c - c0 + 1); row0 = (size_t)b * SEQ + c * 64; }
    bf16x8 yq[NQT][2];
#pragma unroll
    for (int qt = 0; qt < NQT; ++qt)
#pragma unroll
        for (int ks = 0; ks < 2; ++ks) yq[qt][ks] = *(const bf16x8*)(q + (row0 + qt * 16 + l15) * 512 + wid * 64 + 32 * ks + 8 * g);
    {
        const int nkc = nkt * 16 * 16, cpr = nkt * 2, nvc = 128 * cpr;
        u32x4 kv[6], vv[6];
#pragma unroll
        for (int i = 0; i < 6; ++i) { const int idx = tid + i * NTHR; kv[i] = (u32x4){0u, 0u, 0u, 0u};
            if (idx < nkc) kv[i] = *(const u32x4*)(kbase + (size_t)(idx >> 4) * 128 + 8 * (idx & 15)); }
#pragma unroll
        for (int i = 0; i < 6; ++i) { const int idx = tid + i * NTHR, r = idx / cpr, ck = idx - r * cpr; vv[i] = (u32x4){0u, 0u, 0u, 0u};
            if (idx < nvc) vv[i] = *(const u32x4*)(vbase + (size_t)r * vstride + 8 * ck); }
#pragma unroll
        for (int i = 0; i < 6; ++i) { const int idx = tid + i * NTHR; if (idx < nkc) *(LAS u32x4*)(lds + L_KL + (idx >> 4) * 272 + (idx & 15) * 16) = kv[i]; }
#pragma unroll
        for (int i = 0; i < 6; ++i) { const int idx = tid + i * NTHR, r = idx / cpr, ck = idx - r * cpr; if (idx < nvc) *(LAS u32x4*)(lds + L_VL + r * 400 + ck * 16) = vv[i]; }
    }
    __syncthreads();
    const float sink = WSP(const float, WS_SMALL)[SM_SINK + l * 8 + wid];
    const bf16x4 z4 = {0, 0, 0, 0};
    const LAS unsigned char* kL = lds + L_KL + l15 * 272 + (kvh * 64 + 8 * g) * 2;
    const LAS unsigned char* vL = lds + L_VL + (kvh * 64 + l15) * 400 + (4 * g) * 2;
    constexpr int QB = NQT >= 2 ? 2 : 1;
#pragma unroll
    for (int qp = 0; qp < NQT / QB; ++qp) {
        f32x4 s[QB][12];
#pragma unroll
        for (int kt = 0; kt < 12; ++kt) {
#pragma unroll
            for (int qb = 0; qb < QB; ++qb) s[qb][kt] = (f32x4){0.f, 0.f, 0.f, 0.f};
            if (kt < nkt) {
#pragma unroll
                for (int ks = 0; ks < 2; ++ks) { const bf16x8 x = *(const LAS bf16x8*)(kL + kt * 16 * 272 + ks * 64);
#pragma unroll
                    for (int qb = 0; qb < QB; ++qb) s[qb][kt] = mma16(x, yq[qp * QB + qb][ks], s[qb][kt]); } } }
        float inv[QB];
#pragma unroll
        for (int qb = 0; qb < QB; ++qb) {
            float mx = sink;
#pragma unroll
            for (int kt = 0; kt < 12; ++kt) if (kt < nkt) mx = fmaxf(fmaxf(mx, fmaxf(s[qb][kt][0], s[qb][kt][1])), fmaxf(s[qb][kt][2], s[qb][kt][3]));
            mx = fmaxf(mx, __shfl_xor(mx, 16)); mx = fmaxf(mx, __shfl_xor(mx, 32));
            float sum = 0.f;
#pragma unroll
            for (int kt = 0; kt < 12; ++kt) if (kt < nkt) {
#pragma unroll
                for (int j = 0; j < 4; ++j) { const float e = __expf(s[qb][kt][j] - mx); s[qb][kt][j] = e; sum += e; } }
            sum += __shfl_xor(sum, 16); sum += __shfl_xor(sum, 32); sum += __expf(sink - mx);
            inv[qb] = 1.0f / sum;
        }
        f32x4 o[QB][4];
#pragma unroll
        for (int qb = 0; qb < QB; ++qb)
#pragma unroll
            for (int dt = 0; dt < 4; ++dt) o[qb][dt] = (f32x4){0.f, 0.f, 0.f, 0.f};
#pragma unroll
        for (int kk = 0; kk < 6; ++kk) if (2 * kk < nkt) {
            bf16x8 y[QB];
#pragma unroll
            for (int qb = 0; qb < QB; ++qb) { u32x4 w; w.x = cvt_pk_bf16(s[qb][2 * kk][0], s[qb][2 * kk][1]); w.y = cvt_pk_bf16(s[qb][2 * kk][2], s[qb][2 * kk][3]);
                w.z = cvt_pk_bf16(s[qb][2 * kk + 1][0], s[qb][2 * kk + 1][1]); w.w = cvt_pk_bf16(s[qb][2 * kk + 1][2], s[qb][2 * kk + 1][3]);
                y[qb] = __builtin_bit_cast(bf16x8, w); }
            const bool hi = 2 * kk + 1 < nkt;
#pragma unroll
            for (int dt = 0; dt < 4; ++dt) { const LAS unsigned char* vr = vL + dt * 16 * 400 + kk * 64;
                const bf16x4 lo = *(const LAS bf16x4*)vr; const bf16x4 h4 = hi ? *(const LAS bf16x4*)(vr + 32) : z4;
                const bf16x8 x = __builtin_shufflevector(lo, h4, 0, 1, 2, 3, 4, 5, 6, 7);
#pragma unroll
                for (int qb = 0; qb < QB; ++qb) o[qb][dt] = mma16(x, y[qb], o[qb][dt]); }
        }
#pragma unroll
        for (int qb = 0; qb < QB; ++qb) { const size_t qrow = row0 + (qp * QB + qb) * 16 + l15;
#pragma unroll
            for (int dt = 0; dt < 4; ++dt) { u32x2 w; w.x = cvt_pk_bf16(o[qb][dt][0] * inv[qb], o[qb][dt][1] * inv[qb]); w.y = cvt_pk_bf16(o[qb][dt][2] * inv[qb], o[qb][dt][3] * inv[qb]);
                *(u32x2*)(mix + qrow * DM + 512 + wid * 64 + 16 * dt + 4 * g) = w; } }
    }
    __syncthreads();
}

__device__ __forceinline__ void mixer_pass(const Params& p, int l, int pass, LAS unsigned char* lds) {
    {
        LAS float* par = (LAS float*)(lds + L_PAR); const float* sm = WSP(const float, WS_SMALL);
        for (int i = threadIdx.x; i < 2560; i += NTHR) { float v;
            if (i < 1024) v = sm[SM_CW + l * 1024 + i];
            else { const int k = (i - 1024) >> 8, j = i & 255;
                v = k == 0 ? sm[SM_CB + l * 256 + j] : k == 1 ? sm[SM_BRG + l * 256 + j] : k == 2 ? sm[SM_BIG + l * 256 + j] : k == 3 ? WSP(const float, WS_SP)[l * 256 + j] : k == 4 ? sm[SM_SD + l * 256 + j] : sm[SM_BGLU + l * 256 + j]; }
            par[i] = v; }
        __syncthreads();
    }
    float hfold = 0.f; int cprev = 0;
#pragma unroll 1
    for (int it = blockIdx.x; it < NB * 64 + SB; it += gridDim.x) {
        if (it < NB * 64) { const int b = it & 15, c = it >> 4;
            stage_uab<4, false>(p, l, b, c, lds); __syncthreads();
#ifndef DUPM
#define DUPM 0
#endif
            { float hf0 = hfold; for (int r2 = 0; r2 < ((DUPM & 1) ? 2 : 1); ++r2) { hfold = hf0; lru_item<4, false>(p, l, b, c, pass, lds, hfold, cprev); } }
            for (int r2 = 0; r2 < ((DUPM & 2) ? 2 : 1); ++r2) { if ((DUPM & 2) && r2 == 1) { stage_uab<4, false>(p, l, b, c, lds); __syncthreads(); } s5_item<4, false>(p, l, b, c, pass, lds, r2 == 1 && pass == 1 ? c : cprev); }
            cprev = c;
            for (int r2 = 0; r2 < ((DUPM & 4) ? 2 : 1); ++r2) if (pass == 0) attn_item<4, false>(p, l, b, c, lds);
        } else { const int b = it - NB * 64;
            if (pass == 0) { attn_item<1, true>(p, l, b, 0, lds);
                float hf = 0.f; stage_uab<1, true>(p, l, b, 0, lds); __syncthreads(); lru_item<1, true>(p, l, b, 0, 1, lds, hf, 0); s5_item<1, true>(p, l, b, 0, 1, lds, 0); }
        }
    }
}

__device__ __forceinline__ void final_norm(const Params& p) {
    int tid_ = threadIdx.x; asm volatile("" : "+v"(tid_));
    const int lane = tid_ & 63, gw = blockIdx.x * NWAVES + (tid_ >> 6), NGW = gridDim.x * NWAVES;
    const float* ss = WSP(const float, WS_SS); const f32x4* nf = (const f32x4*)(WSP(const float, WS_SMALL) + SM_NF) + 2 * lane;
    const bf16_t* xb = WSP(const bf16_t, WS_XB);
#pragma unroll 1
    for (int row = gw; row < MREAL; row += NGW) {
        const float rs = ss_rs(ss, row); f32x4* o = (f32x4*)(p.out + O_Y + (size_t)row * DM) + 2 * lane; const u32x4* xi = (const u32x4*)(xb + (size_t)row * DM) + lane;
#pragma unroll
        for (int j = 0; j < 2; ++j) { const u32x4 w = xi[64 * j]; const f32x4 g0 = nf[128 * j], g1 = nf[128 * j + 1];
            o[128 * j] = (f32x4){__uint_as_float(w.x << 16) * rs * g0[0], __uint_as_float(w.x & 0xffff0000u) * rs * g0[1], __uint_as_float(w.y << 16) * rs * g0[2], __uint_as_float(w.y & 0xffff0000u) * rs * g0[3]};
            o[128 * j + 1] = (f32x4){__uint_as_float(w.z << 16) * rs * g1[0], __uint_as_float(w.z & 0xffff0000u) * rs * g1[1], __uint_as_float(w.w << 16) * rs * g1[2], __uint_as_float(w.w & 0xffff0000u) * rs * g1[3]}; }
    }
}

template <int KIND>
__device__ __forceinline__ void slab_gemm(const Params& p, LAS unsigned char* lds, const bf16_t* A, const bf16_t* Bt, int K, int N,
                                          const float* xin_s, float* xout_s, bf16_t* xb, float* ss, bf16_t* hid) {
    int tid_ = threadIdx.x; asm volatile("" : "+v"(tid_));
    const int tid = tid_, wid = __builtin_amdgcn_readfirstlane(tid >> 6), lane = tid & 63, l15 = lane & 15, g = lane >> 4;
    const int npieces = 8 * (N / 64), kw = K / 8;
#pragma unroll 1
    for (int pc = blockIdx.x; pc < npieces; pc += gridDim.x) {
        const int rt = pc & 7, cg = pc >> 3;
        f32x4 acc[4];
#pragma unroll
        for (int ct = 0; ct < 4; ++ct) acc[ct] = (f32x4){0.f, 0.f, 0.f, 0.f};
        const bf16_t* ap = A + (size_t)(MP + rt * 16 + l15) * K + wid * kw + 8 * g;
        const bf16_t* bp = Bt + (size_t)(cg * 64 + l15) * K + wid * kw + 8 * g;
#pragma unroll 4
        for (int ks = 0; ks < kw / 32; ++ks) {
            const bf16x8 x = *(const bf16x8*)(ap + 32 * ks);
#pragma unroll
            for (int ct = 0; ct < 4; ++ct) { const bf16x8 y = *(const bf16x8*)(bp + (size_t)ct * 16 * K + 32 * ks); acc[ct] = mma16(x, y, acc[ct]); }
        }
        LAS f32x4* part = (LAS f32x4*)lds;
#pragma unroll
        for (int ct = 0; ct < 4; ++ct) part[(wid * 4 + ct) * 64 + lane] = acc[ct];
        __syncthreads();
        const int r = 2 * wid + (lane >> 5), c = 2 * (lane & 31), gg = r >> 2, j = r & 3;
        float v0 = 0.f, v1 = 0.f;
#pragma unroll
        for (int w = 0; w < 8; ++w) { const LAS float* pp = (const LAS float*)lds + ((w * 4 + (c >> 4)) * 64 + 16 * gg + (c & 15)) * 4 + j; v0 += pp[0]; v1 += pp[4]; }
        const int row = MP + rt * 16 + r, col = cg * 64 + c;
        if (KIND == 0) {
            const size_t off = (size_t)(rt * 16 + r) * DM + col;
            float r0, r1;
            if (xin_s) { r0 = xin_s[off]; r1 = xin_s[off + 1]; }
            else { const unsigned xw = *(const unsigned*)(xb + (size_t)row * DM + col); r0 = __uint_as_float(xw << 16); r1 = __uint_as_float(xw & 0xffff0000u); }
            const float o0 = r0 + v0, o1 = r1 + v1;
            if (xout_s) { xout_s[off] = o0; xout_s[off + 1] = o1; }
            if (xb) *(unsigned*)(xb + (size_t)row * DM + col) = cvt_pk_bf16(o0, o1);
            float sq = o0 * o0 + o1 * o1;
#pragma unroll
            for (int o = 1; o < 32; o <<= 1) sq += __shfl_xor(sq, o);
            if ((lane & 31) == 0) ss[(size_t)row * 16 + cg] = sq;
        } else if (KIND == 1) {
            const float rs = ss_rs(ss, row), a0 = fmaxf(v0 * rs, 0.f), a1 = fmaxf(v1 * rs, 0.f);
            *(unsigned*)(hid + (size_t)row * DFF + col) = cvt_pk_bf16(a0 * a0, a1 * a1);
        } else {
            const int l = (int)(size_t)xin_s;
            const int sb = rt, st = r, pos = SEQ + st;
            const float rs = ss_rs(ss, row), a0 = v0 * rs, a1 = v1 * rs;
            if (col < 768) {
                bf16_t* dst = col < 256 ? WSP(bf16_t, WS_UA) : (col < 512 ? WSP(bf16_t, WS_GA) : WSP(bf16_t, WS_UB)); const int cc = col & 255;
                *(unsigned*)(dst + (size_t)row * 256 + cc) = cvt_pk_bf16(a0, a1);
                if (col < 256 && st >= SS - 3) { float* o = p.out + O_CONVS + ((size_t)(l * SB + sb) * 3 + (st - (SS - 3))) * 256 + cc; o[0] = a0; o[1] = a1; }
            } else if (col < 1408) {
                const int jp = (col & 63) >> 1; const float* rp = WSP(const float, WS_ROPE) + ((size_t)pos * 32 + jp) * 2;
                const float cs = rp[0], sn = rp[1], o0 = a0 * cs - a1 * sn, o1 = a1 * cs + a0 * sn;
                if (col < 1280) *(unsigned*)(WSP(bf16_t, WS_Q) + (size_t)row * 512 + (col - 768)) = cvt_pk_bf16(o0 * 0.125f, o1 * 0.125f);
                else { const int kc = col - 1280, kvh = kc >> 6;
                    *(unsigned*)(WSP(bf16_t, WS_KBS) + ((size_t)(l * SB + sb) * 144 + 128 + st) * 128 + kc) = cvt_pk_bf16(o0, o1);
                    float* o = p.out + O_KS + (((size_t)(l * SB + sb) * SS + st) * 2 + kvh) * 64 + jp; o[0] = o0; o[32] = o1; }
            } else {
                const int vc = col - 1408, kvh = vc >> 6, d = vc & 63;
                bf16_t* vt = WSP(bf16_t, WS_VTS) + ((size_t)(l * SB + sb) * 128 + vc) * 144 + 128 + st; vt[0] = f2bf(a0); vt[144] = f2bf(a1);
                float* o = p.out + O_VS + (((size_t)(l * SB + sb) * SS + st) * 2 + kvh) * 64 + d; o[0] = a0; o[1] = a1;
            }
        }
        __syncthreads();
    }
}

#define XB_TMO      128
#define XB_XCNT(j)  (256  + 64 * (j))
#define XB_XSUB(j)  (1280 + 64 * (j))
#define XB_XGEN(j)  (2304 + 64 * (j))
#define XB_TOP      3328
#define XB_TOPGEN   3392
#define XCD_BAR_WORDS 3456
#define XB_SPIN_CAP (1u << 18)

__device__ __forceinline__ unsigned xb_ld(unsigned* p)              { return __hip_atomic_load(p, __ATOMIC_RELAXED, __HIP_MEMORY_SCOPE_AGENT); }
__device__ __forceinline__ unsigned xb_add(unsigned* p, unsigned v) { return __hip_atomic_fetch_add(p, v, __ATOMIC_RELAXED, __HIP_MEMORY_SCOPE_AGENT); }
__device__ __forceinline__ unsigned xb_xcc_id() { return (unsigned)__builtin_amdgcn_s_getreg((3 << 11) | 20) & 0xFu; }
#define XB_SPIN(cond, bar) do { unsigned _sp = 0; while (cond) { __builtin_amdgcn_s_sleep(1); \
    if ((++_sp & 255u) == 0u) { if (xb_ld(&(bar)[XB_TMO])) break; if (_sp > XB_SPIN_CAP) { atomicAdd(&(bar)[XB_TMO], 1u); break; } } } } while (0)

struct XcdBarrier {
    unsigned* bar; unsigned x;
    volatile LAS unsigned* st;
};

__device__ __forceinline__ XcdBarrier xcd_barrier_post(unsigned* bar, volatile LAS unsigned* st) {
    XcdBarrier b; b.bar = bar; b.x = xb_xcc_id(); b.st = st;
    if (threadIdx.x == 0) (void)xb_add(&bar[XB_XCNT(b.x)], 1u);
    return b;
}
__device__ __forceinline__ void xcd_barrier_complete(unsigned* bar, unsigned x, unsigned& nloc, unsigned& nx) {
    const unsigned G = gridDim.x * gridDim.y * gridDim.z;
    unsigned sum, cnt, mine, sp = 0u;
    for (;;) {
        sum = 0u; cnt = 0u; mine = 0u;
#pragma unroll
        for (unsigned j = 0; j < 16; ++j) { const unsigned c = xb_ld(&bar[XB_XCNT(j)]); sum += c; cnt += (c > 0u) ? 1u : 0u; mine = (j == x) ? c : mine; }
        if (sum == G) break;
        __builtin_amdgcn_s_sleep(1);
        if ((++sp & 255u) == 0u) { if (xb_ld(&bar[XB_TMO])) break; if (sp > XB_SPIN_CAP) { atomicAdd(&bar[XB_TMO], 1u); break; } }
    }
    nloc = mine > 0u ? mine : 1u; nx = cnt > 0u ? cnt : 1u;
}

__device__ __forceinline__ void xcd_barrier(const XcdBarrier& b) {
    asm volatile("s_waitcnt vmcnt(0)" ::: "memory");
    __syncthreads();
    if (threadIdx.x == 0) {
        unsigned* bar = b.bar;
        __builtin_amdgcn_s_waitcnt(0);
        unsigned nloc = b.st[0], nx = b.st[1];
        if (nloc == 0u) { xcd_barrier_complete(bar, b.x, nloc, nx); b.st[0] = nloc; b.st[1] = nx; }
        const unsigned old = xb_add(&bar[XB_XSUB(b.x)], 1u);
        const unsigned gen = old / nloc;
        if (old + 1u == (gen + 1u) * nloc) {
            __builtin_amdgcn_fence(__ATOMIC_RELEASE, "agent");
            asm volatile("s_waitcnt vmcnt(0)" ::: "memory");
            const unsigned og = xb_add(&bar[XB_TOP], 1u);
            const unsigned tg = og / nx;
            if (og + 1u == (tg + 1u) * nx) xb_add(&bar[XB_TOPGEN], 1u);
            else XB_SPIN(xb_ld(&bar[XB_TOPGEN]) == tg, bar);
            __builtin_amdgcn_fence(__ATOMIC_ACQUIRE, "agent");
            xb_add(&bar[XB_XGEN(b.x)], 1u);
            asm volatile("s_waitcnt vmcnt(0)" ::: "memory");
        } else {
            XB_SPIN(xb_ld(&bar[XB_XGEN(b.x)]) == gen, bar);
            __builtin_amdgcn_fence(__ATOMIC_ACQUIRE, "agent");
            asm volatile("s_waitcnt vmcnt(0)" ::: "memory");
        }
    }
    __syncthreads();
}

#define GSYNC_CG() do { asm volatile("s_waitcnt vmcnt(0) lgkmcnt(0)" ::: "memory"); grid.sync(); __builtin_amdgcn_fence(__ATOMIC_ACQUIRE, "agent"); asm volatile("s_waitcnt vmcnt(0)" ::: "memory"); } while (0)
#define GSYNC() do { XcdBarrier xb_; xb_.bar = (unsigned*)(p.ws + WS_CTL); xb_.x = xb_xcc_id(); xb_.st = (volatile LAS unsigned*)(lds + L_MISC); xcd_barrier(xb_); } while (0)
__global__ void __launch_bounds__(NTHR, 2) fwd_kernel(Params p) {
    extern __shared__ __attribute__((aligned(16))) unsigned char lds_raw[];
    LAS unsigned char* lds = (LAS unsigned char*)lds_raw;
    cg::grid_group grid = cg::this_grid();
    const int G = gridDim.x, cid = blockIdx.x;
    volatile LAS unsigned* misc = (volatile LAS unsigned*)(lds + L_MISC);
    if (threadIdx.x < 2) misc[threadIdx.x] = 0u;
    if (threadIdx.x < 33) ((LAS unsigned long long*)(lds + L_PTAB))[threadIdx.x] = ((const unsigned long long*)__builtin_amdgcn_kernarg_segment_ptr())[threadIdx.x];
    __syncthreads();
    (void)xcd_barrier_post((unsigned*)(p.ws + WS_CTL), misc);
#ifndef EN
#define EN 0xff
#endif
#ifndef DUP
#define DUP 0
#endif
#define REPS(bit) (((DUP) & (bit)) && l == 0 ? 2 : 1)
#ifndef DUPP
#define DUPP 1
#endif
#pragma unroll 1
    for (int rp = 0; rp < DUPP; ++rp) { if (EN & 1) prologue(p, lds); __syncthreads(); }
#ifdef NOCG
    if (gridDim.y == 0x7fffffffu)
#endif
    GSYNC_CG();
#ifdef NOCG
    GSYNC();
#endif
#pragma unroll 1
    for (int l = 0; l < DEPTH; ++l) {
        if (EN & 2) {
            pg8::Gemm gm{WSP(const bf16_t, WS_XB), WSP(const bf16_t, WS_WIN) + (size_t)l * DIN * DM, MP, DIN, DM}; pg8::StaticOrder S; S.init(MP, DIN, G, cid);
            EpiIn E{p.ws, p.out, l};
            pg8::gemm_phase<EpiIn, pg8::StaticOrder, true, true>(lds, gm, S, E);
            slab_gemm<2>(p, lds, WSP(const bf16_t, WS_XB), WSP(const bf16_t, WS_WIN) + (size_t)l * DIN * DM, DM, DIN, (const float*)(size_t)l, nullptr, nullptr, WSP(float, WS_SS), nullptr);
        }
        GSYNC();
        if (EN & 4) mixer_pass(p, l, 0, lds);
        GSYNC();
        if (EN & 8) mixer_pass(p, l, 1, lds);
        GSYNC();
        if (EN & 16) {
            pg8::Gemm gm{WSP(const bf16_t, WS_MIX), WSP(const bf16_t, WS_WOUT) + (size_t)l * DM * DM, MP, DM, DM}; pg8::StaticOrder S; S.init(MP, DM, G, cid);
            EpiResB E{WSP(bf16_t, WS_XB), WSP(float, WS_SS)};
            pg8::gemm_phase<EpiResB, pg8::StaticOrder, true, true>(lds, gm, S, E);
            slab_gemm<0>(p, lds, WSP(const bf16_t, WS_MIX), WSP(const bf16_t, WS_WOUT) + (size_t)l * DM * DM, DM, DM, nullptr, nullptr, WSP(bf16_t, WS_XB), WSP(float, WS_SS), nullptr);
        }
        GSYNC();
        if (EN & 32) {
            pg8::Gemm gm{WSP(const bf16_t, WS_XB), WSP(const bf16_t, WS_WUP) + (size_t)l * DFF * DM, MP, DFF, DM}; pg8::StaticOrder S; S.init(MP, DFF, G, cid);
            EpiUp E{WSP(const float, WS_SS), WSP(bf16_t, WS_HID)};
            pg8::gemm_phase<EpiUp, pg8::StaticOrder, true, true>(lds, gm, S, E);
            slab_gemm<1>(p, lds, WSP(const bf16_t, WS_XB), WSP(const bf16_t, WS_WUP) + (size_t)l * DFF * DM, DM, DFF, nullptr, nullptr, nullptr, WSP(float, WS_SS), WSP(bf16_t, WS_HID));
        }
        GSYNC();
        if (EN & 64) {
            pg8::Gemm gm{WSP(const bf16_t, WS_HID), WSP(const bf16_t, WS_WDN) + (size_t)l * DM * DFF, MP, DM, DFF}; pg8::StaticOrder S; S.init(MP, DM, G, cid);
            EpiResB E{WSP(bf16_t, WS_XB), WSP(float, WS_SS)};
            pg8::gemm_phase<EpiResB, pg8::StaticOrder, true, true>(lds, gm, S, E);
            slab_gemm<0>(p, lds, WSP(const bf16_t, WS_HID), WSP(const bf16_t, WS_WDN) + (size_t)l * DM * DFF, DFF, DM, nullptr, nullptr, WSP(bf16_t, WS_XB), WSP(float, WS_SS), nullptr);
        }
        GSYNC();
    }
    if (EN & 128) final_norm(p);
}

extern "C" void kernel_launch(void* const* d_in, const int* in_sizes, int n_in, void* d_out, int out_size, void* d_ws, size_t ws_size, hipStream_t stream) {
    static int grid = 0;
    if (grid == 0) {
        if (n_in != 33 || (size_t)out_size != O_END || ws_size < WS_TOTAL) { fprintf(stderr, "kernel_launch: unexpected shapes (n_in %d out %d ws %zu)\n", n_in, out_size, ws_size); grid = -1; return; }
        int dev = 0, cus = 0, per = 0;
        if (hipGetDevice(&dev) != hipSuccess || hipDeviceGetAttribute(&cus, hipDeviceAttributeMultiprocessorCount, dev) != hipSuccess) { grid = -1; return; }
        if (hipFuncSetAttribute((const void*)fwd_kernel, hipFuncAttributeMaxDynamicSharedMemorySize, LDS_BYTES) != hipSuccess) { fprintf(stderr, "kernel_launch: hipFuncSetAttribute failed\n"); grid = -1; return; }
        if (hipOccupancyMaxActiveBlocksPerMultiprocessor(&per, (const void*)fwd_kernel, NTHR, LDS_BYTES) != hipSuccess || per < 1) { fprintf(stderr, "kernel_launch: occupancy query says %d\n", per); per = 1; }
        (void)hipGetLastError();
        grid = cus;
    }
    if (grid < 0) return;
    if (hipMemsetAsync((char*)d_ws + WS_CTL, 0, CTL_BYTES, stream) != hipSuccess) { fprintf(stderr, "kernel_launch: hipMemsetAsync failed\n"); return; }
    Params p{};
    for (int i = 0; i < 33; ++i) p.in[i] = (const float*)d_in[i];
    p.out = (float*)d_out; p.ws = (unsigned char*)d_ws;
    void* args[] = {&p};
    hipError_t e = hipLaunchCooperativeKernel((const void*)fwd_kernel, dim3(grid), dim3(NTHR), args, LDS_BYTES, stream);
    if (e != hipSuccess) fprintf(stderr, "kernel_launch: cooperative launch failed: %s (grid %d)\n", hipGetErrorString(e), grid);
}
```

```cpp
#define NOCG 1
#include <hip/hip_runtime.h>
#include <hip/hip_cooperative_groups.h>
#include <cstdio>
#include <cstdint>
namespace cg = cooperative_groups;
namespace pg8 {
#define PG8_LAS __attribute__((address_space(3)))
typedef unsigned short bf16_t;
typedef short bf16x8 __attribute__((ext_vector_type(8)));
typedef float f32x4 __attribute__((ext_vector_type(4)));
typedef unsigned u32x4 __attribute__((ext_vector_type(4)));
constexpr int BM = 256, BK = 64, HALF = 128, HTB = HALF * BK * 2  , STAGE_BYTES = 8 * HTB, NXCD = 8, WGM = 8;

__host__ __device__ __forceinline__ int lds_byte(int r, int c) { const int st = (r >> 4) * 2 + (c >> 5), rr = r & 15, cc = c & 31, ob = rr * 64 + cc * 2; return st * 1024 + (ob ^ (((ob >> 9) & 1) << 5)); }
__host__ __device__ __forceinline__ void stage_rc(int b, int& R, int& C) { const int st = b / 1024, sb = b % 1024, swz = sb ^ (((sb >> 9) & 1) << 5); R = (st >> 1) * 16 + swz / 64; C = (st & 1) * 32 + (swz % 64) / 2; }
__host__ __device__ __forceinline__ int perm32(int rho) { const int n = rho >> 4, i = rho & 15; return 8 * (i >> 2) + 4 * n + (i & 3); }

struct Unit { int pm, pn; };
struct Gemm { const bf16_t* A; const bf16_t* Bt; int M, N, K; };

struct StaticOrder {
    int nM, nN, nwg, G, c;
    __host__ __device__ void init(int M, int N, int G_, int c_) { nM = M / BM; nN = N / BM; nwg = nM * nN; G = G_; c = c_; }
    __host__ __device__ bool next(int i, Unit& u) const {
        const long L = (long)i * G + c; if (L >= nwg) return false;
        int wgid = (int)L; { const int q = nwg / NXCD, r = nwg % NXCD, xcd = wgid % NXCD, off = wgid / NXCD; wgid = (xcd < r ? xcd * (q + 1) : r * (q + 1) + (xcd - r) * q) + off; }
        const int nig = WGM * nN, gid = wgid / nig, fm = gid * WGM, gsz = (nM - fm) < WGM ? (nM - fm) : WGM;
        u.pm = fm + ((wgid % nig) % gsz); u.pn = (wgid % nig) / gsz; return true;
    }
    __device__ __forceinline__ void a_ready(const Unit&) const {}
    __device__ __forceinline__ void done(const Unit&) const {}
};

__device__ __forceinline__ unsigned cvt_pk_bf16(float lo, float hi) { unsigned r; asm volatile("v_cvt_pk_bf16_f32 %0, %1, %2" : "=v"(r) : "v"(lo), "v"(hi)); return r; }
typedef float f32x2 __attribute__((ext_vector_type(2)));
template <class Epi, class Sched, bool ALIGN_EPI = false, bool SP2 = false>
__device__ __forceinline__ void gemm_phase(PG8_LAS unsigned char* lds, const Gemm g, const Sched& S, const Epi& E) {
    int tid_ = threadIdx.x; asm volatile("" : "+v"(tid_));
    const int tid = tid_, wid = __builtin_amdgcn_readfirstlane(tid >> 6), lane = tid & 63, wr = wid >> 2, wc = wid & 3, fr = lane & 15, fq = lane >> 4;
    const int K = g.K, nt = K / BK;
    unsigned voffA[2], voffB[2];
#pragma unroll
    for (int i = 0; i < 2; ++i) { int R, C; stage_rc(tid * 16 + i * 8192, R, C); const int Rb = Epi::PERM ? ((R & ~31) + perm32(R & 31)) : R;
        voffA[i] = (unsigned)(R * K + C) * 2u; voffB[i] = (unsigned)(Rb * K + C) * 2u; }
    const size_t kstep = (size_t)(BK * 2);
    const size_t hstep = (size_t)HALF * K * 2;
    const size_t tstep = 2 * hstep;
    const unsigned ldsw = (unsigned)wid * 1024u;
    const int aoff = lds_byte(wr * 64 + fr, fq * 8), boff = lds_byte(wc * 32 + fr, fq * 8);
#define PG8_SA(b, h) (((b) * 2 + (h)) * HTB)
#define PG8_SB(b, h) ((4 + (b) * 2 + (h)) * HTB)
#define PG8_STAGE(bufoff, gbase, voff) do { _Pragma("unroll") for (int _i = 0; _i < 2; ++_i) \
        __builtin_amdgcn_global_load_lds((const unsigned*)((const char*)(gbase) + (voff)[_i]), (PG8_LAS unsigned*)(lds + (bufoff) + ldsw + _i * 8192), 16, 0, 0); } while (0)
#define PG8_LDA(dst, b, h) do { _Pragma("unroll") for (int m = 0; m < 4; ++m) _Pragma("unroll") for (int k = 0; k < 2; ++k) dst[m][k] = *(const PG8_LAS bf16x8*)(lds + PG8_SA(b, h) + aoff + m * 2048 + k * 1024); } while (0)
#define PG8_LDB(dst, b, h) do { _Pragma("unroll") for (int n = 0; n < 2; ++n) _Pragma("unroll") for (int k = 0; k < 2; ++k) dst[n][k] = *(const PG8_LAS bf16x8*)(lds + PG8_SB(b, h) + boff + n * 2048 + k * 1024); } while (0)
#define PG8_MMA(ai, bj, At, Bt) do { __builtin_amdgcn_s_setprio(1); _Pragma("unroll") for (int m = 0; m < 4; ++m) _Pragma("unroll") for (int n = 0; n < 2; ++n) _Pragma("unroll") for (int k = 0; k < 2; ++k) \
        acc[ai][bj][m][n] = __builtin_amdgcn_mfma_f32_16x16x32_bf16(Bt[n][k], At[m][k], acc[ai][bj][m][n], 0, 0, 0); __builtin_amdgcn_s_setprio(0); } while (0)
#define PG8_WAIT_V(n) asm volatile("s_waitcnt vmcnt(" #n ")" ::: "memory")
#define PG8_WAIT_L(n) asm volatile("s_waitcnt lgkmcnt(" #n ")" ::: "memory")
#define PG8_BAR __builtin_amdgcn_s_barrier()
#define PG8_SCHED __builtin_amdgcn_sched_barrier(0)
    Unit cur, nxt; int ui = 0;
    if (!S.next(0, cur)) return;
    f32x4 acc[2][2][4][2];
#pragma unroll
    for (int a = 0; a < 2; ++a)
#pragma unroll
        for (int b = 0; b < 2; ++b)
#pragma unroll
            for (int m = 0; m < 4; ++m)
#pragma unroll
                for (int n = 0; n < 2; ++n) acc[a][b][m][n] = (f32x4){0.f, 0.f, 0.f, 0.f};
    bf16x8 At[4][2], B0[2][2], B1[2][2];
    const char* cA = (const char*)g.A + (size_t)cur.pm * tstep; const char* cB = (const char*)g.Bt + (size_t)cur.pn * tstep;
    S.a_ready(cur);
    if constexpr (SP2) {
        PG8_STAGE(PG8_SB(0, 0), cB, voffB); PG8_STAGE(PG8_SB(0, 1), cB + hstep, voffB); PG8_STAGE(PG8_SA(0, 0), cA, voffA); PG8_STAGE(PG8_SA(0, 1), cA + hstep, voffA);
        if (wr == 1) PG8_BAR;
        PG8_WAIT_V(2); PG8_BAR;
        PG8_STAGE(PG8_SB(1, 0), cB + kstep, voffB); PG8_STAGE(PG8_SA(1, 0), cA + kstep, voffA); PG8_STAGE(PG8_SB(1, 1), cB + hstep + kstep, voffB);
        PG8_WAIT_V(6); PG8_BAR;
    } else {
        PG8_STAGE(PG8_SB(0, 0), cB, voffB); PG8_STAGE(PG8_SA(0, 0), cA, voffA); PG8_STAGE(PG8_SB(0, 1), cB + hstep, voffB); PG8_STAGE(PG8_SA(0, 1), cA + hstep, voffA);
        if (wr == 1) PG8_BAR;
        PG8_WAIT_V(4); PG8_BAR;
        PG8_STAGE(PG8_SB(1, 0), cB + kstep, voffB); PG8_STAGE(PG8_SA(1, 0), cA + kstep, voffA); PG8_STAGE(PG8_SB(1, 1), cB + hstep + kstep, voffB);
        PG8_WAIT_V(6); PG8_BAR;
    }
    for (;;) {
        const bool has_next = S.next(ui + 1, nxt);
        const char* nA = has_next ? (const char*)g.A + (size_t)nxt.pm * tstep : cA; const char* nB = has_next ? (const char*)g.Bt + (size_t)nxt.pn * tstep : cB;
        for (int t = 0; t < nt; t += 2) {
            const bool last = (t == nt - 2);
            const char* a1 = cA + (size_t)(t + 1) * kstep;
            const char* a2 = last ? nA : cA + (size_t)(t + 2) * kstep; const char* b2 = last ? nB : cB + (size_t)(t + 2) * kstep;
            const char* a3 = a2 + kstep; const char* b3 = b2 + kstep;
            if (last && has_next) S.a_ready(nxt);
            if constexpr (SP2) {
            PG8_LDB(B0, 0, 0); PG8_LDB(B1, 0, 1); PG8_SCHED; PG8_LDA(At, 0, 0); PG8_STAGE(PG8_SA(1, 1), a1 + hstep, voffA);
            PG8_WAIT_V(8); PG8_WAIT_L(0); PG8_BAR; PG8_MMA(0, 0, At, B0); PG8_MMA(0, 1, At, B1); PG8_BAR; PG8_SCHED;
            PG8_LDA(At, 0, 1); PG8_STAGE(PG8_SB(0, 0), b2, voffB); PG8_STAGE(PG8_SB(0, 1), b2 + hstep, voffB); PG8_STAGE(PG8_SA(0, 0), a2, voffA);
            PG8_WAIT_V(8); PG8_WAIT_L(0); PG8_BAR; PG8_MMA(1, 0, At, B0); PG8_MMA(1, 1, At, B1); PG8_BAR; PG8_SCHED;
            PG8_LDB(B0, 1, 0); PG8_LDB(B1, 1, 1); PG8_SCHED; PG8_LDA(At, 1, 0); PG8_STAGE(PG8_SA(0, 1), a2 + hstep, voffA);
            PG8_WAIT_V(8); PG8_WAIT_L(0); PG8_BAR; PG8_MMA(0, 0, At, B0); PG8_MMA(0, 1, At, B1); PG8_BAR; PG8_SCHED;
            PG8_LDA(At, 1, 1); PG8_STAGE(PG8_SB(1, 0), b3, voffB); PG8_STAGE(PG8_SB(1, 1), b3 + hstep, voffB); PG8_STAGE(PG8_SA(1, 0), a3, voffA);
            PG8_WAIT_V(8); PG8_WAIT_L(0); PG8_BAR; PG8_MMA(1, 0, At, B0); PG8_MMA(1, 1, At, B1); PG8_BAR; PG8_SCHED;
            } else {
            PG8_LDB(B0, 0, 0); PG8_SCHED; PG8_LDA(At, 0, 0); PG8_STAGE(PG8_SA(1, 1), a1 + hstep, voffA);
            PG8_WAIT_L(8); PG8_BAR; PG8_WAIT_L(0); PG8_MMA(0, 0, At, B0); PG8_BAR; PG8_SCHED;
            PG8_LDB(B1, 0, 1); PG8_STAGE(PG8_SB(0, 0), b2, voffB);
            PG8_BAR; PG8_WAIT_L(0); PG8_MMA(0, 1, At, B1); PG8_BAR;
            PG8_LDA(At, 0, 1); PG8_STAGE(PG8_SA(0, 0), a2, voffA);
            PG8_BAR; PG8_WAIT_L(0); PG8_MMA(1, 0, At, B0); PG8_BAR; PG8_SCHED;
            PG8_STAGE(PG8_SB(0, 1), b2 + hstep, voffB);
            PG8_WAIT_V(6); PG8_BAR; PG8_MMA(1, 1, At, B1); PG8_BAR;
            PG8_LDB(B0, 1, 0); PG8_SCHED; PG8_LDA(At, 1, 0); PG8_STAGE(PG8_SA(0, 1), a2 + hstep, voffA);
            PG8_WAIT_L(8); PG8_BAR; PG8_WAIT_L(0); PG8_MMA(0, 0, At, B0); PG8_BAR; PG8_SCHED;
            PG8_LDB(B1, 1, 1); PG8_STAGE(PG8_SB(1, 0), b3, voffB);
            PG8_BAR; PG8_WAIT_L(0); PG8_MMA(0, 1, At, B1); PG8_BAR;
            PG8_LDA(At, 1, 1); PG8_STAGE(PG8_SA(1, 0), a3, voffA);
            PG8_BAR; PG8_WAIT_L(0); PG8_MMA(1, 0, At, B0); PG8_BAR; PG8_SCHED;
            PG8_STAGE(PG8_SB(1, 1), b3 + hstep, voffB);
            PG8_WAIT_V(6); PG8_BAR; PG8_MMA(1, 1, At, B1); PG8_BAR;
            }
        }
        if constexpr (ALIGN_EPI) { if (wr == 0) PG8_BAR; }
        if constexpr (!Epi::AFTER_DRAIN) { E(acc, cur, wr, wc, fr, fq); S.done(cur); }
        if (!has_next) break;
#pragma unroll
        for (int a = 0; a < 2; ++a)
#pragma unroll
            for (int b = 0; b < 2; ++b)
#pragma unroll
                for (int m = 0; m < 4; ++m)
#pragma unroll
                    for (int n = 0; n < 2; ++n) acc[a][b][m][n] = (f32x4){0.f, 0.f, 0.f, 0.f};
        cur = nxt; cA = nA; cB = nB; ++ui;
        if constexpr (ALIGN_EPI) { if (wr == 1) PG8_BAR; }
    }
    PG8_WAIT_V(0);
    if constexpr (!ALIGN_EPI) { if (wr == 0) PG8_BAR; }
    PG8_BAR;
    if constexpr (Epi::AFTER_DRAIN) { E.fused(acc, cur, wr, wc, fr, fq, lds, wid, lane); S.done(cur); }
#undef PG8_SA
#undef PG8_SB
#undef PG8_STAGE
#undef PG8_LDA
#undef PG8_LDB
#undef PG8_MMA
#undef PG8_WAIT_V
#undef PG8_WAIT_L
#undef PG8_BAR
#undef PG8_SCHED
}
}

using pg8::bf16_t; using pg8::bf16x8; using pg8::f32x4; using pg8::u32x4; using pg8::cvt_pk_bf16;
typedef short bf16x4 __attribute__((ext_vector_type(4)));
typedef unsigned u32x2 __attribute__((ext_vector_type(2)));
#define LAS __attribute__((address_space(3)))

constexpr int DM = 1024, NB = 16, SEQ = 4096, DEPTH = 2, SB = 8, SS = 16;
constexpr int MP = NB * SEQ, MS = SB * SS, MREAL = MP + MS, MPAD = 65792;
constexpr int DIN = 1536, DFF = 4096, NPOS = SEQ + SS;
constexpr float EPS = 1e-6f;
constexpr int NTHR = 512, NWAVES = 8;
constexpr int LDS_BYTES = 147456 + 512, L_MISC = 147456, L_PTAB = 147456 + 64;

constexpr size_t O_Y = 0;
constexpr size_t O_CONVP = (size_t)MREAL * DM;
constexpr size_t O_LRUP = O_CONVP + (size_t)DEPTH * NB * 3 * 256;
constexpr size_t O_SREP = O_LRUP + (size_t)DEPTH * NB * 256;
constexpr size_t O_SIMP = O_SREP + (size_t)DEPTH * NB * 1024;
constexpr size_t O_KP = O_SIMP + (size_t)DEPTH * NB * 1024;
constexpr size_t O_VP = O_KP + (size_t)DEPTH * NB * 128 * 128;
constexpr size_t O_CONVS = O_VP + (size_t)DEPTH * NB * 128 * 128;
constexpr size_t O_LRUS = O_CONVS + (size_t)DEPTH * SB * 3 * 256;
constexpr size_t O_SRES = O_LRUS + (size_t)DEPTH * SB * 256;
constexpr size_t O_SIMS = O_SRES + (size_t)DEPTH * SB * 1024;
constexpr size_t O_KS = O_SIMS + (size_t)DEPTH * SB * 1024;
constexpr size_t O_VS = O_KS + (size_t)DEPTH * SB * 16 * 128;
constexpr size_t O_END = O_VS + (size_t)DEPTH * SB * 16 * 128;
static_assert(O_END == 68501504, "d_out map");

constexpr size_t WS_WIN = 0;
constexpr size_t WS_WOUT = WS_WIN + (size_t)DEPTH * DIN * DM * 2;
constexpr size_t WS_WUP = WS_WOUT + (size_t)DEPTH * DM * DM * 2;
constexpr size_t WS_WDN = WS_WUP + (size_t)DEPTH * DFF * DM * 2;
constexpr size_t WS_ROPE = WS_WDN + (size_t)DEPTH * DM * DFF * 2;
constexpr size_t WS_GATE = WS_ROPE + (size_t)NPOS * 32 * 8;
constexpr size_t WS_SP = WS_GATE + (size_t)DEPTH * 2 * 4 * 64 * 64 * 2;
constexpr size_t WS_ABAR = WS_SP + (size_t)DEPTH * 256 * 4;
constexpr size_t WS_BBM = WS_ABAR + (size_t)DEPTH * 16 * 64 * 4 * 4;
constexpr size_t WS_CMT = WS_BBM + (size_t)DEPTH * 16 * 128 * 16 * 2;
constexpr size_t WS_WGT = WS_CMT + (size_t)DEPTH * 16 * 16 * 128 * 2;
constexpr size_t WS_KBS = WS_WGT + (size_t)DEPTH * 256 * 256 * 2;
constexpr size_t WS_VTS = WS_KBS + (size_t)DEPTH * SB * 144 * 128 * 2;
constexpr size_t WS_SMALL = WS_VTS + (size_t)DEPTH * SB * 128 * 144 * 2;
constexpr int SM_CCONV = 0, SM_SLRU = SM_CCONV + DEPTH * SB * 3 * 256, SM_SSRE = SM_SLRU + DEPTH * SB * 256, SM_SSIM = SM_SSRE + DEPTH * SB * 1024, SM_CW = SM_SSIM + DEPTH * SB * 1024,
              SM_CB = SM_CW + DEPTH * 4 * 256, SM_BRG = SM_CB + DEPTH * 256, SM_BIG = SM_BRG + DEPTH * 256, SM_SD = SM_BIG + DEPTH * 256, SM_BGLU = SM_SD + DEPTH * 256,
              SM_SINK = SM_BGLU + DEPTH * 256, SM_NF = SM_SINK + 64, SM_END = SM_NF + DM;
constexpr size_t WS_SS = WS_SMALL + (size_t)((SM_END * 4 + 255) / 256) * 256;
constexpr size_t WS_SUMA = WS_SS + (size_t)MPAD * 16 * 4;
constexpr size_t WS_SUMB = WS_SUMA + (size_t)NB * 64 * 256 * 4;
constexpr size_t WS_SUMS = WS_SUMB + (size_t)NB * 64 * 256 * 4;
constexpr size_t WS_FOLD = WS_SUMS + (size_t)NB * 64 * 16 * 128 * 4;
constexpr size_t WS_XB = WS_FOLD + (size_t)320 * 16 * 128 * 4;
constexpr size_t WS_XRES = WS_XB + (size_t)MPAD * DM * 2;
constexpr size_t WS_BIG = WS_XRES + (size_t)MPAD * DM * 4;
constexpr size_t WS_UA = WS_BIG;
constexpr size_t WS_GA = WS_UA + (size_t)MPAD * 256 * 2;
constexpr size_t WS_UB = WS_GA + (size_t)MPAD * 256 * 2;
constexpr size_t WS_Q = WS_UB + (size_t)MPAD * 256 * 2;
constexpr size_t WS_KBP = WS_Q + (size_t)MPAD * 512 * 2;
constexpr size_t WS_VTP = WS_KBP + (size_t)MP * 128 * 2;
constexpr size_t WS_MIX = WS_VTP + (size_t)NB * 128 * SEQ * 2;
constexpr size_t WS_MIXEND = WS_MIX + (size_t)MPAD * DM * 2;
constexpr size_t WS_HID = WS_BIG;
constexpr size_t WS_END = WS_BIG + (size_t)MPAD * DFF * 2;
constexpr size_t WS_CTL = WS_END, CTL_BYTES = 16384;
constexpr size_t WS_TOTAL = WS_CTL + CTL_BYTES;
static_assert(WS_MIXEND <= WS_END && WS_TOTAL <= (size_t)1 << 30, "d_ws map");

struct Params { const float* in[33]; float* out; unsigned char* ws; };
enum { I_XP = 0, I_XS, I_CCONV, I_SLRU, I_SSRE, I_SSIM, I_CK, I_CV, I_N1, I_WIN, I_CW, I_CB, I_WRG, I_BRG, I_WIG, I_BIG_, I_LAM,
       I_ARE, I_AIM, I_BRE, I_BIM, I_CRE, I_CIM, I_SD, I_LDT, I_WGLU, I_BGLU, I_SINK, I_WOUT, I_N2, I_WUP, I_WDN, I_NF };

__device__ __forceinline__ float bf2f(short v) { return __uint_as_float(((unsigned)(unsigned short)v) << 16); }
__device__ __forceinline__ bf16_t f2bf(float v) { return (bf16_t)(cvt_pk_bf16(v, 0.f) & 0xffffu); }
__device__ __forceinline__ float sigmoidf_(float x) { return __builtin_amdgcn_rcpf(1.f + __expf(-x)); }
__device__ __forceinline__ float gelu_tanh(float x) { const float u = 1.5957691216f * (x + 0.044715f * x * x * x); return x * __builtin_amdgcn_rcpf(1.f + __expf(-u)); }
__device__ __forceinline__ f32x4 mma16(bf16x8 x, bf16x8 y, f32x4 acc) { return __builtin_amdgcn_mfma_f32_16x16x32_bf16(x, y, acc, 0, 0, 0); }
__device__ __forceinline__ float wave_sum(float v) {
#pragma unroll
    for (int o = 1; o < 64; o <<= 1) v += __shfl_xor(v, o);
    return v;
}
__device__ __forceinline__ void store8(bf16_t* dst, const float (&v)[8]) {
    u32x4 w; w.x = cvt_pk_bf16(v[0], v[1]); w.y = cvt_pk_bf16(v[2], v[3]); w.z = cvt_pk_bf16(v[4], v[5]); w.w = cvt_pk_bf16(v[6], v[7]);
    *(u32x4*)dst = w;
}
__device__ __forceinline__ float ss_rs(const float* ss, int row) {
    const f32x4* s4 = (const f32x4*)(ss + (size_t)row * 16);
    const f32x4 a = s4[0], b = s4[1], c = s4[2], d = s4[3];
    const float tot = (((a[0] + a[1]) + (a[2] + a[3])) + ((b[0] + b[1]) + (b[2] + b[3]))) + (((c[0] + c[1]) + (c[2] + c[3])) + ((d[0] + d[1]) + (d[2] + d[3])));
    return __builtin_amdgcn_rsqf(tot * (1.f / 1024.f) + EPS);
}
__device__ __forceinline__ void rope8(float (&v)[8], const float* rope, int pos, int jp) {
    const f32x4* r = (const f32x4*)(rope + ((size_t)pos * 32 + jp) * 2);
    const f32x4 a = r[0], b = r[1];
    float x1, x2;
    x1 = v[0]; x2 = v[1]; v[0] = x1 * a[0] - x2 * a[1]; v[1] = x2 * a[0] + x1 * a[1];
    x1 = v[2]; x2 = v[3]; v[2] = x1 * a[2] - x2 * a[3]; v[3] = x2 * a[2] + x1 * a[3];
    x1 = v[4]; x2 = v[5]; v[4] = x1 * b[0] - x2 * b[1]; v[5] = x2 * b[0] + x1 * b[1];
    x1 = v[6]; x2 = v[7]; v[6] = x1 * b[2] - x2 * b[3]; v[7] = x2 * b[2] + x1 * b[3];
}

__device__ __forceinline__ void rs8(float (&rsv)[2][4], const float* ss, int rowbase, int fq) {
    f32x4 part[2][4];
#pragma unroll
    for (int ai = 0; ai < 2; ++ai)
#pragma unroll
        for (int m = 0; m < 4; ++m) { const int row = rowbase + ai * 128 + m * 16;
            part[ai][m] = (f32x4){0.f, 0.f, 0.f, 0.f};
            if (row < MREAL) part[ai][m] = *(const f32x4*)(ss + (size_t)row * 16 + 4 * fq); }
#pragma unroll
    for (int ai = 0; ai < 2; ++ai)
#pragma unroll
        for (int m = 0; m < 4; ++m) { float t = (part[ai][m][0] + part[ai][m][1]) + (part[ai][m][2] + part[ai][m][3]);
            t += __shfl_xor(t, 16); t += __shfl_xor(t, 32);
            rsv[ai][m] = __builtin_amdgcn_rsqf(t * (1.f / 1024.f) + EPS); }
}

struct EpiIn {
    static constexpr bool PERM = true, AFTER_DRAIN = false;
    unsigned char* ws; float* out; int l;
    __device__ __forceinline__ void operator()(const f32x4 (&acc)[2][2][4][2], const pg8::Unit& u, int wr, int wc, int fr, int fq) const {
        asm volatile("" : "+v"(fr), "+v"(fq)); asm volatile("" : "+s"(wr), "+s"(wc));
        const int pn = u.pn;
        const float* ss = (const float*)(ws + WS_SS); const float* rope = (const float*)(ws + WS_ROPE);
        bf16_t* ua = (bf16_t*)(ws + WS_UA); bf16_t* ga = (bf16_t*)(ws + WS_GA); bf16_t* ub = (bf16_t*)(ws + WS_UB); bf16_t* q = (bf16_t*)(ws + WS_Q);
        bf16_t* kbp = (bf16_t*)(ws + WS_KBP); bf16_t* vtp = (bf16_t*)(ws + WS_VTP);
        bf16_t* kbs = (bf16_t*)(ws + WS_KBS) + (size_t)l * SB * 144 * 128; bf16_t* vts = (bf16_t*)(ws + WS_VTS) + (size_t)l * SB * 128 * 144;
        float* conv_p = out + O_CONVP + (size_t)l * NB * 3 * 256; float* conv_s = out + O_CONVS + (size_t)l * SB * 3 * 256;
        float* k_p = out + O_KP + (size_t)l * NB * 128 * 128; float* v_p = out + O_VP + (size_t)l * NB * 128 * 128;
        float* k_s = out + O_KS + (size_t)l * SB * 16 * 128; float* v_s = out + O_VS + (size_t)l * SB * 16 * 128;
        float rsv[2][4]; rs8(rsv, ss, u.pm * 256 + wr * 64 + fr, fq);
#pragma unroll
        for (int bjo = 0; bjo < 2; ++bjo) {
#pragma unroll
        for (int ai = 0; ai < 2; ++ai)
#pragma unroll
            for (int m = 0; m < 4; ++m) {
                const int row = u.pm * 256 + ai * 128 + wr * 64 + m * 16 + fr;
                if (row < MREAL) {
                    const float rs = rsv[ai][m];
                    const bool smp = row >= MP;
                    const int b = smp ? (row - MP) >> 4 : row >> 12, t = smp ? (row - MP) & 15 : row & 4095, pos = smp ? SEQ + t : t;
#pragma unroll
                    for (int bj = bjo; bj < bjo + 1; ++bj) {
                        const int c0 = bj * 128 + wc * 32 + fq * 8;
                        float v[8];
#pragma unroll
                        for (int e = 0; e < 4; ++e) { v[e] = acc[ai][bj][m][0][e] * rs; v[4 + e] = acc[ai][bj][m][1][e] * rs; }
                        if (pn <= 2) {
                            bf16_t* dst = (pn == 0 ? ua : (pn == 1 ? ga : ub)) + (size_t)row * 256 + c0;
                            store8(dst, v);
                            if (pn == 0) {
                                const int tt = smp ? t - (SS - 3) : t - (SEQ - 3);
                                if (tt >= 0) { float* o = (smp ? conv_s : conv_p) + (size_t)(b * 3 + tt) * 256 + c0;
                                    *(f32x4*)o = (f32x4){v[0], v[1], v[2], v[3]}; *(f32x4*)(o + 4) = (f32x4){v[4], v[5], v[6], v[7]}; }
                            }
                        } else if (pn <= 4) {
                            rope8(v, rope, pos, (c0 & 63) >> 1);
#pragma unroll
                            for (int e = 0; e < 8; ++e) v[e] *= 0.125f;
                            store8(q + (size_t)row * 512 + (pn - 3) * 256 + c0, v);
                        } else if (bj == 0) {
                            const int kvh = c0 >> 6, jp = (c0 & 63) >> 1;
                            rope8(v, rope, pos, jp);
                            bf16_t* dst = smp ? kbs + (size_t)(b * 144 + 128 + t) * 128 + c0 : kbp + (size_t)row * 128 + c0;
                            store8(dst, v);
                            const int tt = smp ? t : t - (SEQ - 128);
                            if (tt >= 0) { float* o = (smp ? k_s + ((size_t)(b * SS + tt) * 2 + kvh) * 64 : k_p + ((size_t)(b * 128 + tt) * 2 + kvh) * 64) + jp;
                                *(f32x4*)o = (f32x4){v[0], v[2], v[4], v[6]}; *(f32x4*)(o + 32) = (f32x4){v[1], v[3], v[5], v[7]}; }
                        } else {
                            const int cv = c0 - 128, kvh = cv >> 6, d0 = cv & 63;
                            if (!smp) { bf16_t* dst = vtp + (size_t)(b * 128 + cv) * SEQ + t;
#pragma unroll
                                for (int e = 0; e < 8; ++e) dst[(size_t)e * SEQ] = f2bf(v[e]);
                            } else { bf16_t* dst = vts + (size_t)(b * 128 + cv) * 144 + 128 + t;
#pragma unroll
                                for (int e = 0; e < 8; ++e) dst[e * 144] = f2bf(v[e]); }
                            const int tt = smp ? t : t - (SEQ - 128);
                            if (tt >= 0) { float* o = (smp ? v_s + ((size_t)(b * SS + tt) * 2 + kvh) * 64 : v_p + ((size_t)(b * 128 + tt) * 2 + kvh) * 64) + d0;
                                *(f32x4*)o = (f32x4){v[0], v[1], v[2], v[3]}; *(f32x4*)(o + 4) = (f32x4){v[4], v[5], v[6], v[7]}; }
                        }
                    }
                }
            }
        asm volatile("" ::: "memory");
        }
    }
};

struct EpiRes {
    static constexpr bool PERM = true, AFTER_DRAIN = false;
    const __attribute__((address_space(1))) float *xin_p, *xin_s;
    float *xout_p, *xout_s; bf16_t* xb; float* ss;
    __device__ __forceinline__ void operator()(const f32x4 (&acc)[2][2][4][2], const pg8::Unit& u, int wr, int wc, int fr, int fq) const {
        asm volatile("" : "+v"(fr), "+v"(fq)); asm volatile("" : "+s"(wr), "+s"(wc));
        const int pn = u.pn;
#pragma unroll
        for (int ai = 0; ai < 2; ++ai)
#pragma unroll
            for (int m = 0; m < 4; ++m) {
                const int row = u.pm * 256 + ai * 128 + wr * 64 + m * 16 + fr;
                const bool valid = row < MREAL;
                float sq = 0.f;
                if (valid) {
                    const size_t ro = row < MP ? (size_t)row * DM : (size_t)(row - MP) * DM;
                    const __attribute__((address_space(1))) float* xi = (row < MP ? xin_p : xin_s) + ro; float* xo = (row < MP ? xout_p : xout_s) + ro;
#pragma unroll
                    for (int bj = 0; bj < 2; ++bj) {
                        const int c = pn * 256 + bj * 128 + wc * 32 + fq * 8;
                        const f32x4 a0 = *(const __attribute__((address_space(1))) f32x4*)(xi + c) + acc[ai][bj][m][0], a1 = *(const __attribute__((address_space(1))) f32x4*)(xi + c + 4) + acc[ai][bj][m][1];
                        if (xout_p) { *(f32x4*)(xo + c) = a0; *(f32x4*)(xo + c + 4) = a1; }
                        sq += ((a0[0] * a0[0] + a0[1] * a0[1]) + (a0[2] * a0[2] + a0[3] * a0[3])) + ((a1[0] * a1[0] + a1[1] * a1[1]) + (a1[2] * a1[2] + a1[3] * a1[3]));
                        if (xb) { u32x4 w; w.x = cvt_pk_bf16(a0[0], a0[1]); w.y = cvt_pk_bf16(a0[2], a0[3]); w.z = cvt_pk_bf16(a1[0], a1[1]); w.w = cvt_pk_bf16(a1[2], a1[3]);
                            *(u32x4*)(xb + (size_t)row * DM + c) = w; }
                    }
                }
                sq += __shfl_xor(sq, 16); sq += __shfl_xor(sq, 32);
                if (valid && fq == 0) ss[(size_t)row * 16 + pn * 4 + wc] = sq;
            }
    }
};

struct EpiResB {
    static constexpr bool PERM = true, AFTER_DRAIN = false;
    bf16_t* xb; float* ss;
    __device__ __forceinline__ void operator()(const f32x4 (&acc)[2][2][4][2], const pg8::Unit& u, int wr, int wc, int fr, int fq) const {
        asm volatile("" : "+v"(fr), "+v"(fq)); asm volatile("" : "+s"(wr), "+s"(wc));
        const int pn = u.pn;
#pragma unroll
        for (int ai = 0; ai < 2; ++ai)
#pragma unroll
            for (int m = 0; m < 4; ++m) {
                const int row = u.pm * 256 + ai * 128 + wr * 64 + m * 16 + fr;
                const bool valid = row < MREAL;
                float sq = 0.f;
                if (valid) {
#pragma unroll
                    for (int bj = 0; bj < 2; ++bj) {
                        const int c = pn * 256 + bj * 128 + wc * 32 + fq * 8;
                        u32x4* px = (u32x4*)(xb + (size_t)row * DM + c);
                        const u32x4 xw = *px;
                        const f32x4 x0 = {__uint_as_float(xw.x << 16), __uint_as_float(xw.x & 0xffff0000u), __uint_as_float(xw.y << 16), __uint_as_float(xw.y & 0xffff0000u)};
                        const f32x4 x1 = {__uint_as_float(xw.z << 16), __uint_as_float(xw.z & 0xffff0000u), __uint_as_float(xw.w << 16), __uint_as_float(xw.w & 0xffff0000u)};
                        const f32x4 a0 = x0 + acc[ai][bj][m][0], a1 = x1 + acc[ai][bj][m][1];
                        sq += ((a0[0] * a0[0] + a0[1] * a0[1]) + (a0[2] * a0[2] + a0[3] * a0[3])) + ((a1[0] * a1[0] + a1[1] * a1[1]) + (a1[2] * a1[2] + a1[3] * a1[3]));
                        u32x4 w; w.x = cvt_pk_bf16(a0[0], a0[1]); w.y = cvt_pk_bf16(a0[2], a0[3]); w.z = cvt_pk_bf16(a1[0], a1[1]); w.w = cvt_pk_bf16(a1[2], a1[3]);
                        *px = w;
                    }
                }
                sq += __shfl_xor(sq, 16); sq += __shfl_xor(sq, 32);
                if (valid && fq == 0) ss[(size_t)row * 16 + pn * 4 + wc] = sq;
            }
    }
};

struct EpiUp {
    static constexpr bool PERM = true, AFTER_DRAIN = false;
    const float* ss; bf16_t* hid;
    __device__ __forceinline__ void operator()(const f32x4 (&acc)[2][2][4][2], const pg8::Unit& u, int wr, int wc, int fr, int fq) const {
        asm volatile("" : "+v"(fr), "+v"(fq)); asm volatile("" : "+s"(wr), "+s"(wc));
        float rsv[2][4]; rs8(rsv, ss, u.pm * 256 + wr * 64 + fr, fq);
#pragma unroll
        for (int ai = 0; ai < 2; ++ai)
#pragma unroll
            for (int m = 0; m < 4; ++m) {
                const int row = u.pm * 256 + ai * 128 + wr * 64 + m * 16 + fr;
                if (row < MREAL) {
                    const float rs = rsv[ai][m];
#pragma unroll
                    for (int bj = 0; bj < 2; ++bj) {
                        const int c = u.pn * 256 + bj * 128 + wc * 32 + fq * 8;
                        float v[8];
#pragma unroll
                        for (int e = 0; e < 4; ++e) { float a = fmaxf(acc[ai][bj][m][0][e] * rs, 0.f), b = fmaxf(acc[ai][bj][m][1][e] * rs, 0.f); v[e] = a * a; v[4 + e] = b * b; }
                        store8(hid + (size_t)row * DFF + c, v);
                    }
                }
            }
    }
};

#define WSP(T, off) ((T*)(p.ws + (off)))
#define INP(i) ((const float*)(((const LAS unsigned long long*)(lds + L_PTAB))[i]))
#define LDS_WAIT() asm volatile("s_waitcnt lgkmcnt(0)" ::: "memory")

__device__ __forceinline__ void sincos_d(double x, double& s, double& c) {
    const double TWO_PI = 6.283185307179586476925;
    const double k = rint(x / TWO_PI), r = x - k * TWO_PI, r2 = r * r;
    double ps = 1.0, pc = 1.0;
#pragma unroll
    for (int n = 15; n >= 1; --n) { ps = 1.0 - r2 / ((2.0 * n) * (2.0 * n + 1.0)) * ps; pc = 1.0 - r2 / ((2.0 * n - 1.0) * (2.0 * n)) * pc; }
    s = r * ps; c = pc;
}

template <int MODE>
__device__ __forceinline__ void transpose_item(const float* W, const float* gain, int K, int N, bf16_t* WT, LAS float* scr, int item, int lane) {
    const int nblk = N / 32, kb = item / nblk, nb = item % nblk, k0 = 64 * kb, n0 = 32 * nb;
    float wv[32];
#pragma unroll
    for (int i = 0; i < 32; ++i) wv[i] = W[(size_t)(k0 + 2 * i + (lane >> 5)) * N + n0 + (lane & 31)];
    if (gain) {
#pragma unroll
        for (int i = 0; i < 32; ++i) wv[i] *= gain[k0 + 2 * i + (lane >> 5)];
    }
#pragma unroll
    for (int i = 0; i < 32; ++i) scr[(2 * i + (lane >> 5)) * 33 + (lane & 31)] = wv[i];
    LDS_WAIT();
    const int c = lane & 7;
#pragma unroll
    for (int j = 0; j < 4; ++j) { const int n = (lane >> 3) + 8 * j; const LAS float* s = scr + (8 * c) * 33 + n;
        u32x4 o; o.x = cvt_pk_bf16(s[0 * 33], s[1 * 33]); o.y = cvt_pk_bf16(s[2 * 33], s[3 * 33]); o.z = cvt_pk_bf16(s[4 * 33], s[5 * 33]); o.w = cvt_pk_bf16(s[6 * 33], s[7 * 33]);
        int nn = n0 + n;
        if (MODE == 1 && nn >= 768 && nn < 1408) { const int r = nn - 768, d = r & 63; nn = 768 + (r & ~63) + 2 * (d & 31) + (d >> 5); }
        *(u32x4*)(WT + (size_t)nn * K + k0 + 8 * c) = o; }
    LDS_WAIT();
}

__device__ __forceinline__ void prologue(const Params& p, LAS unsigned char* lds) {
    const int tid = threadIdx.x, lane = tid & 63, wave = tid >> 6;
    const int gw = blockIdx.x * NWAVES + wave, NGW = gridDim.x * NWAVES, gt = blockIdx.x * NTHR + tid, NGT = gridDim.x * NTHR;
    LAS float* scr = (LAS float*)(lds + wave * 16384);
#pragma unroll 1
    for (int ph = 0; ph < 2; ++ph) {
      if (((ph ^ wave) & 1) == 0) {
    constexpr int I_IN = 16 * 48, I_OUT = 16 * 32, I_UP = 16 * 128, I_DN = 64 * 32, I_L = I_IN + I_OUT + I_UP + I_DN;
    for (int it = gw; it < DEPTH * I_L; it += NGW) {
        const int l = it / I_L; int r = it % I_L;
        if (r < I_IN) { transpose_item<1>(INP(I_WIN) + (size_t)l * DM * DIN, INP(I_N1) + l * DM, DM, DIN, WSP(bf16_t, WS_WIN) + (size_t)l * DIN * DM, scr, r, lane); continue; } r -= I_IN;
        if (r < I_OUT) { transpose_item<0>(INP(I_WOUT) + (size_t)l * DM * DM, nullptr, DM, DM, WSP(bf16_t, WS_WOUT) + (size_t)l * DM * DM, scr, r, lane); continue; } r -= I_OUT;
        if (r < I_UP) { transpose_item<0>(INP(I_WUP) + (size_t)l * DM * DFF, INP(I_N2) + l * DM, DM, DFF, WSP(bf16_t, WS_WUP) + (size_t)l * DFF * DM, scr, r, lane); continue; } r -= I_UP;
        transpose_item<0>(INP(I_WDN) + (size_t)l * DFF * DM, nullptr, DFF, DM, WSP(bf16_t, WS_WDN) + (size_t)l * DM * DFF, scr, r, lane);
    }
      } else {
    {
        bf16_t* xb = WSP(bf16_t, WS_XB); float* ss = WSP(float, WS_SS);
        static_assert(MPAD % 4 == 0 && MREAL % 4 == 0 && MP % 4 == 0, "row groups of 4");
#pragma unroll 1
        for (int row0 = gw * 4; row0 < MPAD; row0 += NGW * 4) {
            f32x4 v[4][4];
            if (row0 < MREAL) {
                const float* xbase = row0 < MP ? INP(I_XP) + (size_t)row0 * DM : INP(I_XS) + (size_t)(row0 - MP) * DM;
#pragma unroll
                for (int r = 0; r < 4; ++r)
#pragma unroll
                    for (int j = 0; j < 4; ++j) v[r][j] = ((const f32x4*)(xbase + (size_t)r * DM) + lane)[64 * j];
            } else {
#pragma unroll
                for (int r = 0; r < 4; ++r)
#pragma unroll
                    for (int j = 0; j < 4; ++j) v[r][j] = (f32x4){0.f, 0.f, 0.f, 0.f};
            }
#pragma unroll
            for (int r = 0; r < 4; ++r) {
                float sq = 0.f;
#pragma unroll
                for (int j = 0; j < 4; ++j) sq += (v[r][j][0] * v[r][j][0] + v[r][j][1] * v[r][j][1]) + (v[r][j][2] * v[r][j][2] + v[r][j][3] * v[r][j][3]);
                const float tot = wave_sum(sq);
                unsigned long long* o8 = (unsigned long long*)(xb + (size_t)(row0 + r) * DM) + lane;
#pragma unroll
                for (int j = 0; j < 4; ++j) o8[64 * j] = (unsigned long long)cvt_pk_bf16(v[r][j][0], v[r][j][1]) | ((unsigned long long)cvt_pk_bf16(v[r][j][2], v[r][j][3]) << 32);
                if (lane < 16) ss[(size_t)(row0 + r) * 16 + lane] = lane == 0 ? tot : 0.f;
            }
        }
    }
      }
    }
    { float* sm = WSP(float, WS_SMALL);
#define CPY(I, OFF, N) for (int idx = gt; idx < (N); idx += NGT) sm[(OFF) + idx] = INP(I)[idx];
      CPY(I_CCONV, SM_CCONV, DEPTH * SB * 3 * 256) CPY(I_SLRU, SM_SLRU, DEPTH * SB * 256) CPY(I_SSRE, SM_SSRE, DEPTH * SB * 1024) CPY(I_SSIM, SM_SSIM, DEPTH * SB * 1024)
      CPY(I_CW, SM_CW, DEPTH * 4 * 256) CPY(I_CB, SM_CB, DEPTH * 256) CPY(I_BRG, SM_BRG, DEPTH * 256) CPY(I_BIG_, SM_BIG, DEPTH * 256) CPY(I_SD, SM_SD, DEPTH * 256)
      CPY(I_BGLU, SM_BGLU, DEPTH * 256) CPY(I_SINK, SM_SINK, DEPTH * 8) CPY(I_NF, SM_NF, DM)
#undef CPY
    }
    { float* rope = WSP(float, WS_ROPE);
      for (int idx = gt; idx < NPOS * 32; idx += NGT) { const int pos = idx >> 5, j = idx & 31;
          const float invf = (float)exp(-(double)j * (9.210340371976184 / 32.0)); double s, c; sincos_d((double)pos * (double)invf, s, c);
          rope[2 * idx] = (float)c; rope[2 * idx + 1] = (float)s; } }
    { bf16_t* gate = WSP(bf16_t, WS_GATE);
      for (int idx = gt; idx < DEPTH * 2 * 4 * 64 * 64; idx += NGT) { const int k = idx & 63, n = (idx >> 6) & 63, h = (idx >> 12) & 3, gt_ = (idx >> 14) & 1, l = idx >> 15;
          gate[idx] = f2bf((gt_ ? INP(I_WIG) : INP(I_WRG))[((size_t)(l * 4 + h) * 64 + k) * 64 + n]); } }
    { float* sp = WSP(float, WS_SP);
      for (int idx = gt; idx < DEPTH * 256; idx += NGT) sp[idx] = (float)log1p(exp(-(double)INP(I_LAM)[idx])); }
    { float* abar = WSP(float, WS_ABAR); bf16_t* bbm = WSP(bf16_t, WS_BBM);
      for (int idx = gt; idx < DEPTH * 16 * 64; idx += NGT) { const int lg = idx >> 6, pp = idx & 63;
          const double dt = exp((double)INP(I_LDT)[lg]), lr = (double)INP(I_ARE)[idx], li = (double)INP(I_AIM)[idx], mag = exp(lr * dt);
          double sn, cs; sincos_d(li * dt, sn, cs);
          const double ar = mag * cs, ai = mag * sn, den = lr * lr + li * li, nr = ar - 1.0, fr = (nr * lr + ai * li) / den, fi = (ai * lr - nr * li) / den;
          double xr = ar, xi = ai;
#pragma unroll
          for (int q = 0; q < 6; ++q) { const double t = xr * xr - xi * xi; xi = 2.0 * xr * xi; xr = t; }
          *(f32x4*)(abar + (size_t)idx * 4) = (f32x4){(float)ar, (float)ai, (float)xr, (float)xi};
          for (int c = 0; c < 16; ++c) { const double br = (double)INP(I_BRE)[(size_t)idx * 16 + c], bi = (double)INP(I_BIM)[(size_t)idx * 16 + c];
              bbm[((size_t)lg * 128 + pp) * 16 + c] = f2bf((float)(fr * br - fi * bi)); bbm[((size_t)lg * 128 + 64 + pp) * 16 + c] = f2bf((float)(fr * bi + fi * br)); } } }
    { bf16_t* cmt = WSP(bf16_t, WS_CMT);
      for (int idx = gt; idx < DEPTH * 16 * 16 * 128; idx += NGT) { const int k = idx & 127, lgc = idx >> 7;
          cmt[idx] = f2bf(k < 64 ? INP(I_CRE)[(size_t)lgc * 64 + k] : -INP(I_CIM)[(size_t)lgc * 64 + k - 64]); } }
    { bf16_t* wgt = WSP(bf16_t, WS_WGT);
      for (int idx = gt; idx < DEPTH * 65536; idx += NGT) { const int k = idx & 255, n = (idx >> 8) & 255, l = idx >> 16;
          wgt[idx] = f2bf(INP(I_WGLU)[((size_t)l * 256 + k) * 256 + n]); } }
    { bf16_t* kbs = WSP(bf16_t, WS_KBS); bf16_t* vts = WSP(bf16_t, WS_VTS);
      for (int idx = gt; idx < DEPTH * SB * 128 * 128; idx += NGT) { const int col = idx & 127, i = (idx >> 7) & 127, lb = idx >> 14;
          const int kvh = col >> 6, ph = col & 63, d = (ph >> 1) + 32 * (ph & 1);
          kbs[((size_t)lb * 144 + i) * 128 + col] = f2bf(INP(I_CK)[(((size_t)lb * 128 + i) * 2 + kvh) * 64 + d]);
          vts[((size_t)lb * 128 + col) * 144 + i] = f2bf(INP(I_CV)[((size_t)lb * 128 + i) * 128 + col]); } }
}

constexpr int L_AL = 0, L_BL = 33792;
constexpr int L_BU = 0;
constexpr int L_UA = 67584;
constexpr int L_SL = 67584;
constexpr int L_UZ = 103424;
constexpr int L_PAR = 137216;
constexpr int L_KL = 0, L_VL = 52224;
constexpr int UP = 264;
constexpr int P_CW = 0, P_CB = 1024, P_BRG = 1280, P_BIG = 1536, P_SP = 1792, P_SD = 2048, P_BGLU = 2304;
static_assert(L_PAR + 2560 * 4 <= L_MISC && L_UA + 67 * UP * 2 <= L_UZ && L_UZ + 64 * UP * 2 <= L_PAR && L_VL + 128 * 400 <= L_UZ, "mixer LDS map");

template <int NT, bool SMP>
__device__ __forceinline__ void stage_uab(const Params& p, int l, int b, int c, LAS unsigned char* lds) {
    int tid_ = threadIdx.x; asm volatile("" : "+v"(tid_));
    const int tid = tid_;
    const bf16_t* ua = WSP(const bf16_t, WS_UA); const bf16_t* ub = WSP(const bf16_t, WS_UB);
    const size_t seq0 = SMP ? (size_t)MP + b * SS : (size_t)b * SEQ;
    const int ts0 = SMP ? 0 : c * 64;
    constexpr int NR = NT * 16 + 3, NIA = (NR * 32 + NTHR - 1) / NTHR, NIB = (NT * 16 * 32 + NTHR - 1) / NTHR;
    u32x4 va[NIA], vb[NIB];
#pragma unroll
    for (int i = 0; i < NIA; ++i) { const int idx = tid + i * NTHR, r = idx >> 5, ck = idx & 31, ts = ts0 - 3 + r;
        va[i] = (u32x4){0u, 0u, 0u, 0u};
        if (idx < NR * 32) {
            if (ts >= 0) va[i] = *(const u32x4*)(ua + (seq0 + ts) * 256 + 8 * ck);
            else if (SMP) { const float* h = WSP(const float, WS_SMALL) + SM_CCONV + ((size_t)(l * SB + b) * 3 + (3 + ts)) * 256 + 8 * ck;
                const f32x4 x = *(const f32x4*)h, y = *(const f32x4*)(h + 4);
                va[i] = (u32x4){cvt_pk_bf16(x[0], x[1]), cvt_pk_bf16(x[2], x[3]), cvt_pk_bf16(y[0], y[1]), cvt_pk_bf16(y[2], y[3])}; }
        } }
#pragma unroll
    for (int i = 0; i < NIB; ++i) { const int idx = tid + i * NTHR, t = idx >> 5, ck = idx & 31;
        vb[i] = (u32x4){0u, 0u, 0u, 0u};
        if (idx < NT * 16 * 32) vb[i] = *(const u32x4*)(ub + (seq0 + ts0 + t) * 256 + 8 * ck); }
#pragma unroll
    for (int i = 0; i < NIA; ++i) { const int idx = tid + i * NTHR, r = idx >> 5, ck = idx & 31;
        if (idx < NR * 32) *(LAS u32x4*)(lds + L_UA + r * (UP * 2) + ck * 16) = va[i]; }
#pragma unroll
    for (int i = 0; i < NIB; ++i) { const int idx = tid + i * NTHR, t = idx >> 5, ck = idx & 31;
        if (idx < NT * 16 * 32) *(LAS u32x4*)(lds + L_UZ + t * (UP * 2) + ck * 16) = vb[i]; }
}

template <int NV>
__device__ __forceinline__ void conv_lds(float (&xc)[NV], const LAS bf16_t* uaL, const LAS float* par, int tl, int ch) {
#pragma unroll
    for (int e = 0; e < NV; e += 4) { const f32x4 cb = *(const LAS f32x4*)(par + P_CB + ch + e); xc[e] = cb[0]; xc[e + 1] = cb[1]; xc[e + 2] = cb[2]; xc[e + 3] = cb[3]; }
#pragma unroll
    for (int j = 0; j < 4; ++j) {
        float w[NV];
#pragma unroll
        for (int e = 0; e < NV; e += 4) { const f32x4 cw = *(const LAS f32x4*)(par + P_CW + j * 256 + ch + e); w[e] = cw[0]; w[e + 1] = cw[1]; w[e + 2] = cw[2]; w[e + 3] = cw[3]; }
        const LAS bf16_t* src = uaL + (tl + j) * UP + ch;
        if constexpr (NV == 8) { const bf16x8 v = *(const LAS bf16x8*)src;
#pragma unroll
            for (int e = 0; e < 8; ++e) xc[e] += bf2f(v[e]) * w[e];
        } else { const bf16x4 v = *(const LAS bf16x4*)src;
#pragma unroll
            for (int e = 0; e < 4; ++e) xc[e] += bf2f(v[e]) * w[e]; }
    }
}

template <int NT, bool SMP>
__device__ __forceinline__ void lru_item(const Params& p, int l, int b, int c, int pass, LAS unsigned char* lds, float& hfold, int cprev) {
    constexpr int HT = NT >= 2 ? 2 : 1, NH = NT / HT, TS = HT * 16 + 1, NPF = HT * 16 * 128 / NTHR;
    LAS float* aL = (LAS float*)(lds + L_AL); LAS float* bL = (LAS float*)(lds + L_BL);
    const LAS bf16_t* uaL = (const LAS bf16_t*)(lds + L_UA); const LAS float* par = (const LAS float*)(lds + L_PAR);
    int tid_ = threadIdx.x; asm volatile("" : "+v"(tid_));
    const int tid = tid_, wid = __builtin_amdgcn_readfirstlane(tid >> 6), lane = tid & 63, l15 = lane & 15, g = lane >> 4, h = wid >> 1, nh = wid & 1;
    const bf16_t* ga = WSP(const bf16_t, WS_GA); bf16_t* mix = WSP(bf16_t, WS_MIX);
    const size_t row0 = SMP ? (size_t)MP + b * SS : (size_t)b * SEQ + c * 64;
    const bf16_t* gwt = WSP(const bf16_t, WS_GATE) + (size_t)l * 2 * 4 * 4096;
    bf16x8 xr[2][2], xi[2][2];
#pragma unroll
    for (int nt2 = 0; nt2 < 2; ++nt2)
#pragma unroll
        for (int ks = 0; ks < 2; ++ks) { const int n = 32 * nh + 16 * nt2 + l15;
            xr[nt2][ks] = *(const bf16x8*)(gwt + ((size_t)(0 * 4 + h) * 64 + n) * 64 + 32 * ks + 8 * g);
            xi[nt2][ks] = *(const bf16x8*)(gwt + ((size_t)(1 * 4 + h) * 64 + n) * 64 + 32 * ks + 8 * g); }
    float fA[16], fB[16], hsm = 0.f;
#pragma unroll
    for (int i = 0; i < 16; ++i) { fA[i] = 1.f; fB[i] = 0.f; }
    if (tid < 256) {
        if (SMP) hsm = WSP(const float, WS_SMALL)[SM_SLRU + (size_t)(l * SB + b) * 256 + tid];
        else if (pass == 1) {
            const float* sA = WSP(const float, WS_SUMA) + (size_t)b * 64 * 256 + tid; const float* sB = WSP(const float, WS_SUMB) + (size_t)b * 64 * 256 + tid;
#pragma unroll
            for (int i = 0; i < 16; ++i) { const int cc = cprev + i < 63 ? cprev + i : 63; fA[i] = sA[cc * 256]; fB[i] = sB[cc * 256]; }
        }
    }
    {
        const int cgp = tid & 31, t0 = NT * (tid >> 5);
        float w[4][8], xc[NT][8];
#pragma unroll
        for (int j = 0; j < 4; ++j)
#pragma unroll
            for (int e = 0; e < 8; e += 4) { const f32x4 cw = *(const LAS f32x4*)(par + P_CW + j * 256 + 8 * cgp + e); w[j][e] = cw[0]; w[j][e + 1] = cw[1]; w[j][e + 2] = cw[2]; w[j][e + 3] = cw[3]; }
#pragma unroll
        for (int e = 0; e < 8; e += 4) { const f32x4 cb = *(const LAS f32x4*)(par + P_CB + 8 * cgp + e);
#pragma unroll
            for (int tk = 0; tk < NT; ++tk) { xc[tk][e] = cb[0]; xc[tk][e + 1] = cb[1]; xc[tk][e + 2] = cb[2]; xc[tk][e + 3] = cb[3]; } }
#pragma unroll
        for (int i = 0; i < NT + 3; ++i) { const bf16x8 v = *(const LAS bf16x8*)(uaL + (t0 + i) * UP + 8 * cgp);
#pragma unroll
            for (int tk = 0; tk < NT; ++tk) { const int j = i - tk; if (j >= 0 && j < 4) {
#pragma unroll
                for (int e = 0; e < 8; ++e) xc[tk][e] += bf2f(v[e]) * w[j][e]; } } }
        __syncthreads();
#pragma unroll
        for (int tk = 0; tk < NT; ++tk) { u32x4 o; o.x = cvt_pk_bf16(xc[tk][0], xc[tk][1]); o.y = cvt_pk_bf16(xc[tk][2], xc[tk][3]); o.z = cvt_pk_bf16(xc[tk][4], xc[tk][5]); o.w = cvt_pk_bf16(xc[tk][6], xc[tk][7]);
            *(LAS u32x4*)((LAS unsigned char*)(lds + L_UA) + ((t0 + tk) * UP + 8 * cgp) * 2) = o; }
        __syncthreads();
    }
    float hrun = 0.f, prun = 1.f;
    if (tid < 256) {
        if (SMP) hrun = hsm;
        else if (pass == 1) {
            float hf = hfold;
#pragma unroll
            for (int i = 0; i < 16; ++i) if (cprev + i < c) hf = fA[i] * hf + fB[i];
            hfold = hf; hrun = hf;
        }
    }
#pragma unroll 1
    for (int half = 0; half < NH; ++half) {
        unsigned gp[NPF];
        if (pass == 1) {
#pragma unroll
            for (int k = 0; k < NPF; ++k) { const int idx = tid + k * NTHR, t = idx >> 7, ch = 2 * (idx & 127); gp[k] = *(const unsigned*)(ga + (row0 + half * HT * 16 + t) * 256 + ch); }
        }
        f32x4 ar[2][HT], ai_[2][HT];
#pragma unroll
        for (int a = 0; a < 2; ++a)
#pragma unroll
            for (int t = 0; t < HT; ++t) { ar[a][t] = (f32x4){0.f, 0.f, 0.f, 0.f}; ai_[a][t] = (f32x4){0.f, 0.f, 0.f, 0.f}; }
#pragma unroll
        for (int tt = 0; tt < HT; ++tt) {
            const int tl = (half * HT + tt) * 16 + l15;
#pragma unroll
            for (int ks = 0; ks < 2; ++ks) {
                const bf16x8 y = *(const LAS bf16x8*)(uaL + tl * UP + 64 * h + 32 * ks + 8 * g);
#pragma unroll
                for (int nt2 = 0; nt2 < 2; ++nt2) { ar[nt2][tt] = mma16(xr[nt2][ks], y, ar[nt2][tt]); ai_[nt2][tt] = mma16(xi[nt2][ks], y, ai_[nt2][tt]); }
            }
        }
#pragma unroll
        for (int nt2 = 0; nt2 < 2; ++nt2)
#pragma unroll
            for (int tt = 0; tt < HT; ++tt) {
                const int tl = (half * HT + tt) * 16 + l15, ch0 = 64 * h + 32 * nh + 16 * nt2 + 4 * g;
                const bf16x4 xv = *(const LAS bf16x4*)(uaL + tl * UP + ch0);
                const f32x4 br4 = *(const LAS f32x4*)(par + P_BRG + ch0), bi4 = *(const LAS f32x4*)(par + P_BIG + ch0), sp4 = *(const LAS f32x4*)(par + P_SP + ch0);
#pragma unroll
                for (int j = 0; j < 4; ++j) { const int ch = ch0 + j;
                    const float r = sigmoidf_(ar[nt2][tt][j] + br4[j]), ig = sigmoidf_(ai_[nt2][tt][j] + bi4[j]);
                    const float la = -8.0f * r * sp4[j], a = __expf(la), x2 = 2.0f * la;
                    const float ser = -x2 * (1.0f + x2 * (0.5f + x2 * (0.16666667f + x2 * (0.041666668f + x2 * 0.008333334f))));
                    const float mult = __builtin_amdgcn_sqrtf(x2 > -0.25f ? ser : 1.0f - a * a);
                    aL[ch * TS + tt * 16 + l15] = a; bL[ch * TS + tt * 16 + l15] = mult * ig * bf2f(xv[j]); }
            }
        __syncthreads();
        if (tid < 256) {
#pragma unroll 8
            for (int t = 0; t < HT * 16; ++t) { const float a = aL[tid * TS + t]; hrun = a * hrun + bL[tid * TS + t]; prun *= a; bL[tid * TS + t] = hrun; }
        }
        __syncthreads();
        if (pass == 1) {
#pragma unroll
            for (int k = 0; k < NPF; ++k) { const int idx = tid + k * NTHR, t = idx >> 7, ch = 2 * (idx & 127); const size_t row = row0 + half * HT * 16 + t;
                const float h0 = bL[ch * TS + t], h1 = bL[(ch + 1) * TS + t];
                const float g0 = __uint_as_float(gp[k] << 16), g1 = __uint_as_float(gp[k] & 0xffff0000u);
                *(unsigned*)(mix + row * DM + ch) = cvt_pk_bf16(h0 * gelu_tanh(g0), h1 * gelu_tanh(g1)); }
        }
        __syncthreads();
    }
    if (tid < 256) {
        if (!SMP && pass == 0) { WSP(float, WS_SUMA)[((size_t)b * 64 + c) * 256 + tid] = prun; WSP(float, WS_SUMB)[((size_t)b * 64 + c) * 256 + tid] = hrun; }
        if (pass == 1) { if (SMP) p.out[O_LRUS + (size_t)(l * SB + b) * 256 + tid] = hrun; else if (c == 63) p.out[O_LRUP + (size_t)(l * NB + b) * 256 + tid] = hrun; }
    }
}

template <int NT, bool SMP>
__device__ __forceinline__ void s5_item(const Params& p, int l, int b, int c, int pass, LAS unsigned char* lds, int cprev) {
    const bool fin = SMP || pass == 1;
    int tid_ = threadIdx.x; asm volatile("" : "+v"(tid_));
    const int tid = tid_, wid = __builtin_amdgcn_readfirstlane(tid >> 6), lane = tid & 63, l15 = lane & 15, g = lane >> 4;
    LAS float* buL = (LAS float*)(lds + L_BU + wid * 8448);
    LAS bf16_t* sL = (LAS bf16_t*)(lds + L_SL + wid * 4352);
    LAS bf16_t* uz = (LAS bf16_t*)(lds + L_UZ);
    const LAS float* par = (const LAS float*)(lds + L_PAR);
    bf16_t* mix = WSP(bf16_t, WS_MIX);
    const size_t row0 = SMP ? (size_t)MP + b * SS : (size_t)b * SEQ + c * 64;
    const float* abar = WSP(const float, WS_ABAR); const bf16_t* bbm = WSP(const bf16_t, WS_BBM); const bf16_t* cmt = WSP(const bf16_t, WS_CMT);
    const bf16x8 z8 = {0, 0, 0, 0, 0, 0, 0, 0};
    float zf = 0.f; asm volatile("" : "+v"(zf));
#pragma unroll 1
    for (int gi = 0; gi < 2; ++gi) {
        const int grp = 2 * wid + gi, lg = l * 16 + grp;
        const f32x4 ab = *(const f32x4*)(abar + ((size_t)lg * 64 + lane) * 4);
        float sre = 0.f, sim = 0.f;
        if (SMP) { sre = WSP(const float, WS_SMALL)[SM_SSRE + ((size_t)(l * SB + b) * 16 + grp) * 64 + lane]; sim = WSP(const float, WS_SMALL)[SM_SSIM + ((size_t)(l * SB + b) * 16 + grp) * 64 + lane]; }
        else if (pass == 1) {
            float* fs = WSP(float, WS_FOLD) + ((size_t)blockIdx.x * 16 + grp) * 128 + lane;
            if (cprev > 0) { sre = fs[0]; sim = fs[64]; }
            const float* S = WSP(const float, WS_SUMS) + ((size_t)b * 64 * 16 + grp) * 128 + lane;
            float re[16], im[16];
#pragma unroll
            for (int i = 0; i < 16; ++i) { const int cc = cprev + i < 63 ? cprev + i : 63; re[i] = S[(size_t)cc * 2048]; im[i] = S[(size_t)cc * 2048 + 64]; }
#pragma unroll
            for (int i = 0; i < 16; ++i) if (cprev + i < c) { const float nre = ab[2] * sre - ab[3] * sim + re[i], nim = ab[2] * sim + ab[3] * sre + im[i]; sre = nre; sim = nim; }
            fs[0] = sre; fs[64] = sim;
        }
        bf16x8 ybb[8], ycm[4];
#pragma unroll
        for (int pt = 0; pt < 8; ++pt) ybb[pt] = g < 2 ? *(const bf16x8*)(bbm + ((size_t)lg * 128 + 16 * pt + l15) * 16 + 8 * g) : z8;
#pragma unroll
        for (int ks = 0; ks < 4; ++ks) ycm[ks] = *(const bf16x8*)(cmt + ((size_t)lg * 16 + l15) * 128 + 32 * ks + 8 * g);
        const float dd = par[P_SD + 16 * grp + l15];
#pragma unroll 1
        for (int tt = 0; tt < NT; ++tt) {
            const bf16x8 x = g < 2 ? *(const LAS bf16x8*)(uz + (tt * 16 + l15) * UP + 16 * grp + 8 * g) : z8;
            LAS bf16_t* buT = (LAS bf16_t*)buL;
#pragma unroll
            for (int pt = 0; pt < 8; ++pt) { const f32x4 a = mma16(x, ybb[pt], (f32x4){0.f, 0.f, 0.f, 0.f});
                u32x2 w; w.x = cvt_pk_bf16(a[0] + zf, a[1] + zf); w.y = cvt_pk_bf16(a[2] + zf, a[3] + zf);
                *(LAS u32x2*)(buT + (16 * pt + l15) * 24 + 4 * g) = w; }
            LDS_WAIT();
            {
                const u32x4 r0 = *(const LAS u32x4*)(buT + lane * 24), r1 = *(const LAS u32x4*)(buT + lane * 24 + 8);
                const u32x4 i0 = *(const LAS u32x4*)(buT + (64 + lane) * 24), i1 = *(const LAS u32x4*)(buT + (64 + lane) * 24 + 8);
                const unsigned rw[8] = {r0.x, r0.y, r0.z, r0.w, r1.x, r1.y, r1.z, r1.w}, iw[8] = {i0.x, i0.y, i0.z, i0.w, i1.x, i1.y, i1.z, i1.w};
#pragma unroll
                for (int t = 0; t < 16; ++t) {
                    const float re = (t & 1) ? __uint_as_float(rw[t >> 1] & 0xffff0000u) : __uint_as_float(rw[t >> 1] << 16);
                    const float im = (t & 1) ? __uint_as_float(iw[t >> 1] & 0xffff0000u) : __uint_as_float(iw[t >> 1] << 16);
                    const float nre = ab[0] * sre - ab[1] * sim + re, nim = ab[0] * sim + ab[1] * sre + im; sre = nre; sim = nim;
                    if (fin) { sL[t * 136 + lane] = f2bf(sre); sL[t * 136 + 64 + lane] = f2bf(sim); } }
            }
            LDS_WAIT();
            if (fin) {
                f32x4 y = {0.f, 0.f, 0.f, 0.f};
#pragma unroll
                for (int ks = 0; ks < 4; ++ks) { const bf16x8 xs = *(const LAS bf16x8*)(sL + l15 * 136 + 32 * ks + 8 * g); y = mma16(xs, ycm[ks], y); }
#pragma unroll
                for (int j = 0; j < 4; ++j) { const int t = tt * 16 + 4 * g + j, ch = 16 * grp + l15;
                    const float u = bf2f((short)uz[t * UP + ch]); uz[t * UP + ch] = f2bf(gelu_tanh(y[j] + dd * u)); }
            }
            LDS_WAIT();
        }
        if (!SMP && pass == 0) { float* S = WSP(float, WS_SUMS) + (((size_t)b * 64 + c) * 16 + grp) * 128; S[lane] = sre; S[64 + lane] = sim; }
        if (pass == 1) {
            if (SMP) { p.out[O_SRES + ((size_t)(l * SB + b) * 16 + grp) * 64 + lane] = sre; p.out[O_SIMS + ((size_t)(l * SB + b) * 16 + grp) * 64 + lane] = sim; }
            else if (c == 63) { p.out[O_SREP + ((size_t)(l * NB + b) * 16 + grp) * 64 + lane] = sre; p.out[O_SIMP + ((size_t)(l * NB + b) * 16 + grp) * 64 + lane] = sim; }
        }
    }
    if (fin) {
        __syncthreads();
        const bf16_t* wgt = WSP(const bf16_t, WS_WGT) + (size_t)l * 65536;
#pragma unroll 1
        for (int nt2 = 0; nt2 < 2; ++nt2) {
            bf16x8 yw[8];
#pragma unroll
            for (int ks = 0; ks < 8; ++ks) yw[ks] = *(const bf16x8*)(wgt + (size_t)(32 * wid + 16 * nt2 + l15) * 256 + 32 * ks + 8 * g);
            const float bg = par[P_BGLU + 32 * wid + 16 * nt2 + l15];
#pragma unroll 1
            for (int tt = 0; tt < NT; ++tt) {
                f32x4 a = {0.f, 0.f, 0.f, 0.f};
#pragma unroll
                for (int ks = 0; ks < 8; ++ks) { const bf16x8 xz = *(const LAS bf16x8*)(uz + (tt * 16 + l15) * UP + 32 * ks + 8 * g); a = mma16(xz, yw[ks], a); }
#pragma unroll
                for (int j = 0; j < 4; ++j) { const int t = tt * 16 + 4 * g + j, n = 32 * wid + 16 * nt2 + l15;
                    const float z = bf2f((short)uz[t * UP + n]); mix[(row0 + t) * DM + 256 + n] = f2bf(z * sigmoidf_(a[j] + bg)); }
            }
        }
    }
    __syncthreads();
}

template <int NQT, bool SMP>
__device__ __forceinline__ void attn_item(const Params& p, int l, int b, int c, LAS unsigned char* lds) {
    int tid_ = threadIdx.x; asm volatile("" : "+v"(tid_));
    const int tid = tid_, wid = __builtin_amdgcn_readfirstlane(tid >> 6), lane = tid & 63, l15 = lane & 15, g = lane >> 4, kvh = wid >> 2;
    const bf16_t* q = WSP(const bf16_t, WS_Q); bf16_t* mix = WSP(bf16_t, WS_MIX);
    const bf16_t* kbase; const bf16_t* vbase; size_t vstride, row0; int nkt;
    if (SMP) { kbase = WSP(const bf16_t, WS_KBS) + (size_t)(l * SB + b) * 144 * 128; vbase = WSP(const bf16_t, WS_VTS) + (size_t)(l * SB + b) * 128 * 144; vstride = 144; nkt = 9; row0 = (size_t)MP + b * SS; }
    else { const int c0 = c >= 2 ? c - 2 : 0; kbase = WSP(const bf16_t, WS_KBP) + ((size_t)b * SEQ + c0 * 64) * 128; vbase = WSP(const bf16_t, WS_VTP) + (size_t)b * 128 * SEQ + c0 * 64;
        vstride = SEQ; nkt = 4 * (c - c0 + 1); row0 = (size_t)b * SEQ + c * 64; }
    bf16x8 yq[NQT][2];
#pragma unroll
    for (int qt = 0; qt < NQT; ++qt)
#pragma unroll
        for (int ks = 0; ks < 2; ++ks) yq[qt][ks] = *(const bf16x8*)(q + (row0 + qt * 16 + l15) * 512 + wid * 64 + 32 * ks + 8 * g);
    {
        const int nkc = nkt * 16 * 16, cpr = nkt * 2, nvc = 128 * cpr;
        u32x4 kv[6], vv[6];
#pragma unroll
        for (int i = 0; i < 6; ++i) { const int idx = tid + i * NTHR; kv[i] = (u32x4){0u, 0u, 0u, 0u};
            if (idx < nkc) kv[i] = *(const u32x4*)(kbase + (size_t)(idx >> 4) * 128 + 8 * (idx & 15)); }
#pragma unroll
        for (int i = 0; i < 6; ++i) { const int idx = tid + i * NTHR, r = idx / cpr, ck = idx - r * cpr; vv[i] = (u32x4){0u, 0u, 0u, 0u};
            if (idx < nvc) vv[i] = *(const u32x4*)(vbase + (size_t)r * vstride + 8 * ck); }
#pragma unroll
        for (int i = 0; i < 6; ++i) { const int idx = tid + i * NTHR; if (idx < nkc) *(LAS u32x4*)(lds + L_KL + (idx >> 4) * 272 + (idx & 15) * 16) = kv[i]; }
#pragma unroll
        for (int i = 0; i < 6; ++i) { const int idx = tid + i * NTHR, r = idx / cpr, ck = idx - r * cpr; if (idx < nvc) *(LAS u32x4*)(lds + L_VL + r * 400 + ck * 16) = vv[i]; }
    }
    __syncthreads();
    const float sink = WSP(const float, WS_SMALL)[SM_SINK + l * 8 + wid];
    const bf16x4 z4 = {0, 0, 0, 0};
    const LAS unsigned char* kL = lds + L_KL + l15 * 272 + (kvh * 64 + 8 * g) * 2;
    const LAS unsigned char* vL = lds + L_VL + (kvh * 64 + l15) * 400 + (4 * g) * 2;
    constexpr int QB = NQT >= 2 ? 2 : 1;
#pragma unroll
    for (int qp = 0; qp < NQT / QB; ++qp) {
        f32x4 s[QB][12];
#pragma unroll
        for (int kt = 0; kt < 12; ++kt) {
#pragma unroll
            for (int qb = 0; qb < QB; ++qb) s[qb][kt] = (f32x4){0.f, 0.f, 0.f, 0.f};
            if (kt < nkt) {
#pragma unroll
                for (int ks = 0; ks < 2; ++ks) { const bf16x8 x = *(const LAS bf16x8*)(kL + kt * 16 * 272 + ks * 64);
#pragma unroll
                    for (int qb = 0; qb < QB; ++qb) s[qb][kt] = mma16(x, yq[qp * QB + qb][ks], s[qb][kt]); } } }
        float inv[QB];
#pragma unroll
        for (int qb = 0; qb < QB; ++qb) {
            float mx = sink;
#pragma unroll
            for (int kt = 0; kt < 12; ++kt) if (kt < nkt) mx = fmaxf(fmaxf(mx, fmaxf(s[qb][kt][0], s[qb][kt][1])), fmaxf(s[qb][kt][2], s[qb][kt][3]));
            mx = fmaxf(mx, __shfl_xor(mx, 16)); mx = fmaxf(mx, __shfl_xor(mx, 32));
            float sum = 0.f;
#pragma unroll
            for (int kt = 0; kt < 12; ++kt) if (kt < nkt) {
#pragma unroll
                for (int j = 0; j < 4; ++j) { const float e = __expf(s[qb][kt][j] - mx); s[qb][kt][j] = e; sum += e; } }
            sum += __shfl_xor(sum, 16); sum += __shfl_xor(sum, 32); sum += __expf(sink - mx);
            inv[qb] = 1.0f / sum;
        }
        f32x4 o[QB][4];
#pragma unroll
        for (int qb = 0; qb < QB; ++qb)
#pragma unroll
            for (int dt = 0; dt < 4; ++dt) o[qb][dt] = (f32x4){0.f, 0.f, 0.f, 0.f};
#pragma unroll
        for (int kk = 0; kk < 6; ++kk) if (2 * kk < nkt) {
            bf16x8 y[QB];
#pragma unroll
            for (int qb = 0; qb < QB; ++qb) { u32x4 w; w.x = cvt_pk_bf16(s[qb][2 * kk][0], s[qb][2 * kk][1]); w.y = cvt_pk_bf16(s[qb][2 * kk][2], s[qb][2 * kk][3]);
                w.z = cvt_pk_bf16(s[qb][2 * kk + 1][0], s[qb][2 * kk + 1][1]); w.w = cvt_pk_bf16(s[qb][2 * kk + 1][2], s[qb][2 * kk + 1][3]);
                y[qb] = __builtin_bit_cast(bf16x8, w); }
            const bool hi = 2 * kk + 1 < nkt;
#pragma unroll
            for (int dt = 0; dt < 4; ++dt) { const LAS unsigned char* vr = vL + dt * 16 * 400 + kk * 64;
                const bf16x4 lo = *(const LAS bf16x4*)vr; const bf16x4 h4 = hi ? *(const LAS bf16x4*)(vr + 32) : z4;
                const bf16x8 x = __builtin_shufflevector(lo, h4, 0, 1, 2, 3, 4, 5, 6, 7);
#pragma unroll
                for (int qb = 0; qb < QB; ++qb) o[qb][dt] = mma16(x, y[qb], o[qb][dt]); }
        }
#pragma unroll
        for (int qb = 0; qb < QB; ++qb) { const size_t qrow = row0 + (qp * QB + qb) * 16 + l15;
#pragma unroll
            for (int dt = 0; dt < 4; ++dt) { u32x2 w; w.x = cvt_pk_bf16(o[qb][dt][0] * inv[qb], o[qb][dt][1] * inv[qb]); w.y = cvt_pk_bf16(o[qb][dt][2] * inv[qb], o[qb][dt][3] * inv[qb]);
                *(u32x2*)(mix + qrow * DM + 512 + wid * 64 + 16 * dt + 4 * g) = w; } }
    }
    __syncthreads();
}

__device__ __forceinline__ void mixer_pass(const Params& p, int l, int pass, LAS unsigned char* lds) {
    {
        LAS float* par = (LAS float*)(lds + L_PAR); const float* sm = WSP(const float, WS_SMALL);
        for (int i = threadIdx.x; i < 2560; i += NTHR) { float v;
            if (i < 1024) v = sm[SM_CW + l * 1024 + i];
            else { const int k = (i - 1024) >> 8, j = i & 255;
                v = k == 0 ? sm[SM_CB + l * 256 + j] : k == 1 ? sm[SM_BRG + l * 256 + j] : k == 2 ? sm[SM_BIG + l * 256 + j] : k == 3 ? WSP(const float, WS_SP)[l * 256 + j] : k == 4 ? sm[SM_SD + l * 256 + j] : sm[SM_BGLU + l * 256 + j]; }
            par[i] = v; }
        __syncthreads();
    }
    float hfold = 0.f; int cprev = 0;
#pragma unroll 1
    for (int it = blockIdx.x; it < NB * 64 + SB; it += gridDim.x) {
        if (it < NB * 64) { const int b = it & 15, c = it >> 4;
            stage_uab<4, false>(p, l, b, c, lds); __syncthreads();
#ifndef DUPM
#define DUPM 0
#endif
            { float hf0 = hfold; for (int r2 = 0; r2 < ((DUPM & 1) ? 2 : 1); ++r2) { hfold = hf0; lru_item<4, false>(p, l, b, c, pass, lds, hfold, cprev); } }
            for (int r2 = 0; r2 < ((DUPM & 2) ? 2 : 1); ++r2) { if ((DUPM & 2) && r2 == 1) { stage_uab<4, false>(p, l, b, c, lds); __syncthreads(); } s5_item<4, false>(p, l, b, c, pass, lds, r2 == 1 && pass == 1 ? c : cprev); }
            cprev = c;
            for (int r2 = 0; r2 < ((DUPM & 4) ? 2 : 1); ++r2) if (pass == 0) attn_item<4, false>(p, l, b, c, lds);
        } else { const int b = it - NB * 64;
            if (pass == 0) { attn_item<1, true>(p, l, b, 0, lds);
                float hf = 0.f; stage_uab<1, true>(p, l, b, 0, lds); __syncthreads(); lru_item<1, true>(p, l, b, 0, 1, lds, hf, 0); s5_item<1, true>(p, l, b, 0, 1, lds, 0); }
        }
    }
}

__device__ __forceinline__ void final_norm(const Params& p) {
    int tid_ = threadIdx.x; asm volatile("" : "+v"(tid_));
    const int lane = tid_ & 63, gw = blockIdx.x * NWAVES + (tid_ >> 6), NGW = gridDim.x * NWAVES;
    const float* ss = WSP(const float, WS_SS); const f32x4* nf = (const f32x4*)(WSP(const float, WS_SMALL) + SM_NF) + 2 * lane;
    const bf16_t* xb = WSP(const bf16_t, WS_XB);
#pragma unroll 1
    for (int row = gw; row < MREAL; row += NGW) {
        const float rs = ss_rs(ss, row); f32x4* o = (f32x4*)(p.out + O_Y + (size_t)row * DM) + 2 * lane; const u32x4* xi = (const u32x4*)(xb + (size_t)row * DM) + lane;
#pragma unroll
        for (int j = 0; j < 2; ++j) { const u32x4 w = xi[64 * j]; const f32x4 g0 = nf[128 * j], g1 = nf[128 * j + 1];
            o[128 * j] = (f32x4){__uint_as_float(w.x << 16) * rs * g0[0], __uint_as_float(w.x & 0xffff0000u) * rs * g0[1], __uint_as_float(w.y << 16) * rs * g0[2], __uint_as_float(w.y & 0xffff0000u) * rs * g0[3]};
            o[128 * j + 1] = (f32x4){__uint_as_float(w.z << 16) * rs * g1[0], __uint_as_float(w.z & 0xffff0000u) * rs * g1[1], __uint_as_float(w.w << 16) * rs * g1[2], __uint_as_float(w.w & 0xffff0000u) * rs * g1[3]}; }
    }
}

template <int KIND>
__device__ __forceinline__ void slab_gemm(const Params& p, LAS unsigned char* lds, const bf16_t* A, const bf16_t* Bt, int K, int N,
                                          const float* xin_s, float* xout_s, bf16_t* xb, float* ss, bf16_t* hid) {
    int tid_ = threadIdx.x; asm volatile("" : "+v"(tid_));
    const int tid = tid_, wid = __builtin_amdgcn_readfirstlane(tid >> 6), lane = tid & 63, l15 = lane & 15, g = lane >> 4;
    const int npieces = 8 * (N / 64), kw = K / 8;
#pragma unroll 1
    for (int pc = blockIdx.x; pc < npieces; pc += gridDim.x) {
        const int rt = pc & 7, cg = pc >> 3;
        f32x4 acc[4];
#pragma unroll
        for (int ct = 0; ct < 4; ++ct) acc[ct] = (f32x4){0.f, 0.f, 0.f, 0.f};
        const bf16_t* ap = A + (size_t)(MP + rt * 16 + l15) * K + wid * kw + 8 * g;
        const bf16_t* bp = Bt + (size_t)(cg * 64 + l15) * K + wid * kw + 8 * g;
#pragma unroll 4
        for (int ks = 0; ks < kw / 32; ++ks) {
            const bf16x8 x = *(const bf16x8*)(ap + 32 * ks);
#pragma unroll
            for (int ct = 0; ct < 4; ++ct) { const bf16x8 y = *(const bf16x8*)(bp + (size_t)ct * 16 * K + 32 * ks); acc[ct] = mma16(x, y, acc[ct]); }
        }
        LAS f32x4* part = (LAS f32x4*)lds;
#pragma unroll
        for (int ct = 0; ct < 4; ++ct) part[(wid * 4 + ct) * 64 + lane] = acc[ct];
        __syncthreads();
        const int r = 2 * wid + (lane >> 5), c = 2 * (lane & 31), gg = r >> 2, j = r & 3;
        float v0 = 0.f, v1 = 0.f;
#pragma unroll
        for (int w = 0; w < 8; ++w) { const LAS float* pp = (const LAS float*)lds + ((w * 4 + (c >> 4)) * 64 + 16 * gg + (c & 15)) * 4 + j; v0 += pp[0]; v1 += pp[4]; }
        const int row = MP + rt * 16 + r, col = cg * 64 + c;
        if (KIND == 0) {
            const size_t off = (size_t)(rt * 16 + r) * DM + col;
            float r0, r1;
            if (xin_s) { r0 = xin_s[off]; r1 = xin_s[off + 1]; }
            else { const unsigned xw = *(const unsigned*)(xb + (size_t)row * DM + col); r0 = __uint_as_float(xw << 16); r1 = __uint_as_float(xw & 0xffff0000u); }
            const float o0 = r0 + v0, o1 = r1 + v1;
            if (xout_s) { xout_s[off] = o0; xout_s[off + 1] = o1; }
            if (xb) *(unsigned*)(xb + (size_t)row * DM + col) = cvt_pk_bf16(o0, o1);
            float sq = o0 * o0 + o1 * o1;
#pragma unroll
            for (int o = 1; o < 32; o <<= 1) sq += __shfl_xor(sq, o);
            if ((lane & 31) == 0) ss[(size_t)row * 16 + cg] = sq;
        } else if (KIND == 1) {
            const float rs = ss_rs(ss, row), a0 = fmaxf(v0 * rs, 0.f), a1 = fmaxf(v1 * rs, 0.f);
            *(unsigned*)(hid + (size_t)row * DFF + col) = cvt_pk_bf16(a0 * a0, a1 * a1);
        } else {
            const int l = (int)(size_t)xin_s;
            const int sb = rt, st = r, pos = SEQ + st;
            const float rs = ss_rs(ss, row), a0 = v0 * rs, a1 = v1 * rs;
            if (col < 768) {
                bf16_t* dst = col < 256 ? WSP(bf16_t, WS_UA) : (col < 512 ? WSP(bf16_t, WS_GA) : WSP(bf16_t, WS_UB)); const int cc = col & 255;
                *(unsigned*)(dst + (size_t)row * 256 + cc) = cvt_pk_bf16(a0, a1);
                if (col < 256 && st >= SS - 3) { float* o = p.out + O_CONVS + ((size_t)(l * SB + sb) * 3 + (st - (SS - 3))) * 256 + cc; o[0] = a0; o[1] = a1; }
            } else if (col < 1408) {
                const int jp = (col & 63) >> 1; const float* rp = WSP(const float, WS_ROPE) + ((size_t)pos * 32 + jp) * 2;
                const float cs = rp[0], sn = rp[1], o0 = a0 * cs - a1 * sn, o1 = a1 * cs + a0 * sn;
                if (col < 1280) *(unsigned*)(WSP(bf16_t, WS_Q) + (size_t)row * 512 + (col - 768)) = cvt_pk_bf16(o0 * 0.125f, o1 * 0.125f);
                else { const int kc = col - 1280, kvh = kc >> 6;
                    *(unsigned*)(WSP(bf16_t, WS_KBS) + ((size_t)(l * SB + sb) * 144 + 128 + st) * 128 + kc) = cvt_pk_bf16(o0, o1);
                    float* o = p.out + O_KS + (((size_t)(l * SB + sb) * SS + st) * 2 + kvh) * 64 + jp; o[0] = o0; o[32] = o1; }
            } else {
                const int vc = col - 1408, kvh = vc >> 6, d = vc & 63;
                bf16_t* vt = WSP(bf16_t, WS_VTS) + ((size_t)(l * SB + sb) * 128 + vc) * 144 + 128 + st; vt[0] = f2bf(a0); vt[144] = f2bf(a1);
                float* o = p.out + O_VS + (((size_t)(l * SB + sb) * SS + st) * 2 + kvh) * 64 + d; o[0] = a0; o[1] = a1;
            }
        }
        __syncthreads();
    }
}

#define XB_TMO      128
#define XB_XCNT(j)  (256  + 64 * (j))
#define XB_XSUB(j)  (1280 + 64 * (j))
#define XB_XGEN(j)  (2304 + 64 * (j))
#define XB_TOP      3328
#define XB_TOPGEN   3392
#define XCD_BAR_WORDS 3456
#define XB_SPIN_CAP (1u << 18)

__device__ __forceinline__ unsigned xb_ld(unsigned* p)              { return __hip_atomic_load(p, __ATOMIC_RELAXED, __HIP_MEMORY_SCOPE_AGENT); }
__device__ __forceinline__ unsigned xb_add(unsigned* p, unsigned v) { return __hip_atomic_fetch_add(p, v, __ATOMIC_RELAXED, __HIP_MEMORY_SCOPE_AGENT); }
__device__ __forceinline__ unsigned xb_xcc_id() { return (unsigned)__builtin_amdgcn_s_getreg((3 << 11) | 20) & 0xFu; }
#define XB_SPIN(cond, bar) do { unsigned _sp = 0; while (cond) { __builtin_amdgcn_s_sleep(1); \
    if ((++_sp & 255u) == 0u) { if (xb_ld(&(bar)[XB_TMO])) break; if (_sp > XB_SPIN_CAP) { atomicAdd(&(bar)[XB_TMO], 1u); break; } } } } while (0)

struct XcdBarrier {
    unsigned* bar; unsigned x;
    volatile LAS unsigned* st;
};

__device__ __forceinline__ XcdBarrier xcd_barrier_post(unsigned* bar, volatile LAS unsigned* st) {
    XcdBarrier b; b.bar = bar; b.x = xb_xcc_id(); b.st = st;
    if (threadIdx.x == 0) (void)xb_add(&bar[XB_XCNT(b.x)], 1u);
    return b;
}
__device__ __forceinline__ void xcd_barrier_complete(unsigned* bar, unsigned x, unsigned& nloc, unsigned& nx) {
    const unsigned G = gridDim.x * gridDim.y * gridDim.z;
    unsigned sum, cnt, mine, sp = 0u;
    for (;;) {
        sum = 0u; cnt = 0u; mine = 0u;
#pragma unroll
        for (unsigned j = 0; j < 16; ++j) { const unsigned c = xb_ld(&bar[XB_XCNT(j)]); sum += c; cnt += (c > 0u) ? 1u : 0u; mine = (j == x) ? c : mine; }
        if (sum == G) break;
        __builtin_amdgcn_s_sleep(1);
        if ((++sp & 255u) == 0u) { if (xb_ld(&bar[XB_TMO])) break; if (sp > XB_SPIN_CAP) { atomicAdd(&bar[XB_TMO], 1u); break; } }
    }
    nloc = mine > 0u ? mine : 1u; nx = cnt > 0u ? cnt : 1u;
}

__device__ __forceinline__ void xcd_barrier(const XcdBarrier& b) {
    asm volatile("s_waitcnt vmcnt(0)" ::: "memory");
    __syncthreads();
    if (threadIdx.x == 0) {
        unsigned* bar = b.bar;
        __builtin_amdgcn_s_waitcnt(0);
        unsigned nloc = b.st[0], nx = b.st[1];
        if (nloc == 0u) { xcd_barrier_complete(bar, b.x, nloc, nx); b.st[0] = nloc; b.st[1] = nx; }
        const unsigned old = xb_add(&bar[XB_XSUB(b.x)], 1u);
        const unsigned gen = old / nloc;
        if (old + 1u == (gen + 1u) * nloc) {
            __builtin_amdgcn_fence(__ATOMIC_RELEASE, "agent");
            asm volatile("s_waitcnt vmcnt(0)" ::: "memory");
            const unsigned og = xb_add(&bar[XB_TOP], 1u);
            const unsigned tg = og / nx;
            if (og + 1u == (tg + 1u) * nx) xb_add(&bar[XB_TOPGEN], 1u);
            else XB_SPIN(xb_ld(&bar[XB_TOPGEN]) == tg, bar);
            __builtin_amdgcn_fence(__ATOMIC_ACQUIRE, "agent");
            xb_add(&bar[XB_XGEN(b.x)], 1u);
            asm volatile("s_waitcnt vmcnt(0)" ::: "memory");
        } else {
            XB_SPIN(xb_ld(&bar[XB_XGEN(b.x)]) == gen, bar);
            __builtin_amdgcn_fence(__ATOMIC_ACQUIRE, "agent");
            asm volatile("s_waitcnt vmcnt(0)" ::: "memory");
        }
    }
    __syncthreads();
}

#define GSYNC_CG() do { asm volatile("s_waitcnt vmcnt(0) lgkmcnt(0)" ::: "memory"); grid.sync(); __builtin_amdgcn_fence(__ATOMIC_ACQUIRE, "agent"); asm volatile("s_waitcnt vmcnt(0)" ::: "memory"); } while (0)
#define GSYNC() do { XcdBarrier xb_; xb_.bar = (unsigned*)(p.ws + WS_CTL); xb_.x = xb_xcc_id(); xb_.st = (volatile LAS unsigned*)(lds + L_MISC); xcd_barrier(xb_); } while (0)
__global__ void __launch_bounds__(NTHR, 2) fwd_kernel(Params p) {
    extern __shared__ __attribute__((aligned(16))) unsigned char lds_raw[];
    LAS unsigned char* lds = (LAS unsigned char*)lds_raw;
    cg::grid_group grid = cg::this_grid();
    const int G = gridDim.x, cid = blockIdx.x;
    volatile LAS unsigned* misc = (volatile LAS unsigned*)(lds + L_MISC);
    if (threadIdx.x < 2) misc[threadIdx.x] = 0u;
    if (threadIdx.x < 33) ((LAS unsigned long long*)(lds + L_PTAB))[threadIdx.x] = ((const unsigned long long*)__builtin_amdgcn_kernarg_segment_ptr())[threadIdx.x];
    __syncthreads();
    (void)xcd_barrier_post((unsigned*)(p.ws + WS_CTL), misc);
#ifndef EN
#define EN 0xff
#endif
#ifndef DUP
#define DUP 0
#endif
#define REPS(bit) (((DUP) & (bit)) && l == 0 ? 2 : 1)
#ifndef DUPP
#define DUPP 1
#endif
#pragma unroll 1
    for (int rp = 0; rp < DUPP; ++rp) { if (EN & 1) prologue(p, lds); __syncthreads(); }
#ifdef NOCG
    if (gridDim.y == 0x7fffffffu)
#endif
    GSYNC_CG();
#ifdef NOCG
    GSYNC();
#endif
#pragma unroll 1
    for (int l = 0; l < DEPTH; ++l) {
        if (EN & 2) {
            pg8::Gemm gm{WSP(const bf16_t, WS_XB), WSP(const bf16_t, WS_WIN) + (size_t)l * DIN * DM, MP, DIN, DM}; pg8::StaticOrder S; S.init(MP, DIN, G, cid);
            EpiIn E{p.ws, p.out, l};
            pg8::gemm_phase<EpiIn, pg8::StaticOrder, true, true>(lds, gm, S, E);
            slab_gemm<2>(p, lds, WSP(const bf16_t, WS_XB), WSP(const bf16_t, WS_WIN) + (size_t)l * DIN * DM, DM, DIN, (const float*)(size_t)l, nullptr, nullptr, WSP(float, WS_SS), nullptr);
        }
        GSYNC();
        if (EN & 4) mixer_pass(p, l, 0, lds);
        GSYNC();
        if (EN & 8) mixer_pass(p, l, 1, lds);
        GSYNC();
        if (EN & 16) {
            pg8::Gemm gm{WSP(const bf16_t, WS_MIX), WSP(const bf16_t, WS_WOUT) + (size_t)l * DM * DM, MP, DM, DM}; pg8::StaticOrder S; S.init(MP, DM, G, cid);
            EpiResB E{WSP(bf16_t, WS_XB), WSP(float, WS_SS)};
            pg8::gemm_phase<EpiResB, pg8::StaticOrder, true, true>(lds, gm, S, E);
            slab_gemm<0>(p, lds, WSP(const bf16_t, WS_MIX), WSP(const bf16_t, WS_WOUT) + (size_t)l * DM * DM, DM, DM, nullptr, nullptr, WSP(bf16_t, WS_XB), WSP(float, WS_SS), nullptr);
        }
        GSYNC();
        if (EN & 32) {
            pg8::Gemm gm{WSP(const bf16_t, WS_XB), WSP(const bf16_t, WS_WUP) + (size_t)l * DFF * DM, MP, DFF, DM}; pg8::StaticOrder S; S.init(MP, DFF, G, cid);
            EpiUp E{WSP(const float, WS_SS), WSP(bf16_t, WS_HID)};
            pg8::gemm_phase<EpiUp, pg8::StaticOrder, true, true>(lds, gm, S, E);
            slab_gemm<1>(p, lds, WSP(const bf16_t, WS_XB), WSP(const bf16_t, WS_WUP) + (size_t)l * DFF * DM, DM, DFF, nullptr, nullptr, nullptr, WSP(float, WS_SS), WSP(bf16_t, WS_HID));
        }
        GSYNC();
        if (EN & 64) {
            pg8::Gemm gm{WSP(const bf16_t, WS_HID), WSP(const bf16_t, WS_WDN) + (size_t)l * DM * DFF, MP, DM, DFF}; pg8::StaticOrder S; S.init(MP, DM, G, cid);
            EpiResB E{WSP(bf16_t, WS_XB), WSP(float, WS_SS)};
            pg8::gemm_phase<EpiResB, pg8::StaticOrder, true, true>(lds, gm, S, E);
            slab_gemm<0>(p, lds, WSP(const bf16_t, WS_HID), WSP(const bf16_t, WS_WDN) + (size_t)l * DM * DFF, DFF, DM, nullptr, nullptr, WSP(bf16_t, WS_XB), WSP(float, WS_SS), nullptr);
        }
        GSYNC();
    }
    if (EN & 128) final_norm(p);
}

extern "C" void kernel_launch(void* const* d_in, const int* in_sizes, int n_in, void* d_out, int out_size, void* d_ws, size_t ws_size, hipStream_t stream) {
    static int grid = 0;
    if (grid == 0) {
        if (n_in != 33 || (size_t)out_size != O_END || ws_size < WS_TOTAL) { fprintf(stderr, "kernel_launch: unexpected shapes (n_in %d out %d ws %zu)\n", n_in, out_size, ws_size); grid = -1; return; }
        int dev = 0, cus = 0, per = 0;
        if (hipGetDevice(&dev) != hipSuccess || hipDeviceGetAttribute(&cus, hipDeviceAttributeMultiprocessorCount, dev) != hipSuccess) { grid = -1; return; }
        if (hipFuncSetAttribute((const void*)fwd_kernel, hipFuncAttributeMaxDynamicSharedMemorySize, LDS_BYTES) != hipSuccess) { fprintf(stderr, "kernel_launch: hipFuncSetAttribute failed\n"); grid = -1; return; }
        if (hipOccupancyMaxActiveBlocksPerMultiprocessor(&per, (const void*)fwd_kernel, NTHR, LDS_BYTES) != hipSuccess || per < 1) { fprintf(stderr, "kernel_launch: occupancy query says %d\n", per); per = 1; }
        (void)hipGetLastError();
        grid = cus;
    }
    if (grid < 0) return;
    if (hipMemsetAsync((char*)d_ws + WS_CTL, 0, CTL_BYTES, stream) != hipSuccess) { fprintf(stderr, "kernel_launch: hipMemsetAsync failed\n"); return; }
    Params p{};
    for (int i = 0; i < 33; ++i) p.in[i] = (const float*)d_in[i];
    p.out = (float*)d_out; p.ws = (unsigned char*)d_ws;
    void* args[] = {&p};
    hipError_t e = hipLaunchCooperativeKernel((const void*)fwd_kernel, dim3(grid), dim3(NTHR), args, LDS_BYTES, stream);
    if (e != hipSuccess) fprintf(stderr, "kernel_launch: cooperative launch failed: %s (grid %d)\n", hipGetErrorString(e), grid);
}
```

```cpp
#define NOCG 1
#include <hip/hip_runtime.h>
#include <hip/hip_cooperative_groups.h>
#include <cstdio>
#include <cstdint>
namespace cg = cooperative_groups;
namespace pg8 {
#define PG8_LAS __attribute__((address_space(3)))
typedef unsigned short bf16_t;
typedef short bf16x8 __attribute__((ext_vector_type(8)));
typedef float f32x4 __attribute__((ext_vector_type(4)));
typedef unsigned u32x4 __attribute__((ext_vector_type(4)));
constexpr int BM = 256, BK = 64, HALF = 128, HTB = HALF * BK * 2  , STAGE_BYTES = 8 * HTB, NXCD = 8, WGM = 8;

__host__ __device__ __forceinline__ int lds_byte(int r, int c) { const int st = (r >> 4) * 2 + (c >> 5), rr = r & 15, cc = c & 31, ob = rr * 64 + cc * 2; return st * 1024 + (ob ^ (((ob >> 9) & 1) << 5)); }
__host__ __device__ __forceinline__ void stage_rc(int b, int& R, int& C) { const int st = b / 1024, sb = b % 1024, swz = sb ^ (((sb >> 9) & 1) << 5); R = (st >> 1) * 16 + swz / 64; C = (st & 1) * 32 + (swz % 64) / 2; }
__host__ __device__ __forceinline__ int perm32(int rho) { const int n = rho >> 4, i = rho & 15; return 8 * (i >> 2) + 4 * n + (i & 3); }

struct Unit { int pm, pn; };
struct Gemm { const bf16_t* A; const bf16_t* Bt; int M, N, K; };

struct StaticOrder {
    int nM, nN, nwg, G, c;
    __host__ __device__ void init(int M, int N, int G_, int c_) { nM = M / BM; nN = N / BM; nwg = nM * nN; G = G_; c = c_; }
    __host__ __device__ bool next(int i, Unit& u) const {
        const long L = (long)i * G + c; if (L >= nwg) return false;
        int wgid = (int)L; { const int q = nwg / NXCD, r = nwg % NXCD, xcd = wgid % NXCD, off = wgid / NXCD; wgid = (xcd < r ? xcd * (q + 1) : r * (q + 1) + (xcd - r) * q) + off; }
        const int nig = WGM * nN, gid = wgid / nig, fm = gid * WGM, gsz = (nM - fm) < WGM ? (nM - fm) : WGM;
        u.pm = fm + ((wgid % nig) % gsz); u.pn = (wgid % nig) / gsz; return true;
    }
    __device__ __forceinline__ void a_ready(const Unit&) const {}
    __device__ __forceinline__ void done(const Unit&) const {}
};

__device__ __forceinline__ unsigned cvt_pk_bf16(float lo, float hi) { unsigned r; asm volatile("v_cvt_pk_bf16_f32 %0, %1, %2" : "=v"(r) : "v"(lo), "v"(hi)); return r; }
typedef float f32x2 __attribute__((ext_vector_type(2)));
template <class Epi, class Sched, bool ALIGN_EPI = false, bool SP2 = false>
__device__ __forceinline__ void gemm_phase(PG8_LAS unsigned char* lds, const Gemm g, const Sched& S, const Epi& E) {
    int tid_ = threadIdx.x; asm volatile("" : "+v"(tid_));
    const int tid = tid_, wid = __builtin_amdgcn_readfirstlane(tid >> 6), lane = tid & 63, wr = wid >> 2, wc = wid & 3, fr = lane & 15, fq = lane >> 4;
    const int K = g.K, nt = K / BK;
    unsigned voffA[2], voffB[2];
#pragma unroll
    for (int i = 0; i < 2; ++i) { int R, C; stage_rc(tid * 16 + i * 8192, R, C); const int Rb = Epi::PERM ? ((R & ~31) + perm32(R & 31)) : R;
        voffA[i] = (unsigned)(R * K + C) * 2u; voffB[i] = (unsigned)(Rb * K + C) * 2u; }
    const size_t kstep = (size_t)(BK * 2);
    const size_t hstep = (size_t)HALF * K * 2;
    const size_t tstep = 2 * hstep;
    const unsigned ldsw = (unsigned)wid * 1024u;
    const int aoff = lds_byte(wr * 64 + fr, fq * 8), boff = lds_byte(wc * 32 + fr, fq * 8);
#define PG8_SA(b, h) (((b) * 2 + (h)) * HTB)
#define PG8_SB(b, h) ((4 + (b) * 2 + (h)) * HTB)
#define PG8_STAGE(bufoff, gbase, voff) do { _Pragma("unroll") for (int _i = 0; _i < 2; ++_i) \
        __builtin_amdgcn_global_load_lds((const unsigned*)((const char*)(gbase) + (voff)[_i]), (PG8_LAS unsigned*)(lds + (bufoff) + ldsw + _i * 8192), 16, 0, 0); } while (0)
#define PG8_LDA(dst, b, h) do { _Pragma("unroll") for (int m = 0; m < 4; ++m) _Pragma("unroll") for (int k = 0; k < 2; ++k) dst[m][k] = *(const PG8_LAS bf16x8*)(lds + PG8_SA(b, h) + aoff + m * 2048 + k * 1024); } while (0)
#define PG8_LDB(dst, b, h) do { _Pragma("unroll") for (int n = 0; n < 2; ++n) _Pragma("unroll") for (int k = 0; k < 2; ++k) dst[n][k] = *(const PG8_LAS bf16x8*)(lds + PG8_SB(b, h) + boff + n * 2048 + k * 1024); } while (0)
#define PG8_MMA(ai, bj, At, Bt) do { __builtin_amdgcn_s_setprio(1); _Pragma("unroll") for (int m = 0; m < 4; ++m) _Pragma("unroll") for (int n = 0; n < 2; ++n) _Pragma("unroll") for (int k = 0; k < 2; ++k) \
        acc[ai][bj][m][n] = __builtin_amdgcn_mfma_f32_16x16x32_bf16(Bt[n][k], At[m][k], acc[ai][bj][m][n], 0, 0, 0); __builtin_amdgcn_s_setprio(0); } while (0)
#define PG8_WAIT_V(n) asm volatile("s_waitcnt vmcnt(" #n ")" ::: "memory")
#define PG8_WAIT_L(n) asm volatile("s_waitcnt lgkmcnt(" #n ")" ::: "memory")
#define PG8_BAR __builtin_amdgcn_s_barrier()
#define PG8_SCHED __builtin_amdgcn_sched_barrier(0)
    Unit cur, nxt; int ui = 0;
    if (!S.next(0, cur)) return;
    f32x4 acc[2][2][4][2];
#pragma unroll
    for (int a = 0; a < 2; ++a)
#pragma unroll
        for (int b = 0; b < 2; ++b)
#pragma unroll
            for (int m = 0; m < 4; ++m)
#pragma unroll
                for (int n = 0; n < 2; ++n) acc[a][b][m][n] = (f32x4){0.f, 0.f, 0.f, 0.f};
    bf16x8 At[4][2], B0[2][2], B1[2][2];
    const char* cA = (const char*)g.A + (size_t)cur.pm * tstep; const char* cB = (const char*)g.Bt + (size_t)cur.pn * tstep;
    S.a_ready(cur);
    if constexpr (SP2) {
        PG8_STAGE(PG8_SB(0, 0), cB, voffB); PG8_STAGE(PG8_SB(0, 1), cB + hstep, voffB); PG8_STAGE(PG8_SA(0, 0), cA, voffA); PG8_STAGE(PG8_SA(0, 1), cA + hstep, voffA);
        if (wr == 1) PG8_BAR;
        PG8_WAIT_V(2); PG8_BAR;
        PG8_STAGE(PG8_SB(1, 0), cB + kstep, voffB); PG8_STAGE(PG8_SA(1, 0), cA + kstep, voffA); PG8_STAGE(PG8_SB(1, 1), cB + hstep + kstep, voffB);
        PG8_WAIT_V(6); PG8_BAR;
    } else {
        PG8_STAGE(PG8_SB(0, 0), cB, voffB); PG8_STAGE(PG8_SA(0, 0), cA, voffA); PG8_STAGE(PG8_SB(0, 1), cB + hstep, voffB); PG8_STAGE(PG8_SA(0, 1), cA + hstep, voffA);
        if (wr == 1) PG8_BAR;
        PG8_WAIT_V(4); PG8_BAR;
        PG8_STAGE(PG8_SB(1, 0), cB + kstep, voffB); PG8_STAGE(PG8_SA(1, 0), cA + kstep, voffA); PG8_STAGE(PG8_SB(1, 1), cB + hstep + kstep, voffB);
        PG8_WAIT_V(6); PG8_BAR;
    }
    for (;;) {
        const bool has_next = S.next(ui + 1, nxt);
        const char* nA = has_next ? (const char*)g.A + (size_t)nxt.pm * tstep : cA; const char* nB = has_next ? (const char*)g.Bt + (size_t)nxt.pn * tstep : cB;
        for (int t = 0; t < nt; t += 2) {
            const bool last = (t == nt - 2);
            const char* a1 = cA + (size_t)(t + 1) * kstep;
            const char* a2 = last ? nA : cA + (size_t)(t + 2) * kstep; const char* b2 = last ? nB : cB + (size_t)(t + 2) * kstep;
            const char* a3 = a2 + kstep; const char* b3 = b2 + kstep;
            if (last && has_next) S.a_ready(nxt);
            if constexpr (SP2) {
            PG8_LDB(B0, 0, 0); PG8_LDB(B1, 0, 1); PG8_SCHED; PG8_LDA(At, 0, 0); PG8_STAGE(PG8_SA(1, 1), a1 + hstep, voffA);
            PG8_WAIT_V(8); PG8_WAIT_L(0); PG8_BAR; PG8_MMA(0, 0, At, B0); PG8_MMA(0, 1, At, B1); PG8_BAR; PG8_SCHED;
            PG8_LDA(At, 0, 1); PG8_STAGE(PG8_SB(0, 0), b2, voffB); PG8_STAGE(PG8_SB(0, 1), b2 + hstep, voffB); PG8_STAGE(PG8_SA(0, 0), a2, voffA);
            PG8_WAIT_V(8); PG8_WAIT_L(0); PG8_BAR; PG8_MMA(1, 0, At, B0); PG8_MMA(1, 1, At, B1); PG8_BAR; PG8_SCHED;
            PG8_LDB(B0, 1, 0); PG8_LDB(B1, 1, 1); PG8_SCHED; PG8_LDA(At, 1, 0); PG8_STAGE(PG8_SA(0, 1), a2 + hstep, voffA);
            PG8_WAIT_V(8); PG8_WAIT_L(0); PG8_BAR; PG8_MMA(0, 0, At, B0); PG8_MMA(0, 1, At, B1); PG8_BAR; PG8_SCHED;
            PG8_LDA(At, 1, 1); PG8_STAGE(PG8_SB(1, 0), b3, voffB); PG8_STAGE(PG8_SB(1, 1), b3 + hstep, voffB); PG8_STAGE(PG8_SA(1, 0), a3, voffA);
            PG8_WAIT_V(8); PG8_WAIT_L(0); PG8_BAR; PG8_MMA(1, 0, At, B0); PG8_MMA(1, 1, At, B1); PG8_BAR; PG8_SCHED;
            } else {
            PG8_LDB(B0, 0, 0); PG8_SCHED; PG8_LDA(At, 0, 0); PG8_STAGE(PG8_SA(1, 1), a1 + hstep, voffA);
            PG8_WAIT_L(8); PG8_BAR; PG8_WAIT_L(0); PG8_MMA(0, 0, At, B0); PG8_BAR; PG8_SCHED;
            PG8_LDB(B1, 0, 1); PG8_STAGE(PG8_SB(0, 0), b2, voffB);
            PG8_BAR; PG8_WAIT_L(0); PG8_MMA(0, 1, At, B1); PG8_BAR;
            PG8_LDA(At, 0, 1); PG8_STAGE(PG8_SA(0, 0), a2, voffA);
            PG8_BAR; PG8_WAIT_L(0); PG8_MMA(1, 0, At, B0); PG8_BAR; PG8_SCHED;
            PG8_STAGE(PG8_SB(0, 1), b2 + hstep, voffB);
            PG8_WAIT_V(6); PG8_BAR; PG8_MMA(1, 1, At, B1); PG8_BAR;
            PG8_LDB(B0, 1, 0); PG8_SCHED; PG8_LDA(At, 1, 0); PG8_STAGE(PG8_SA(0, 1), a2 + hstep, voffA);
            PG8_WAIT_L(8); PG8_BAR; PG8_WAIT_L(0); PG8_MMA(0, 0, At, B0); PG8_BAR; PG8_SCHED;
            PG8_LDB(B1, 1, 1); PG8_STAGE(PG8_SB(1, 0), b3, voffB);
            PG8_BAR; PG8_WAIT_L(0); PG8_MMA(0, 1, At, B1); PG8_BAR;
            PG8_LDA(At, 1, 1); PG8_STAGE(PG8_SA(1, 0), a3, voffA);
            PG8_BAR; PG8_WAIT_L(0); PG8_MMA(1, 0, At, B0); PG8_BAR; PG8_SCHED;
            PG8_STAGE(PG8_SB(1, 1), b3 + hstep, voffB);
            PG8_WAIT_V(6); PG8_BAR; PG8_MMA(1, 1, At, B1); PG8_BAR;
            }
        }
        if constexpr (ALIGN_EPI) { if (wr == 0) PG8_BAR; }
        if constexpr (!Epi::AFTER_DRAIN) { E(acc, cur, wr, wc, fr, fq); S.done(cur); }
        if (!has_next) break;
#pragma unroll
        for (int a = 0; a < 2; ++a)
#pragma unroll
            for (int b = 0; b < 2; ++b)
#pragma unroll
                for (int m = 0; m < 4; ++m)
#pragma unroll
                    for (int n = 0; n < 2; ++n) acc[a][b][m][n] = (f32x4){0.f, 0.f, 0.f, 0.f};
        cur = nxt; cA = nA; cB = nB; ++ui;
        if constexpr (ALIGN_EPI) { if (wr == 1) PG8_BAR; }
    }
    PG8_WAIT_V(0);
    if constexpr (!ALIGN_EPI) { if (wr == 0) PG8_BAR; }
    PG8_BAR;
    if constexpr (Epi::AFTER_DRAIN) { E.fused(acc, cur, wr, wc, fr, fq, lds, wid, lane); S.done(cur); }
#undef PG8_SA
#undef PG8_SB
#undef PG8_STAGE
#undef PG8_LDA
#undef PG8_LDB
#undef PG8_MMA
#undef PG8_WAIT_V
#undef PG8_WAIT_L
#undef PG8_BAR
#undef PG8_SCHED
}
}

using pg8::bf16_t; using pg8::bf16x8; using pg8::f32x4; using pg8::u32x4; using pg8::cvt_pk_bf16;
typedef short bf16x4 __attribute__((ext_vector_type(4)));
typedef unsigned u32x2 __attribute__((ext_vector_type(2)));
#define LAS __attribute__((address_space(3)))

constexpr int DM = 1024, NB = 16, SEQ = 4096, DEPTH = 2, SB = 8, SS = 16;
constexpr int MP = NB * SEQ, MS = SB * SS, MREAL = MP + MS, MPAD = 65792;
constexpr int DIN = 1536, DFF = 4096, NPOS = SEQ + SS;
constexpr float EPS = 1e-6f;
constexpr int NTHR = 512, NWAVES = 8;
constexpr int LDS_BYTES = 147456 + 512, L_MISC = 147456, L_PTAB = 147456 + 64;

constexpr size_t O_Y = 0;
constexpr size_t O_CONVP = (size_t)MREAL * DM;
constexpr size_t O_LRUP = O_CONVP + (size_t)DEPTH * NB * 3 * 256;
constexpr size_t O_SREP = O_LRUP + (size_t)DEPTH * NB * 256;
constexpr size_t O_SIMP = O_SREP + (size_t)DEPTH * NB * 1024;
constexpr size_t O_KP = O_SIMP + (size_t)DEPTH * NB * 1024;
constexpr size_t O_VP = O_KP + (size_t)DEPTH * NB * 128 * 128;
constexpr size_t O_CONVS = O_VP + (size_t)DEPTH * NB * 128 * 128;
constexpr size_t O_LRUS = O_CONVS + (size_t)DEPTH * SB * 3 * 256;
constexpr size_t O_SRES = O_LRUS + (size_t)DEPTH * SB * 256;
constexpr size_t O_SIMS = O_SRES + (size_t)DEPTH * SB * 1024;
constexpr size_t O_KS = O_SIMS + (size_t)DEPTH * SB * 1024;
constexpr size_t O_VS = O_KS + (size_t)DEPTH * SB * 16 * 128;
constexpr size_t O_END = O_VS + (size_t)DEPTH * SB * 16 * 128;
static_assert(O_END == 68501504, "d_out map");

constexpr size_t WS_WIN = 0;
constexpr size_t WS_WOUT = WS_WIN + (size_t)DEPTH * DIN * DM * 2;
constexpr size_t WS_WUP = WS_WOUT + (size_t)DEPTH * DM * DM * 2;
constexpr size_t WS_WDN = WS_WUP + (size_t)DEPTH * DFF * DM * 2;
constexpr size_t WS_ROPE = WS_WDN + (size_t)DEPTH * DM * DFF * 2;
constexpr size_t WS_GATE = WS_ROPE + (size_t)NPOS * 32 * 8;
constexpr size_t WS_SP = WS_GATE + (size_t)DEPTH * 2 * 4 * 64 * 64 * 2;
constexpr size_t WS_ABAR = WS_SP + (size_t)DEPTH * 256 * 4;
constexpr size_t WS_BBM = WS_ABAR + (size_t)DEPTH * 16 * 64 * 4 * 4;
constexpr size_t WS_CMT = WS_BBM + (size_t)DEPTH * 16 * 128 * 16 * 2;
constexpr size_t WS_WGT = WS_CMT + (size_t)DEPTH * 16 * 16 * 128 * 2;
constexpr size_t WS_KBS = WS_WGT + (size_t)DEPTH * 256 * 256 * 2;
constexpr size_t WS_VTS = WS_KBS + (size_t)DEPTH * SB * 144 * 128 * 2;
constexpr size_t WS_SMALL = WS_VTS + (size_t)DEPTH * SB * 128 * 144 * 2;
constexpr int SM_CCONV = 0, SM_SLRU = SM_CCONV + DEPTH * SB * 3 * 256, SM_SSRE = SM_SLRU + DEPTH * SB * 256, SM_SSIM = SM_SSRE + DEPTH * SB * 1024, SM_CW = SM_SSIM + DEPTH * SB * 1024,
              SM_CB = SM_CW + DEPTH * 4 * 256, SM_BRG = SM_CB + DEPTH * 256, SM_BIG = SM_BRG + DEPTH * 256, SM_SD = SM_BIG + DEPTH * 256, SM_BGLU = SM_SD + DEPTH * 256,
              SM_SINK = SM_BGLU + DEPTH * 256, SM_NF = SM_SINK + 64, SM_END = SM_NF + DM;
constexpr size_t WS_SS = WS_SMALL + (size_t)((SM_END * 4 + 255) / 256) * 256;
constexpr size_t WS_SUMA = WS_SS + (size_t)MPAD * 16 * 4;
constexpr size_t WS_SUMB = WS_SUMA + (size_t)NB * 64 * 256 * 4;
constexpr size_t WS_SUMS = WS_SUMB + (size_t)NB * 64 * 256 * 4;
constexpr size_t WS_FOLD = WS_SUMS + (size_t)NB * 64 * 16 * 128 * 4;
constexpr size_t WS_XB = WS_FOLD + (size_t)320 * 16 * 128 * 4;
constexpr size_t WS_XRES = WS_XB + (size_t)MPAD * DM * 2;
constexpr size_t WS_BIG = WS_XRES + (size_t)MPAD * DM * 4;
constexpr size_t WS_UA = WS_BIG;
constexpr size_t WS_GA = WS_UA + (size_t)MPAD * 256 * 2;
constexpr size_t WS_UB = WS_GA + (size_t)MPAD * 256 * 2;
constexpr size_t WS_Q = WS_UB + (size_t)MPAD * 256 * 2;
constexpr size_t WS_KBP = WS_Q + (size_t)MPAD * 512 * 2;
constexpr size_t WS_VTP = WS_KBP + (size_t)MP * 128 * 2;
constexpr size_t WS_MIX = WS_VTP + (size_t)NB * 128 * SEQ * 2;
constexpr size_t WS_MIXEND = WS_MIX + (size_t)MPAD * DM * 2;
constexpr size_t WS_HID = WS_BIG;
constexpr size_t WS_END = WS_BIG + (size_t)MPAD * DFF * 2;
constexpr size_t WS_CTL = WS_END, CTL_BYTES = 16384;
constexpr size_t WS_TOTAL = WS_CTL + CTL_BYTES;
static_assert(WS_MIXEND <= WS_END && WS_TOTAL <= (size_t)1 << 30, "d_ws map");

struct Params { const float* in[33]; float* out; unsigned char* ws; };
enum { I_XP = 0, I_XS, I_CCONV, I_SLRU, I_SSRE, I_SSIM, I_CK, I_CV, I_N1, I_WIN, I_CW, I_CB, I_WRG, I_BRG, I_WIG, I_BIG_, I_LAM,
       I_ARE, I_AIM, I_BRE, I_BIM, I_CRE, I_CIM, I_SD, I_LDT, I_WGLU, I_BGLU, I_SINK, I_WOUT, I_N2, I_WUP, I_WDN, I_NF };

__device__ __forceinline__ float bf2f(short v) { return __uint_as_float(((unsigned)(unsigned short)v) << 16); }
__device__ __forceinline__ bf16_t f2bf(float v) { return (bf16_t)(cvt_pk_bf16(v, 0.f) & 0xffffu); }
__device__ __forceinline__ float sigmoidf_(float x) { return __builtin_amdgcn_rcpf(1.f + __expf(-x)); }
__device__ __forceinline__ float gelu_tanh(float x) { const float u = 1.5957691216f * (x + 0.044715f * x * x * x); return x * __builtin_amdgcn_rcpf(1.f + __expf(-u)); }
__device__ __forceinline__ f32x4 mma16(bf16x8 x, bf16x8 y, f32x4 acc) { return __builtin_amdgcn_mfma_f32_16x16x32_bf16(x, y, acc, 0, 0, 0); }
__device__ __forceinline__ float wave_sum(float v) {
#pragma unroll
    for (int o = 1; o < 64; o <<= 1) v += __shfl_xor(v, o);
    return v;
}
__device__ __forceinline__ void store8(bf16_t* dst, const float (&v)[8]) {
    u32x4 w; w.x = cvt_pk_bf16(v[0], v[1]); w.y = cvt_pk_bf16(v[2], v[3]); w.z = cvt_pk_bf16(v[4], v[5]); w.w = cvt_pk_bf16(v[6], v[7]);
    *(u32x4*)dst = w;
}
__device__ __forceinline__ float ss_rs(const float* ss, int row) {
    const f32x4* s4 = (const f32x4*)(ss + (size_t)row * 16);
    const f32x4 a = s4[0], b = s4[1], c = s4[2], d = s4[3];
    const float tot = (((a[0] + a[1]) + (a[2] + a[3])) + ((b[0] + b[1]) + (b[2] + b[3]))) + (((c[0] + c[1]) + (c[2] + c[3])) + ((d[0] + d[1]) + (d[2] + d[3])));
    return __builtin_amdgcn_rsqf(tot * (1.f / 1024.f) + EPS);
}
__device__ __forceinline__ void rope8(float (&v)[8], const float* rope, int pos, int jp) {
    const f32x4* r = (const f32x4*)(rope + ((size_t)pos * 32 + jp) * 2);
    const f32x4 a = r[0], b = r[1];
    float x1, x2;
    x1 = v[0]; x2 = v[1]; v[0] = x1 * a[0] - x2 * a[1]; v[1] = x2 * a[0] + x1 * a[1];
    x1 = v[2]; x2 = v[3]; v[2] = x1 * a[2] - x2 * a[3]; v[3] = x2 * a[2] + x1 * a[3];
    x1 = v[4]; x2 = v[5]; v[4] = x1 * b[0] - x2 * b[1]; v[5] = x2 * b[0] + x1 * b[1];
    x1 = v[6]; x2 = v[7]; v[6] = x1 * b[2] - x2 * b[3]; v[7] = x2 * b[2] + x1 * b[3];
}

__device__ __forceinline__ void rs8(float (&rsv)[2][4], const float* ss, int rowbase, int fq) {
    f32x4 part[2][4];
#pragma unroll
    for (int ai = 0; ai < 2; ++ai)
#pragma unroll
        for (int m = 0; m < 4; ++m) { const int row = rowbase + ai * 128 + m * 16;
            part[ai][m] = (f32x4){0.f, 0.f, 0.f, 0.f};
            if (row < MREAL) part[ai][m] = *(const f32x4*)(ss + (size_t)row * 16 + 4 * fq); }
#pragma unroll
    for (int ai = 0; ai < 2; ++ai)
#pragma unroll
        for (int m = 0; m < 4; ++m) { float t = (part[ai][m][0] + part[ai][m][1]) + (part[ai][m][2] + part[ai][m][3]);
            t += __shfl_xor(t, 16); t += __shfl_xor(t, 32);
            rsv[ai][m] = __builtin_amdgcn_rsqf(t * (1.f / 1024.f) + EPS); }
}

struct EpiIn {
    static constexpr bool PERM = true, AFTER_DRAIN = false;
    unsigned char* ws; float* out; int l;
    __device__ __forceinline__ void operator()(const f32x4 (&acc)[2][2][4][2], const pg8::Unit& u, int wr, int wc, int fr, int fq) const {
        asm volatile("" : "+v"(fr), "+v"(fq)); asm volatile("" : "+s"(wr), "+s"(wc));
        const int pn = u.pn;
        const float* ss = (const float*)(ws + WS_SS); const float* rope = (const float*)(ws + WS_ROPE);
        bf16_t* ua = (bf16_t*)(ws + WS_UA); bf16_t* ga = (bf16_t*)(ws + WS_GA); bf16_t* ub = (bf16_t*)(ws + WS_UB); bf16_t* q = (bf16_t*)(ws + WS_Q);
        bf16_t* kbp = (bf16_t*)(ws + WS_KBP); bf16_t* vtp = (bf16_t*)(ws + WS_VTP);
        bf16_t* kbs = (bf16_t*)(ws + WS_KBS) + (size_t)l * SB * 144 * 128; bf16_t* vts = (bf16_t*)(ws + WS_VTS) + (size_t)l * SB * 128 * 144;
        float* conv_p = out + O_CONVP + (size_t)l * NB * 3 * 256; float* conv_s = out + O_CONVS + (size_t)l * SB * 3 * 256;
        float* k_p = out + O_KP + (size_t)l * NB * 128 * 128; float* v_p = out + O_VP + (size_t)l * NB * 128 * 128;
        float* k_s = out + O_KS + (size_t)l * SB * 16 * 128; float* v_s = out + O_VS + (size_t)l * SB * 16 * 128;
        float rsv[2][4]; rs8(rsv, ss, u.pm * 256 + wr * 64 + fr, fq);
#pragma unroll
        for (int bjo = 0; bjo < 2; ++bjo) {
#pragma unroll
        for (int ai = 0; ai < 2; ++ai)
#pragma unroll
            for (int m = 0; m < 4; ++m) {
                const int row = u.pm * 256 + ai * 128 + wr * 64 + m * 16 + fr;
                if (row < MREAL) {
                    const float rs = rsv[ai][m];
                    const bool smp = row >= MP;
                    const int b = smp ? (row - MP) >> 4 : row >> 12, t = smp ? (row - MP) & 15 : row & 4095, pos = smp ? SEQ + t : t;
#pragma unroll
                    for (int bj = bjo; bj < bjo + 1; ++bj) {
                        const int c0 = bj * 128 + wc * 32 + fq * 8;
                        float v[8];
#pragma unroll
                        for (int e = 0; e < 4; ++e) { v[e] = acc[ai][bj][m][0][e] * rs; v[4 + e] = acc[ai][bj][m][1][e] * rs; }
                        if (pn <= 2) {
                            bf16_t* dst = (pn == 0 ? ua : (pn == 1 ? ga : ub)) + (size_t)row * 256 + c0;
                            store8(dst, v);
                            if (pn == 0) {
                                const int tt = smp ? t - (SS - 3) : t - (SEQ - 3);
                                if (tt >= 0) { float* o = (smp ? conv_s : conv_p) + (size_t)(b * 3 + tt) * 256 + c0;
                                    *(f32x4*)o = (f32x4){v[0], v[1], v[2], v[3]}; *(f32x4*)(o + 4) = (f32x4){v[4], v[5], v[6], v[7]}; }
                            }
                        } else if (pn <= 4) {
                            rope8(v, rope, pos, (c0 & 63) >> 1);
#pragma unroll
                            for (int e = 0; e < 8; ++e) v[e] *= 0.125f;
                            store8(q + (size_t)row * 512 + (pn - 3) * 256 + c0, v);
                        } else if (bj == 0) {
                            const int kvh = c0 >> 6, jp = (c0 & 63) >> 1;
                            rope8(v, rope, pos, jp);
                            bf16_t* dst = smp ? kbs + (size_t)(b * 144 + 128 + t) * 128 + c0 : kbp + (size_t)row * 128 + c0;
                            store8(dst, v);
                            const int tt = smp ? t : t - (SEQ - 128);
                            if (tt >= 0) { float* o = (smp ? k_s + ((size_t)(b * SS + tt) * 2 + kvh) * 64 : k_p + ((size_t)(b * 128 + tt) * 2 + kvh) * 64) + jp;
                                *(f32x4*)o = (f32x4){v[0], v[2], v[4], v[6]}; *(f32x4*)(o + 32) = (f32x4){v[1], v[3], v[5], v[7]}; }
                        } else {
                            const int cv = c0 - 128, kvh = cv >> 6, d0 = cv & 63;
                            if (!smp) { bf16_t* dst = vtp + (size_t)(b * 128 + cv) * SEQ + t;
#pragma unroll
                                for (int e = 0; e < 8; ++e) dst[(size_t)e * SEQ] = f2bf(v[e]);
                            } else { bf16_t* dst = vts + (size_t)(b * 128 + cv) * 144 + 128 + t;
#pragma unroll
                                for (int e = 0; e < 8; ++e) dst[e * 144] = f2bf(v[e]); }
                            const int tt = smp ? t : t - (SEQ - 128);
                            if (tt >= 0) { float* o = (smp ? v_s + ((size_t)(b * SS + tt) * 2 + kvh) * 64 : v_p + ((size_t)(b * 128 + tt) * 2 + kvh) * 64) + d0;
                                *(f32x4*)o = (f32x4){v[0], v[1], v[2], v[3]}; *(f32x4*)(o + 4) = (f32x4){v[4], v[5], v[6], v[7]}; }
                        }
                    }
                }
            }
        asm volatile("" ::: "memory");
        }
    }
};

struct EpiRes {
    static constexpr bool PERM = true, AFTER_DRAIN = false;
    const __attribute__((address_space(1))) float *xin_p, *xin_s;
    float *xout_p, *xout_s; bf16_t* xb; float* ss;
    __device__ __forceinline__ void operator()(const f32x4 (&acc)[2][2][4][2], const pg8::Unit& u, int wr, int wc, int fr, int fq) const {
        asm volatile("" : "+v"(fr), "+v"(fq)); asm volatile("" : "+s"(wr), "+s"(wc));
        const int pn = u.pn;
#pragma unroll
        for (int ai = 0; ai < 2; ++ai)
#pragma unroll
            for (int m = 0; m < 4; ++m) {
                const int row = u.pm * 256 + ai * 128 + wr * 64 + m * 16 + fr;
                const bool valid = row < MREAL;
                float sq = 0.f;
                if (valid) {
                    const size_t ro = row < MP ? (size_t)row * DM : (size_t)(row - MP) * DM;
                    const __attribute__((address_space(1))) float* xi = (row < MP ? xin_p : xin_s) + ro; float* xo = (row < MP ? xout_p : xout_s) + ro;
#pragma unroll
                    for (int bj = 0; bj < 2; ++bj) {
                        const int c = pn * 256 + bj * 128 + wc * 32 + fq * 8;
                        const f32x4 a0 = *(const __attribute__((address_space(1))) f32x4*)(xi + c) + acc[ai][bj][m][0], a1 = *(const __attribute__((address_space(1))) f32x4*)(xi + c + 4) + acc[ai][bj][m][1];
                        if (xout_p) { *(f32x4*)(xo + c) = a0; *(f32x4*)(xo + c + 4) = a1; }
                        sq += ((a0[0] * a0[0] + a0[1] * a0[1]) + (a0[2] * a0[2] + a0[3] * a0[3])) + ((a1[0] * a1[0] + a1[1] * a1[1]) + (a1[2] * a1[2] + a1[3] * a1[3]));
                        if (xb) { u32x4 w; w.x = cvt_pk_bf16(a0[0], a0[1]); w.y = cvt_pk_bf16(a0[2], a0[3]); w.z = cvt_pk_bf16(a1[0], a1[1]); w.w = cvt_pk_bf16(a1[2], a1[3]);
                            *(u32x4*)(xb + (size_t)row * DM + c) = w; }
                    }
                }
                sq += __shfl_xor(sq, 16); sq += __shfl_xor(sq, 32);
                if (valid && fq == 0) ss[(size_t)row * 16 + pn * 4 + wc] = sq;
            }
    }
};

struct EpiResB {
    static constexpr bool PERM = true, AFTER_DRAIN = false;
    bf16_t* xb; float* ss;
    __device__ __forceinline__ void operator()(const f32x4 (&acc)[2][2][4][2], const pg8::Unit& u, int wr, int wc, int fr, int fq) const {
        asm volatile("" : "+v"(fr), "+v"(fq)); asm volatile("" : "+s"(wr), "+s"(wc));
        const int pn = u.pn;
#pragma unroll
        for (int ai = 0; ai < 2; ++ai) {
            u32x4 xw[4][2];
#pragma unroll
            for (int m = 0; m < 4; ++m) {
                const int row = u.pm * 256 + ai * 128 + wr * 64 + m * 16 + fr;
#pragma unroll
                for (int bj = 0; bj < 2; ++bj) { xw[m][bj] = (u32x4){0u, 0u, 0u, 0u};
                    if (row < MREAL) xw[m][bj] = *(const u32x4*)(xb + (size_t)row * DM + pn * 256 + bj * 128 + wc * 32 + fq * 8); }
            }
#pragma unroll
            for (int m = 0; m < 4; ++m) {
                const int row = u.pm * 256 + ai * 128 + wr * 64 + m * 16 + fr;
                const bool valid = row < MREAL;
                float sq = 0.f;
#pragma unroll
                for (int bj = 0; bj < 2; ++bj) {
                    const int c = pn * 256 + bj * 128 + wc * 32 + fq * 8;
                    const u32x4 w0 = xw[m][bj];
                    const f32x4 x0 = {__uint_as_float(w0.x << 16), __uint_as_float(w0.x & 0xffff0000u), __uint_as_float(w0.y << 16), __uint_as_float(w0.y & 0xffff0000u)};
                    const f32x4 x1 = {__uint_as_float(w0.z << 16), __uint_as_float(w0.z & 0xffff0000u), __uint_as_float(w0.w << 16), __uint_as_float(w0.w & 0xffff0000u)};
                    const f32x4 a0 = x0 + acc[ai][bj][m][0], a1 = x1 + acc[ai][bj][m][1];
                    sq += ((a0[0] * a0[0] + a0[1] * a0[1]) + (a0[2] * a0[2] + a0[3] * a0[3])) + ((a1[0] * a1[0] + a1[1] * a1[1]) + (a1[2] * a1[2] + a1[3] * a1[3]));
                    u32x4 w; w.x = cvt_pk_bf16(a0[0], a0[1]); w.y = cvt_pk_bf16(a0[2], a0[3]); w.z = cvt_pk_bf16(a1[0], a1[1]); w.w = cvt_pk_bf16(a1[2], a1[3]);
                    if (valid) *(u32x4*)(xb + (size_t)row * DM + c) = w;
                }
                sq += __shfl_xor(sq, 16); sq += __shfl_xor(sq, 32);
                if (valid && fq == 0) ss[(size_t)row * 16 + pn * 4 + wc] = sq;
            }
            asm volatile("" ::: "memory");
        }
    }
};

struct EpiUp {
    static constexpr bool PERM = true, AFTER_DRAIN = false;
    const float* ss; bf16_t* hid;
    __device__ __forceinline__ void operator()(const f32x4 (&acc)[2][2][4][2], const pg8::Unit& u, int wr, int wc, int fr, int fq) const {
        asm volatile("" : "+v"(fr), "+v"(fq)); asm volatile("" : "+s"(wr), "+s"(wc));
        float rsv[2][4]; rs8(rsv, ss, u.pm * 256 + wr * 64 + fr, fq);
#pragma unroll
        for (int ai = 0; ai < 2; ++ai)
#pragma unroll
            for (int m = 0; m < 4; ++m) {
                const int row = u.pm * 256 + ai * 128 + wr * 64 + m * 16 + fr;
                if (row < MREAL) {
                    const float rs = rsv[ai][m];
#pragma unroll
                    for (int bj = 0; bj < 2; ++bj) {
                        const int c = u.pn * 256 + bj * 128 + wc * 32 + fq * 8;
                        float v[8];
#pragma unroll
                        for (int e = 0; e < 4; ++e) { float a = fmaxf(acc[ai][bj][m][0][e] * rs, 0.f), b = fmaxf(acc[ai][bj][m][1][e] * rs, 0.f); v[e] = a * a; v[4 + e] = b * b; }
                        store8(hid + (size_t)row * DFF + c, v);
                    }
                }
            }
    }
};

#define WSP(T, off) ((T*)(p.ws + (off)))
#define INP(i) ((const float*)(((const LAS unsigned long long*)(lds + L_PTAB))[i]))
#define LDS_WAIT() asm volatile("s_waitcnt lgkmcnt(0)" ::: "memory")

__device__ __forceinline__ void sincos_d(double x, double& s, double& c) {
    const double TWO_PI = 6.283185307179586476925;
    const double k = rint(x / TWO_PI), r = x - k * TWO_PI, r2 = r * r;
    double ps = 1.0, pc = 1.0;
#pragma unroll
    for (int n = 15; n >= 1; --n) { ps = 1.0 - r2 / ((2.0 * n) * (2.0 * n + 1.0)) * ps; pc = 1.0 - r2 / ((2.0 * n - 1.0) * (2.0 * n)) * pc; }
    s = r * ps; c = pc;
}

template <int MODE>
__device__ __forceinline__ void transpose_item(const float* W, const float* gain, int K, int N, bf16_t* WT, LAS float* scr, int item, int lane) {
    const int nblk = N / 32, kb = item / nblk, nb = item % nblk, k0 = 64 * kb, n0 = 32 * nb;
    float wv[32];
#pragma unroll
    for (int i = 0; i < 32; ++i) wv[i] = W[(size_t)(k0 + 2 * i + (lane >> 5)) * N + n0 + (lane & 31)];
    if (gain) {
#pragma unroll
        for (int i = 0; i < 32; ++i) wv[i] *= gain[k0 + 2 * i + (lane >> 5)];
    }
#pragma unroll
    for (int i = 0; i < 32; ++i) scr[(2 * i + (lane >> 5)) * 33 + (lane & 31)] = wv[i];
    LDS_WAIT();
    const int c = lane & 7;
#pragma unroll
    for (int j = 0; j < 4; ++j) { const int n = (lane >> 3) + 8 * j; const LAS float* s = scr + (8 * c) * 33 + n;
        u32x4 o; o.x = cvt_pk_bf16(s[0 * 33], s[1 * 33]); o.y = cvt_pk_bf16(s[2 * 33], s[3 * 33]); o.z = cvt_pk_bf16(s[4 * 33], s[5 * 33]); o.w = cvt_pk_bf16(s[6 * 33], s[7 * 33]);
        int nn = n0 + n;
        if (MODE == 1 && nn >= 768 && nn < 1408) { const int r = nn - 768, d = r & 63; nn = 768 + (r & ~63) + 2 * (d & 31) + (d >> 5); }
        *(u32x4*)(WT + (size_t)nn * K + k0 + 8 * c) = o; }
    LDS_WAIT();
}

__device__ __forceinline__ void prologue(const Params& p, LAS unsigned char* lds) {
    const int tid = threadIdx.x, lane = tid & 63, wave = tid >> 6;
    const int gw = blockIdx.x * NWAVES + wave, NGW = gridDim.x * NWAVES, gt = blockIdx.x * NTHR + tid, NGT = gridDim.x * NTHR;
    LAS float* scr = (LAS float*)(lds + wave * 16384);
#pragma unroll 1
    for (int ph = 0; ph < 2; ++ph) {
      if (((ph ^ wave) & 1) == 0) {
    constexpr int I_IN = 16 * 48, I_OUT = 16 * 32, I_UP = 16 * 128, I_DN = 64 * 32, I_L = I_IN + I_OUT + I_UP + I_DN;
    for (int it = gw; it < DEPTH * I_L; it += NGW) {
        const int l = it / I_L; int r = it % I_L;
        if (r < I_IN) { transpose_item<1>(INP(I_WIN) + (size_t)l * DM * DIN, INP(I_N1) + l * DM, DM, DIN, WSP(bf16_t, WS_WIN) + (size_t)l * DIN * DM, scr, r, lane); continue; } r -= I_IN;
        if (r < I_OUT) { transpose_item<0>(INP(I_WOUT) + (size_t)l * DM * DM, nullptr, DM, DM, WSP(bf16_t, WS_WOUT) + (size_t)l * DM * DM, scr, r, lane); continue; } r -= I_OUT;
        if (r < I_UP) { transpose_item<0>(INP(I_WUP) + (size_t)l * DM * DFF, INP(I_N2) + l * DM, DM, DFF, WSP(bf16_t, WS_WUP) + (size_t)l * DFF * DM, scr, r, lane); continue; } r -= I_UP;
        transpose_item<0>(INP(I_WDN) + (size_t)l * DFF * DM, nullptr, DFF, DM, WSP(bf16_t, WS_WDN) + (size_t)l * DM * DFF, scr, r, lane);
    }
      } else {
    {
        bf16_t* xb = WSP(bf16_t, WS_XB); float* ss = WSP(float, WS_SS);
        static_assert(MPAD % 4 == 0 && MREAL % 4 == 0 && MP % 4 == 0, "row groups of 4");
#pragma unroll 1
        for (int row0 = gw * 4; row0 < MPAD; row0 += NGW * 4) {
            f32x4 v[4][4];
            if (row0 < MREAL) {
                const float* xbase = row0 < MP ? INP(I_XP) + (size_t)row0 * DM : INP(I_XS) + (size_t)(row0 - MP) * DM;
#pragma unroll
                for (int r = 0; r < 4; ++r)
#pragma unroll
                    for (int j = 0; j < 4; ++j) v[r][j] = ((const f32x4*)(xbase + (size_t)r * DM) + lane)[64 * j];
            } else {
#pragma unroll
                for (int r = 0; r < 4; ++r)
#pragma unroll
                    for (int j = 0; j < 4; ++j) v[r][j] = (f32x4){0.f, 0.f, 0.f, 0.f};
            }
#pragma unroll
            for (int r = 0; r < 4; ++r) {
                float sq = 0.f;
#pragma unroll
                for (int j = 0; j < 4; ++j) sq += (v[r][j][0] * v[r][j][0] + v[r][j][1] * v[r][j][1]) + (v[r][j][2] * v[r][j][2] + v[r][j][3] * v[r][j][3]);
                const float tot = wave_sum(sq);
                unsigned long long* o8 = (unsigned long long*)(xb + (size_t)(row0 + r) * DM) + lane;
#pragma unroll
                for (int j = 0; j < 4; ++j) o8[64 * j] = (unsigned long long)cvt_pk_bf16(v[r][j][0], v[r][j][1]) | ((unsigned long long)cvt_pk_bf16(v[r][j][2], v[r][j][3]) << 32);
                if (lane < 16) ss[(size_t)(row0 + r) * 16 + lane] = lane == 0 ? tot : 0.f;
            }
        }
    }
      }
    }
    { float* sm = WSP(float, WS_SMALL);
#define CPY(I, OFF, N) for (int idx = gt; idx < (N); idx += NGT) sm[(OFF) + idx] = INP(I)[idx];
      CPY(I_CCONV, SM_CCONV, DEPTH * SB * 3 * 256) CPY(I_SLRU, SM_SLRU, DEPTH * SB * 256) CPY(I_SSRE, SM_SSRE, DEPTH * SB * 1024) CPY(I_SSIM, SM_SSIM, DEPTH * SB * 1024)
      CPY(I_CW, SM_CW, DEPTH * 4 * 256) CPY(I_CB, SM_CB, DEPTH * 256) CPY(I_BRG, SM_BRG, DEPTH * 256) CPY(I_BIG_, SM_BIG, DEPTH * 256) CPY(I_SD, SM_SD, DEPTH * 256)
      CPY(I_BGLU, SM_BGLU, DEPTH * 256) CPY(I_SINK, SM_SINK, DEPTH * 8) CPY(I_NF, SM_NF, DM)
#undef CPY
    }
    { float* rope = WSP(float, WS_ROPE);
      for (int idx = gt; idx < NPOS * 32; idx += NGT) { const int pos = idx >> 5, j = idx & 31;
          const float invf = (float)exp(-(double)j * (9.210340371976184 / 32.0)); double s, c; sincos_d((double)pos * (double)invf, s, c);
          rope[2 * idx] = (float)c; rope[2 * idx + 1] = (float)s; } }
    { bf16_t* gate = WSP(bf16_t, WS_GATE);
      for (int idx = gt; idx < DEPTH * 2 * 4 * 64 * 64; idx += NGT) { const int k = idx & 63, n = (idx >> 6) & 63, h = (idx >> 12) & 3, gt_ = (idx >> 14) & 1, l = idx >> 15;
          gate[idx] = f2bf((gt_ ? INP(I_WIG) : INP(I_WRG))[((size_t)(l * 4 + h) * 64 + k) * 64 + n]); } }
    { float* sp = WSP(float, WS_SP);
      for (int idx = gt; idx < DEPTH * 256; idx += NGT) sp[idx] = (float)log1p(exp(-(double)INP(I_LAM)[idx])); }
    { float* abar = WSP(float, WS_ABAR); bf16_t* bbm = WSP(bf16_t, WS_BBM);
      for (int idx = gt; idx < DEPTH * 16 * 64; idx += NGT) { const int lg = idx >> 6, pp = idx & 63;
          const double dt = exp((double)INP(I_LDT)[lg]), lr = (double)INP(I_ARE)[idx], li = (double)INP(I_AIM)[idx], mag = exp(lr * dt);
          double sn, cs; sincos_d(li * dt, sn, cs);
          const double ar = mag * cs, ai = mag * sn, den = lr * lr + li * li, nr = ar - 1.0, fr = (nr * lr + ai * li) / den, fi = (ai * lr - nr * li) / den;
          double xr = ar, xi = ai;
#pragma unroll
          for (int q = 0; q < 6; ++q) { const double t = xr * xr - xi * xi; xi = 2.0 * xr * xi; xr = t; }
          *(f32x4*)(abar + (size_t)idx * 4) = (f32x4){(float)ar, (float)ai, (float)xr, (float)xi};
          for (int c = 0; c < 16; ++c) { const double br = (double)INP(I_BRE)[(size_t)idx * 16 + c], bi = (double)INP(I_BIM)[(size_t)idx * 16 + c];
              bbm[((size_t)lg * 128 + pp) * 16 + c] = f2bf((float)(fr * br - fi * bi)); bbm[((size_t)lg * 128 + 64 + pp) * 16 + c] = f2bf((float)(fr * bi + fi * br)); } } }
    { bf16_t* cmt = WSP(bf16_t, WS_CMT);
      for (int idx = gt; idx < DEPTH * 16 * 16 * 128; idx += NGT) { const int k = idx & 127, lgc = idx >> 7;
          cmt[idx] = f2bf(k < 64 ? INP(I_CRE)[(size_t)lgc * 64 + k] : -INP(I_CIM)[(size_t)lgc * 64 + k - 64]); } }
    { bf16_t* wgt = WSP(bf16_t, WS_WGT);
      for (int idx = gt; idx < DEPTH * 65536; idx += NGT) { const int k = idx & 255, n = (idx >> 8) & 255, l = idx >> 16;
          wgt[idx] = f2bf(INP(I_WGLU)[((size_t)l * 256 + k) * 256 + n]); } }
    { bf16_t* kbs = WSP(bf16_t, WS_KBS); bf16_t* vts = WSP(bf16_t, WS_VTS);
      for (int idx = gt; idx < DEPTH * SB * 128 * 128; idx += NGT) { const int col = idx & 127, i = (idx >> 7) & 127, lb = idx >> 14;
          const int kvh = col >> 6, ph = col & 63, d = (ph >> 1) + 32 * (ph & 1);
          kbs[((size_t)lb * 144 + i) * 128 + col] = f2bf(INP(I_CK)[(((size_t)lb * 128 + i) * 2 + kvh) * 64 + d]);
          vts[((size_t)lb * 128 + col) * 144 + i] = f2bf(INP(I_CV)[((size_t)lb * 128 + i) * 128 + col]); } }
}

constexpr int L_AL = 0, L_BL = 33792;
constexpr int L_BU = 0;
constexpr int L_UA = 67584;
constexpr int L_SL = 67584;
constexpr int L_UZ = 103424;
constexpr int L_PAR = 137216;
constexpr int L_KL = 0, L_VL = 52224;
constexpr int UP = 264;
constexpr int P_CW = 0, P_CB = 1024, P_BRG = 1280, P_BIG = 1536, P_SP = 1792, P_SD = 2048, P_BGLU = 2304;
static_assert(L_PAR + 2560 * 4 <= L_MISC && L_UA + 67 * UP * 2 <= L_UZ && L_UZ + 64 * UP * 2 <= L_PAR && L_VL + 128 * 400 <= L_UZ, "mixer LDS map");

template <int NT, bool SMP>
__device__ __forceinline__ void stage_uab(const Params& p, int l, int b, int c, LAS unsigned char* lds) {
    int tid_ = threadIdx.x; asm volatile("" : "+v"(tid_));
    const int tid = tid_;
    const bf16_t* ua = WSP(const bf16_t, WS_UA); const bf16_t* ub = WSP(const bf16_t, WS_UB);
    const size_t seq0 = SMP ? (size_t)MP + b * SS : (size_t)b * SEQ;
    const int ts0 = SMP ? 0 : c * 64;
    constexpr int NR = NT * 16 + 3, NIA = (NR * 32 + NTHR - 1) / NTHR, NIB = (NT * 16 * 32 + NTHR - 1) / NTHR;
    u32x4 va[NIA], vb[NIB];
#pragma unroll
    for (int i = 0; i < NIA; ++i) { const int idx = tid + i * NTHR, r = idx >> 5, ck = idx & 31, ts = ts0 - 3 + r;
        va[i] = (u32x4){0u, 0u, 0u, 0u};
        if (idx < NR * 32) {
            if (ts >= 0) va[i] = *(const u32x4*)(ua + (seq0 + ts) * 256 + 8 * ck);
            else if (SMP) { const float* h = WSP(const float, WS_SMALL) + SM_CCONV + ((size_t)(l * SB + b) * 3 + (3 + ts)) * 256 + 8 * ck;
                const f32x4 x = *(const f32x4*)h, y = *(const f32x4*)(h + 4);
                va[i] = (u32x4){cvt_pk_bf16(x[0], x[1]), cvt_pk_bf16(x[2], x[3]), cvt_pk_bf16(y[0], y[1]), cvt_pk_bf16(y[2], y[3])}; }
        } }
#pragma unroll
    for (int i = 0; i < NIB; ++i) { const int idx = tid + i * NTHR, t = idx >> 5, ck = idx & 31;
        vb[i] = (u32x4){0u, 0u, 0u, 0u};
        if (idx < NT * 16 * 32) vb[i] = *(const u32x4*)(ub + (seq0 + ts0 + t) * 256 + 8 * ck); }
#pragma unroll
    for (int i = 0; i < NIA; ++i) { const int idx = tid + i * NTHR, r = idx >> 5, ck = idx & 31;
        if (idx < NR * 32) *(LAS u32x4*)(lds + L_UA + r * (UP * 2) + ck * 16) = va[i]; }
#pragma unroll
    for (int i = 0; i < NIB; ++i) { const int idx = tid + i * NTHR, t = idx >> 5, ck = idx & 31;
        if (idx < NT * 16 * 32) *(LAS u32x4*)(lds + L_UZ + t * (UP * 2) + ck * 16) = vb[i]; }
}

template <int NV>
__device__ __forceinline__ void conv_lds(float (&xc)[NV], const LAS bf16_t* uaL, const LAS float* par, int tl, int ch) {
#pragma unroll
    for (int e = 0; e < NV; e += 4) { const f32x4 cb = *(const LAS f32x4*)(par + P_CB + ch + e); xc[e] = cb[0]; xc[e + 1] = cb[1]; xc[e + 2] = cb[2]; xc[e + 3] = cb[3]; }
#pragma unroll
    for (int j = 0; j < 4; ++j) {
        float w[NV];
#pragma unroll
        for (int e = 0; e < NV; e += 4) { const f32x4 cw = *(const LAS f32x4*)(par + P_CW + j * 256 + ch + e); w[e] = cw[0]; w[e + 1] = cw[1]; w[e + 2] = cw[2]; w[e + 3] = cw[3]; }
        const LAS bf16_t* src = uaL + (tl + j) * UP + ch;
        if constexpr (NV == 8) { const bf16x8 v = *(const LAS bf16x8*)src;
#pragma unroll
            for (int e = 0; e < 8; ++e) xc[e] += bf2f(v[e]) * w[e];
        } else { const bf16x4 v = *(const LAS bf16x4*)src;
#pragma unroll
            for (int e = 0; e < 4; ++e) xc[e] += bf2f(v[e]) * w[e]; }
    }
}

template <int NT, bool SMP>
__device__ __forceinline__ void lru_item(const Params& p, int l, int b, int c, int pass, LAS unsigned char* lds, float& hfold, int cprev) {
    constexpr int HT = NT >= 2 ? 2 : 1, NH = NT / HT, TS = HT * 16 + 1, NPF = HT * 16 * 128 / NTHR;
    LAS float* aL = (LAS float*)(lds + L_AL); LAS float* bL = (LAS float*)(lds + L_BL);
    const LAS bf16_t* uaL = (const LAS bf16_t*)(lds + L_UA); const LAS float* par = (const LAS float*)(lds + L_PAR);
    int tid_ = threadIdx.x; asm volatile("" : "+v"(tid_));
    const int tid = tid_, wid = __builtin_amdgcn_readfirstlane(tid >> 6), lane = tid & 63, l15 = lane & 15, g = lane >> 4, h = wid >> 1, nh = wid & 1;
    const bf16_t* ga = WSP(const bf16_t, WS_GA); bf16_t* mix = WSP(bf16_t, WS_MIX);
    const size_t row0 = SMP ? (size_t)MP + b * SS : (size_t)b * SEQ + c * 64;
    const bf16_t* gwt = WSP(const bf16_t, WS_GATE) + (size_t)l * 2 * 4 * 4096;
    bf16x8 xr[2][2], xi[2][2];
#pragma unroll
    for (int nt2 = 0; nt2 < 2; ++nt2)
#pragma unroll
        for (int ks = 0; ks < 2; ++ks) { const int n = 32 * nh + 16 * nt2 + l15;
            xr[nt2][ks] = *(const bf16x8*)(gwt + ((size_t)(0 * 4 + h) * 64 + n) * 64 + 32 * ks + 8 * g);
            xi[nt2][ks] = *(const bf16x8*)(gwt + ((size_t)(1 * 4 + h) * 64 + n) * 64 + 32 * ks + 8 * g); }
    float fA[16], fB[16], hsm = 0.f;
#pragma unroll
    for (int i = 0; i < 16; ++i) { fA[i] = 1.f; fB[i] = 0.f; }
    if (tid < 256) {
        if (SMP) hsm = WSP(const float, WS_SMALL)[SM_SLRU + (size_t)(l * SB + b) * 256 + tid];
        else if (pass == 1) {
            const float* sA = WSP(const float, WS_SUMA) + (size_t)b * 64 * 256 + tid; const float* sB = WSP(const float, WS_SUMB) + (size_t)b * 64 * 256 + tid;
#pragma unroll
            for (int i = 0; i < 16; ++i) { const int cc = cprev + i < 63 ? cprev + i : 63; fA[i] = sA[cc * 256]; fB[i] = sB[cc * 256]; }
        }
    }
    {
        const int cgp = tid & 31, t0 = NT * (tid >> 5);
        float w[4][8], xc[NT][8];
#pragma unroll
        for (int j = 0; j < 4; ++j)
#pragma unroll
            for (int e = 0; e < 8; e += 4) { const f32x4 cw = *(const LAS f32x4*)(par + P_CW + j * 256 + 8 * cgp + e); w[j][e] = cw[0]; w[j][e + 1] = cw[1]; w[j][e + 2] = cw[2]; w[j][e + 3] = cw[3]; }
#pragma unroll
        for (int e = 0; e < 8; e += 4) { const f32x4 cb = *(const LAS f32x4*)(par + P_CB + 8 * cgp + e);
#pragma unroll
            for (int tk = 0; tk < NT; ++tk) { xc[tk][e] = cb[0]; xc[tk][e + 1] = cb[1]; xc[tk][e + 2] = cb[2]; xc[tk][e + 3] = cb[3]; } }
#pragma unroll
        for (int i = 0; i < NT + 3; ++i) { const bf16x8 v = *(const LAS bf16x8*)(uaL + (t0 + i) * UP + 8 * cgp);
#pragma unroll
            for (int tk = 0; tk < NT; ++tk) { const int j = i - tk; if (j >= 0 && j < 4) {
#pragma unroll
                for (int e = 0; e < 8; ++e) xc[tk][e] += bf2f(v[e]) * w[j][e]; } } }
        __syncthreads();
#pragma unroll
        for (int tk = 0; tk < NT; ++tk) { u32x4 o; o.x = cvt_pk_bf16(xc[tk][0], xc[tk][1]); o.y = cvt_pk_bf16(xc[tk][2], xc[tk][3]); o.z = cvt_pk_bf16(xc[tk][4], xc[tk][5]); o.w = cvt_pk_bf16(xc[tk][6], xc[tk][7]);
            *(LAS u32x4*)((LAS unsigned char*)(lds + L_UA) + ((t0 + tk) * UP + 8 * cgp) * 2) = o; }
        __syncthreads();
    }
    float hrun = 0.f, prun = 1.f;
    if (tid < 256) {
        if (SMP) hrun = hsm;
        else if (pass == 1) {
            float hf = hfold;
#pragma unroll
            for (int i = 0; i < 16; ++i) if (cprev + i < c) hf = fA[i] * hf + fB[i];
            hfold = hf; hrun = hf;
        }
    }
#pragma unroll 1
    for (int half = 0; half < NH; ++half) {
        unsigned gp[NPF];
        if (pass == 1) {
#pragma unroll
            for (int k = 0; k < NPF; ++k) { const int idx = tid + k * NTHR, t = idx >> 7, ch = 2 * (idx & 127); gp[k] = *(const unsigned*)(ga + (row0 + half * HT * 16 + t) * 256 + ch); }
        }
        f32x4 ar[2][HT], ai_[2][HT];
#pragma unroll
        for (int a = 0; a < 2; ++a)
#pragma unroll
            for (int t = 0; t < HT; ++t) { ar[a][t] = (f32x4){0.f, 0.f, 0.f, 0.f}; ai_[a][t] = (f32x4){0.f, 0.f, 0.f, 0.f}; }
#pragma unroll
        for (int tt = 0; tt < HT; ++tt) {
            const int tl = (half * HT + tt) * 16 + l15;
#pragma unroll
            for (int ks = 0; ks < 2; ++ks) {
                const bf16x8 y = *(const LAS bf16x8*)(uaL + tl * UP + 64 * h + 32 * ks + 8 * g);
#pragma unroll
                for (int nt2 = 0; nt2 < 2; ++nt2) { ar[nt2][tt] = mma16(xr[nt2][ks], y, ar[nt2][tt]); ai_[nt2][tt] = mma16(xi[nt2][ks], y, ai_[nt2][tt]); }
            }
        }
#pragma unroll
        for (int nt2 = 0; nt2 < 2; ++nt2)
#pragma unroll
            for (int tt = 0; tt < HT; ++tt) {
                const int tl = (half * HT + tt) * 16 + l15, ch0 = 64 * h + 32 * nh + 16 * nt2 + 4 * g;
                const bf16x4 xv = *(const LAS bf16x4*)(uaL + tl * UP + ch0);
                const f32x4 br4 = *(const LAS f32x4*)(par + P_BRG + ch0), bi4 = *(const LAS f32x4*)(par + P_BIG + ch0), sp4 = *(const LAS f32x4*)(par + P_SP + ch0);
#pragma unroll
                for (int j = 0; j < 4; ++j) { const int ch = ch0 + j;
                    const float r = sigmoidf_(ar[nt2][tt][j] + br4[j]), ig = sigmoidf_(ai_[nt2][tt][j] + bi4[j]);
                    const float la = -8.0f * r * sp4[j], a = __expf(la), x2 = 2.0f * la;
                    const float ser = -x2 * (1.0f + x2 * (0.5f + x2 * (0.16666667f + x2 * (0.041666668f + x2 * 0.008333334f))));
                    const float mult = __builtin_amdgcn_sqrtf(x2 > -0.25f ? ser : 1.0f - a * a);
                    aL[ch * TS + tt * 16 + l15] = a; bL[ch * TS + tt * 16 + l15] = mult * ig * bf2f(xv[j]); }
            }
        __syncthreads();
        if (tid < 256) {
#pragma unroll 8
            for (int t = 0; t < HT * 16; ++t) { const float a = aL[tid * TS + t]; hrun = a * hrun + bL[tid * TS + t]; prun *= a; bL[tid * TS + t] = hrun; }
        }
        __syncthreads();
        if (pass == 1) {
#pragma unroll
            for (int k = 0; k < NPF; ++k) { const int idx = tid + k * NTHR, t = idx >> 7, ch = 2 * (idx & 127); const size_t row = row0 + half * HT * 16 + t;
                const float h0 = bL[ch * TS + t], h1 = bL[(ch + 1) * TS + t];
                const float g0 = __uint_as_float(gp[k] << 16), g1 = __uint_as_float(gp[k] & 0xffff0000u);
                *(unsigned*)(mix + row * DM + ch) = cvt_pk_bf16(h0 * gelu_tanh(g0), h1 * gelu_tanh(g1)); }
        }
        __syncthreads();
    }
    if (tid < 256) {
        if (!SMP && pass == 0) { WSP(float, WS_SUMA)[((size_t)b * 64 + c) * 256 + tid] = prun; WSP(float, WS_SUMB)[((size_t)b * 64 + c) * 256 + tid] = hrun; }
        if (pass == 1) { if (SMP) p.out[O_LRUS + (size_t)(l * SB + b) * 256 + tid] = hrun; else if (c == 63) p.out[O_LRUP + (size_t)(l * NB + b) * 256 + tid] = hrun; }
    }
}

template <int NT, bool SMP>
__device__ __forceinline__ void s5_item(const Params& p, int l, int b, int c, int pass, LAS unsigned char* lds, int cprev) {
    const bool fin = SMP || pass == 1;
    int tid_ = threadIdx.x; asm volatile("" : "+v"(tid_));
    const int tid = tid_, wid = __builtin_amdgcn_readfirstlane(tid >> 6), lane = tid & 63, l15 = lane & 15, g = lane >> 4;
    LAS float* buL = (LAS float*)(lds + L_BU + wid * 8448);
    LAS bf16_t* sL = (LAS bf16_t*)(lds + L_SL + wid * 4352);
    LAS bf16_t* uz = (LAS bf16_t*)(lds + L_UZ);
    const LAS float* par = (const LAS float*)(lds + L_PAR);
    bf16_t* mix = WSP(bf16_t, WS_MIX);
    const size_t row0 = SMP ? (size_t)MP + b * SS : (size_t)b * SEQ + c * 64;
    const float* abar = WSP(const float, WS_ABAR); const bf16_t* bbm = WSP(const bf16_t, WS_BBM); const bf16_t* cmt = WSP(const bf16_t, WS_CMT);
    const bf16x8 z8 = {0, 0, 0, 0, 0, 0, 0, 0};
    float zf = 0.f; asm volatile("" : "+v"(zf));
#pragma unroll 1
    for (int gi = 0; gi < 2; ++gi) {
        const int grp = 2 * wid + gi, lg = l * 16 + grp;
        const f32x4 ab = *(const f32x4*)(abar + ((size_t)lg * 64 + lane) * 4);
        float sre = 0.f, sim = 0.f;
        if (SMP) { sre = WSP(const float, WS_SMALL)[SM_SSRE + ((size_t)(l * SB + b) * 16 + grp) * 64 + lane]; sim = WSP(const float, WS_SMALL)[SM_SSIM + ((size_t)(l * SB + b) * 16 + grp) * 64 + lane]; }
        else if (pass == 1) {
            float* fs = WSP(float, WS_FOLD) + ((size_t)blockIdx.x * 16 + grp) * 128 + lane;
            if (cprev > 0) { sre = fs[0]; sim = fs[64]; }
            const float* S = WSP(const float, WS_SUMS) + ((size_t)b * 64 * 16 + grp) * 128 + lane;
            float re[16], im[16];
#pragma unroll
            for (int i = 0; i < 16; ++i) { const int cc = cprev + i < 63 ? cprev + i : 63; re[i] = S[(size_t)cc * 2048]; im[i] = S[(size_t)cc * 2048 + 64]; }
#pragma unroll
            for (int i = 0; i < 16; ++i) if (cprev + i < c) { const float nre = ab[2] * sre - ab[3] * sim + re[i], nim = ab[2] * sim + ab[3] * sre + im[i]; sre = nre; sim = nim; }
            fs[0] = sre; fs[64] = sim;
        }
        bf16x8 ybb[8], ycm[4];
#pragma unroll
        for (int pt = 0; pt < 8; ++pt) ybb[pt] = g < 2 ? *(const bf16x8*)(bbm + ((size_t)lg * 128 + 16 * pt + l15) * 16 + 8 * g) : z8;
#pragma unroll
        for (int ks = 0; ks < 4; ++ks) ycm[ks] = *(const bf16x8*)(cmt + ((size_t)lg * 16 + l15) * 128 + 32 * ks + 8 * g);
        const float dd = par[P_SD + 16 * grp + l15];
#pragma unroll 1
        for (int tt = 0; tt < NT; ++tt) {
            const bf16x8 x = g < 2 ? *(const LAS bf16x8*)(uz + (tt * 16 + l15) * UP + 16 * grp + 8 * g) : z8;
            LAS bf16_t* buT = (LAS bf16_t*)buL;
#pragma unroll
            for (int pt = 0; pt < 8; ++pt) { const f32x4 a = mma16(x, ybb[pt], (f32x4){0.f, 0.f, 0.f, 0.f});
                u32x2 w; w.x = cvt_pk_bf16(a[0] + zf, a[1] + zf); w.y = cvt_pk_bf16(a[2] + zf, a[3] + zf);
                *(LAS u32x2*)(buT + (16 * pt + l15) * 24 + 4 * g) = w; }
            LDS_WAIT();
            {
                const u32x4 r0 = *(const LAS u32x4*)(buT + lane * 24), r1 = *(const LAS u32x4*)(buT + lane * 24 + 8);
                const u32x4 i0 = *(const LAS u32x4*)(buT + (64 + lane) * 24), i1 = *(const LAS u32x4*)(buT + (64 + lane) * 24 + 8);
                const unsigned rw[8] = {r0.x, r0.y, r0.z, r0.w, r1.x, r1.y, r1.z, r1.w}, iw[8] = {i0.x, i0.y, i0.z, i0.w, i1.x, i1.y, i1.z, i1.w};
#pragma unroll
                for (int t = 0; t < 16; ++t) {
                    const float re = (t & 1) ? __uint_as_float(rw[t >> 1] & 0xffff0000u) : __uint_as_float(rw[t >> 1] << 16);
                    const float im = (t & 1) ? __uint_as_float(iw[t >> 1] & 0xffff0000u) : __uint_as_float(iw[t >> 1] << 16);
                    const float nre = ab[0] * sre - ab[1] * sim + re, nim = ab[0] * sim + ab[1] * sre + im; sre = nre; sim = nim;
                    if (fin) { sL[t * 136 + lane] = f2bf(sre); sL[t * 136 + 64 + lane] = f2bf(sim); } }
            }
            LDS_WAIT();
            if (fin) {
                f32x4 y = {0.f, 0.f, 0.f, 0.f};
#pragma unroll
                for (int ks = 0; ks < 4; ++ks) { const bf16x8 xs = *(const LAS bf16x8*)(sL + l15 * 136 + 32 * ks + 8 * g); y = mma16(xs, ycm[ks], y); }
#pragma unroll
                for (int j = 0; j < 4; ++j) { const int t = tt * 16 + 4 * g + j, ch = 16 * grp + l15;
                    const float u = bf2f((short)uz[t * UP + ch]); uz[t * UP + ch] = f2bf(gelu_tanh(y[j] + dd * u)); }
            }
            LDS_WAIT();
        }
        if (!SMP && pass == 0) { float* S = WSP(float, WS_SUMS) + (((size_t)b * 64 + c) * 16 + grp) * 128; S[lane] = sre; S[64 + lane] = sim; }
        if (pass == 1) {
            if (SMP) { p.out[O_SRES + ((size_t)(l * SB + b) * 16 + grp) * 64 + lane] = sre; p.out[O_SIMS + ((size_t)(l * SB + b) * 16 + grp) * 64 + lane] = sim; }
            else if (c == 63) { p.out[O_SREP + ((size_t)(l * NB + b) * 16 + grp) * 64 + lane] = sre; p.out[O_SIMP + ((size_t)(l * NB + b) * 16 + grp) * 64 + lane] = sim; }
        }
    }
    if (fin) {
        __syncthreads();
        const bf16_t* wgt = WSP(const bf16_t, WS_WGT) + (size_t)l * 65536;
#pragma unroll 1
        for (int nt2 = 0; nt2 < 2; ++nt2) {
            bf16x8 yw[8];
#pragma unroll
            for (int ks = 0; ks < 8; ++ks) yw[ks] = *(const bf16x8*)(wgt + (size_t)(32 * wid + 16 * nt2 + l15) * 256 + 32 * ks + 8 * g);
            const float bg = par[P_BGLU + 32 * wid + 16 * nt2 + l15];
#pragma unroll 1
            for (int tt = 0; tt < NT; ++tt) {
                f32x4 a = {0.f, 0.f, 0.f, 0.f};
#pragma unroll
                for (int ks = 0; ks < 8; ++ks) { const bf16x8 xz = *(const LAS bf16x8*)(uz + (tt * 16 + l15) * UP + 32 * ks + 8 * g); a = mma16(xz, yw[ks], a); }
#pragma unroll
                for (int j = 0; j < 4; ++j) { const int t = tt * 16 + 4 * g + j, n = 32 * wid + 16 * nt2 + l15;
                    const float z = bf2f((short)uz[t * UP + n]); mix[(row0 + t) * DM + 256 + n] = f2bf(z * sigmoidf_(a[j] + bg)); }
            }
        }
    }
    __syncthreads();
}

template <int NQT, bool SMP>
__device__ __forceinline__ void attn_item(const Params& p, int l, int b, int c, LAS unsigned char* lds) {
    int tid_ = threadIdx.x; asm volatile("" : "+v"(tid_));
    const int tid = tid_, wid = __builtin_amdgcn_readfirstlane(tid >> 6), lane = tid & 63, l15 = lane & 15, g = lane >> 4, kvh = wid >> 2;
    const bf16_t* q = WSP(const bf16_t, WS_Q); bf16_t* mix = WSP(bf16_t, WS_MIX);
    const bf16_t* kbase; const bf16_t* vbase; size_t vstride, row0; int nkt;
    if (SMP) { kbase = WSP(const bf16_t, WS_KBS) + (size_t)(l * SB + b) * 144 * 128; vbase = WSP(const bf16_t, WS_VTS) + (size_t)(l * SB + b) * 128 * 144; vstride = 144; nkt = 9; row0 = (size_t)MP + b * SS; }
    else { const int c0 = c >= 2 ? c - 2 : 0; kbase = WSP(const bf16_t, WS_KBP) + ((size_t)b * SEQ + c0 * 64) * 128; vbase = WSP(const bf16_t, WS_VTP) + (size_t)b * 128 * SEQ + c0 * 64;
        vstride = SEQ; nkt = 4 * (c - c0 + 1); row0 = (size_t)b * SEQ + c * 64; }
    bf16x8 yq[NQT][2];
#pragma unroll
    for (int qt = 0; qt < NQT; ++qt)
#pragma unroll
        for (int ks = 0; ks < 2; ++ks) yq[qt][ks] = *(const bf16x8*)(q + (row0 + qt * 16 + l15) * 512 + wid * 64 + 32 * ks + 8 * g);
    {
        const int nkc = nkt * 16 * 16, cpr = nkt * 2, nvc = 128 * cpr;
        u32x4 kv[6], vv[6];
#pragma unroll
        for (int i = 0; i < 6; ++i) { const int idx = tid + i * NTHR; kv[i] = (u32x4){0u, 0u, 0u, 0u};
            if (idx < nkc) kv[i] = *(const u32x4*)(kbase + (size_t)(idx >> 4) * 128 + 8 * (idx & 15)); }
#pragma unroll
        for (int i = 0; i < 6; ++i) { const int idx = tid + i * NTHR, r = idx / cpr, ck = idx - r * cpr; vv[i] = (u32x4){0u, 0u, 0u, 0u};
            if (idx < nvc) vv[i] = *(const u32x4*)(vbase + (size_t)r * vstride + 8 * ck); }
#pragma unroll
        for (int i = 0; i < 6; ++i) { const int idx = tid + i * NTHR; if (idx < nkc) *(LAS u32x4*)(lds + L_KL + (idx >> 4) * 272 + (idx & 15) * 16) = kv[i]; }
#pragma unroll
        for (int i = 0; i < 6; ++i) { const int idx = tid + i * NTHR, r = idx / cpr, ck = idx - r * cpr; if (idx < nvc) *(LAS u32x4*)(lds + L_VL + r * 400 + ck * 16) = vv[i]; }
    }
    __syncthreads();
    const float sink = WSP(const float, WS_SMALL)[SM_SINK + l * 8 + wid];
    const bf16x4 z4 = {0, 0, 0, 0};
    const LAS unsigned char* kL = lds + L_KL + l15 * 272 + (kvh * 64 + 8 * g) * 2;
    const LAS unsigned char* vL = lds + L_VL + (kvh * 64 + l15) * 400 + (4 * g) * 2;
    constexpr int QB = NQT >= 2 ? 2 : 1;
#pragma unroll
    for (int qp = 0; qp < NQT / QB; ++qp) {
        f32x4 s[QB][12];
#pragma unroll
        for (int kt = 0; kt < 12; ++kt) {
#pragma unroll
            for (int qb = 0; qb < QB; ++qb) s[qb][kt] = (f32x4){0.f, 0.f, 0.f, 0.f};
            if (kt < nkt) {
#pragma unroll
                for (int ks = 0; ks < 2; ++ks) { const bf16x8 x = *(const LAS bf16x8*)(kL + kt * 16 * 272 + ks * 64);
#pragma unroll
                    for (int qb = 0; qb < QB; ++qb) s[qb][kt] = mma16(x, yq[qp * QB + qb][ks], s[qb][kt]); } } }
        float inv[QB];
#pragma unroll
        for (int qb = 0; qb < QB; ++qb) {
            float mx = sink;
#pragma unroll
            for (int kt = 0; kt < 12; ++kt) if (kt < nkt) mx = fmaxf(fmaxf(mx, fmaxf(s[qb][kt][0], s[qb][kt][1])), fmaxf(s[qb][kt][2], s[qb][kt][3]));
            mx = fmaxf(mx, __shfl_xor(mx, 16)); mx = fmaxf(mx, __shfl_xor(mx, 32));
            float sum = 0.f;
#pragma unroll
            for (int kt = 0; kt < 12; ++kt) if (kt < nkt) {
#pragma unroll
                for (int j = 0; j < 4; ++j) { const float e = __expf(s[qb][kt][j] - mx); s[qb][kt][j] = e; sum += e; } }
            sum += __shfl_xor(sum, 16); sum += __shfl_xor(sum, 32); sum += __expf(sink - mx);
            inv[qb] = 1.0f / sum;
        }
        f32x4 o[QB][4];
#pragma unroll
        for (int qb = 0; qb < QB; ++qb)
#pragma unroll
            for (int dt = 0; dt < 4; ++dt) o[qb][dt] = (f32x4){0.f, 0.f, 0.f, 0.f};
#pragma unroll
        for (int kk = 0; kk < 6; ++kk) if (2 * kk < nkt) {
            bf16x8 y[QB];
#pragma unroll
            for (int qb = 0; qb < QB; ++qb) { u32x4 w; w.x = cvt_pk_bf16(s[qb][2 * kk][0], s[qb][2 * kk][1]); w.y = cvt_pk_bf16(s[qb][2 * kk][2], s[qb][2 * kk][3]);
                w.z = cvt_pk_bf16(s[qb][2 * kk + 1][0], s[qb][2 * kk + 1][1]); w.w = cvt_pk_bf16(s[qb][2 * kk + 1][2], s[qb][2 * kk + 1][3]);
                y[qb] = __builtin_bit_cast(bf16x8, w); }
            const bool hi = 2 * kk + 1 < nkt;
#pragma unroll
            for (int dt = 0; dt < 4; ++dt) { const LAS unsigned char* vr = vL + dt * 16 * 400 + kk * 64;
                const bf16x4 lo = *(const LAS bf16x4*)vr; const bf16x4 h4 = hi ? *(const LAS bf16x4*)(vr + 32) : z4;
                const bf16x8 x = __builtin_shufflevector(lo, h4, 0, 1, 2, 3, 4, 5, 6, 7);
#pragma unroll
                for (int qb = 0; qb < QB; ++qb) o[qb][dt] = mma16(x, y[qb], o[qb][dt]); }
        }
#pragma unroll
        for (int qb = 0; qb < QB; ++qb) { const size_t qrow = row0 + (qp * QB + qb) * 16 + l15;
#pragma unroll
            for (int dt = 0; dt < 4; ++dt) { u32x2 w; w.x = cvt_pk_bf16(o[qb][dt][0] * inv[qb], o[qb][dt][1] * inv[qb]); w.y = cvt_pk_bf16(o[qb][dt][2] * inv[qb], o[qb][dt][3] * inv[qb]);
                *(u32x2*)(mix + qrow * DM + 512 + wid * 64 + 16 * dt + 4 * g) = w; } }
    }
    __syncthreads();
}

__device__ __forceinline__ void mixer_pass(const Params& p, int l, int pass, LAS unsigned char* lds) {
    {
        LAS float* par = (LAS float*)(lds + L_PAR); const float* sm = WSP(const float, WS_SMALL);
        for (int i = threadIdx.x; i < 2560; i += NTHR) { float v;
            if (i < 1024) v = sm[SM_CW + l * 1024 + i];
            else { const int k = (i - 1024) >> 8, j = i & 255;
                v = k == 0 ? sm[SM_CB + l * 256 + j] : k == 1 ? sm[SM_BRG + l * 256 + j] : k == 2 ? sm[SM_BIG + l * 256 + j] : k == 3 ? WSP(const float, WS_SP)[l * 256 + j] : k == 4 ? sm[SM_SD + l * 256 + j] : sm[SM_BGLU + l * 256 + j]; }
            par[i] = v; }
        __syncthreads();
    }
    float hfold = 0.f; int cprev = 0;
#pragma unroll 1
    for (int it = blockIdx.x; it < NB * 64 + SB; it += gridDim.x) {
        if (it < NB * 64) { const int b = it & 15, c = it >> 4;
            stage_uab<4, false>(p, l, b, c, lds); __syncthreads();
#ifndef DUPM
#define DUPM 0
#endif
            { float hf0 = hfold; for (int r2 = 0; r2 < ((DUPM & 1) ? 2 : 1); ++r2) { hfold = hf0; lru_item<4, false>(p, l, b, c, pass, lds, hfold, cprev); } }
            for (int r2 = 0; r2 < ((DUPM & 2) ? 2 : 1); ++r2) { if ((DUPM & 2) && r2 == 1) { stage_uab<4, false>(p, l, b, c, lds); __syncthreads(); } s5_item<4, false>(p, l, b, c, pass, lds, r2 == 1 && pass == 1 ? c : cprev); }
            cprev = c;
            for (int r2 = 0; r2 < ((DUPM & 4) ? 2 : 1); ++r2) if (pass == 0) attn_item<4, false>(p, l, b, c, lds);
        } else { const int b = it - NB * 64;
            if (pass == 0) { attn_item<1, true>(p, l, b, 0, lds);
                float hf = 0.f; stage_uab<1, true>(p, l, b, 0, lds); __syncthreads(); lru_item<1, true>(p, l, b, 0, 1, lds, hf, 0); s5_item<1, true>(p, l, b, 0, 1, lds, 0); }
        }
    }
}

__device__ __forceinline__ void final_norm(const Params& p) {
    int tid_ = threadIdx.x; asm volatile("" : "+v"(tid_));
    const int lane = tid_ & 63, gw = blockIdx.x * NWAVES + (tid_ >> 6), NGW = gridDim.x * NWAVES;
    const float* ss = WSP(const float, WS_SS); const f32x4* nf = (const f32x4*)(WSP(const float, WS_SMALL) + SM_NF) + 2 * lane;
    const bf16_t* xb = WSP(const bf16_t, WS_XB);
#pragma unroll 1
    for (int row = gw; row < MREAL; row += NGW) {
        const float rs = ss_rs(ss, row); f32x4* o = (f32x4*)(p.out + O_Y + (size_t)row * DM) + 2 * lane; const u32x4* xi = (const u32x4*)(xb + (size_t)row * DM) + lane;
#pragma unroll
        for (int j = 0; j < 2; ++j) { const u32x4 w = xi[64 * j]; const f32x4 g0 = nf[128 * j], g1 = nf[128 * j + 1];
            o[128 * j] = (f32x4){__uint_as_float(w.x << 16) * rs * g0[0], __uint_as_float(w.x & 0xffff0000u) * rs * g0[1], __uint_as_float(w.y << 16) * rs * g0[2], __uint_as_float(w.y & 0xffff0000u) * rs * g0[3]};
            o[128 * j + 1] = (f32x4){__uint_as_float(w.z << 16) * rs * g1[0], __uint_as_float(w.z & 0xffff0000u) * rs * g1[1], __uint_as_float(w.w << 16) * rs * g1[2], __uint_as_float(w.w & 0xffff0000u) * rs * g1[3]}; }
    }
}

template <int KIND>
__device__ __forceinline__ void slab_gemm(const Params& p, LAS unsigned char* lds, const bf16_t* A, const bf16_t* Bt, int K, int N,
                                          const float* xin_s, float* xout_s, bf16_t* xb, float* ss, bf16_t* hid) {
    int tid_ = threadIdx.x; asm volatile("" : "+v"(tid_));
    const int tid = tid_, wid = __builtin_amdgcn_readfirstlane(tid >> 6), lane = tid & 63, l15 = lane & 15, g = lane >> 4;
    const int npieces = 8 * (N / 64), kw = K / 8;
#pragma unroll 1
    for (int pc = blockIdx.x; pc < npieces; pc += gridDim.x) {
        const int rt = pc & 7, cg = pc >> 3;
        f32x4 acc[4];
#pragma unroll
        for (int ct = 0; ct < 4; ++ct) acc[ct] = (f32x4){0.f, 0.f, 0.f, 0.f};
        const bf16_t* ap = A + (size_t)(MP + rt * 16 + l15) * K + wid * kw + 8 * g;
        const bf16_t* bp = Bt + (size_t)(cg * 64 + l15) * K + wid * kw + 8 * g;
#pragma unroll 4
        for (int ks = 0; ks < kw / 32; ++ks) {
            const bf16x8 x = *(const bf16x8*)(ap + 32 * ks);
#pragma unroll
            for (int ct = 0; ct < 4; ++ct) { const bf16x8 y = *(const bf16x8*)(bp + (size_t)ct * 16 * K + 32 * ks); acc[ct] = mma16(x, y, acc[ct]); }
        }
        LAS f32x4* part = (LAS f32x4*)lds;
#pragma unroll
        for (int ct = 0; ct < 4; ++ct) part[(wid * 4 + ct) * 64 + lane] = acc[ct];
        __syncthreads();
        const int r = 2 * wid + (lane >> 5), c = 2 * (lane & 31), gg = r >> 2, j = r & 3;
        float v0 = 0.f, v1 = 0.f;
#pragma unroll
        for (int w = 0; w < 8; ++w) { const LAS float* pp = (const LAS float*)lds + ((w * 4 + (c >> 4)) * 64 + 16 * gg + (c & 15)) * 4 + j; v0 += pp[0]; v1 += pp[4]; }
        const int row = MP + rt * 16 + r, col = cg * 64 + c;
        if (KIND == 0) {
            const size_t off = (size_t)(rt * 16 + r) * DM + col;
            float r0, r1;
            if (xin_s) { r0 = xin_s[off]; r1 = xin_s[off + 1]; }
            else { const unsigned xw = *(const unsigned*)(xb + (size_t)row * DM + col); r0 = __uint_as_float(xw << 16); r1 = __uint_as_float(xw & 0xffff0000u); }
            const float o0 = r0 + v0, o1 = r1 + v1;
            if (xout_s) { xout_s[off] = o0; xout_s[off + 1] = o1; }
            if (xb) *(unsigned*)(xb + (size_t)row * DM + col) = cvt_pk_bf16(o0, o1);
            float sq = o0 * o0 + o1 * o1;
#pragma unroll
            for (int o = 1; o < 32; o <<= 1) sq += __shfl_xor(sq, o);
            if ((lane & 31) == 0) ss[(size_t)row * 16 + cg] = sq;
        } else if (KIND == 1) {
            const float rs = ss_rs(ss, row), a0 = fmaxf(v0 * rs, 0.f), a1 = fmaxf(v1 * rs, 0.f);
            *(unsigned*)(hid + (size_t)row * DFF + col) = cvt_pk_bf16(a0 * a0, a1 * a1);
        } else {
            const int l = (int)(size_t)xin_s;
            const int sb = rt, st = r, pos = SEQ + st;
            const float rs = ss_rs(ss, row), a0 = v0 * rs, a1 = v1 * rs;
            if (col < 768) {
                bf16_t* dst = col < 256 ? WSP(bf16_t, WS_UA) : (col < 512 ? WSP(bf16_t, WS_GA) : WSP(bf16_t, WS_UB)); const int cc = col & 255;
                *(unsigned*)(dst + (size_t)row * 256 + cc) = cvt_pk_bf16(a0, a1);
                if (col < 256 && st >= SS - 3) { float* o = p.out + O_CONVS + ((size_t)(l * SB + sb) * 3 + (st - (SS - 3))) * 256 + cc; o[0] = a0; o[1] = a1; }
            } else if (col < 1408) {
                const int jp = (col & 63) >> 1; const float* rp = WSP(const float, WS_ROPE) + ((size_t)pos * 32 + jp) * 2;
                const float cs = rp[0], sn = rp[1], o0 = a0 * cs - a1 * sn, o1 = a1 * cs + a0 * sn;
                if (col < 1280) *(unsigned*)(WSP(bf16_t, WS_Q) + (size_t)row * 512 + (col - 768)) = cvt_pk_bf16(o0 * 0.125f, o1 * 0.125f);
                else { const int kc = col - 1280, kvh = kc >> 6;
                    *(unsigned*)(WSP(bf16_t, WS_KBS) + ((size_t)(l * SB + sb) * 144 + 128 + st) * 128 + kc) = cvt_pk_bf16(o0, o1);
                    float* o = p.out + O_KS + (((size_t)(l * SB + sb) * SS + st) * 2 + kvh) * 64 + jp; o[0] = o0; o[32] = o1; }
            } else {
                const int vc = col - 1408, kvh = vc >> 6, d = vc & 63;
                bf16_t* vt = WSP(bf16_t, WS_VTS) + ((size_t)(l * SB + sb) * 128 + vc) * 144 + 128 + st; vt[0] = f2bf(a0); vt[144] = f2bf(a1);
                float* o = p.out + O_VS + (((size_t)(l * SB + sb) * SS + st) * 2 + kvh) * 64 + d; o[0] = a0; o[1] = a1;
            }
        }
        __syncthreads();
    }
}

#define XB_TMO      128
#define XB_XCNT(j)  (256  + 64 * (j))
#define XB_XSUB(j)  (1280 + 64 * (j))
#define XB_XGEN(j)  (2304 + 64 * (j))
#define XB_TOP      3328
#define XB_TOPGEN   3392
#define XCD_BAR_WORDS 3456
#define XB_SPIN_CAP (1u << 18)

__device__ __forceinline__ unsigned xb_ld(unsigned* p)              { return __hip_atomic_load(p, __ATOMIC_RELAXED, __HIP_MEMORY_SCOPE_AGENT); }
__device__ __forceinline__ unsigned xb_add(unsigned* p, unsigned v) { return __hip_atomic_fetch_add(p, v, __ATOMIC_RELAXED, __HIP_MEMORY_SCOPE_AGENT); }
__device__ __forceinline__ unsigned xb_xcc_id() { return (unsigned)__builtin_amdgcn_s_getreg((3 << 11) | 20) & 0xFu; }
#define XB_SPIN(cond, bar) do { unsigned _sp = 0; while (cond) { __builtin_amdgcn_s_sleep(1); \
    if ((++_sp & 255u) == 0u) { if (xb_ld(&(bar)[XB_TMO])) break; if (_sp > XB_SPIN_CAP) { atomicAdd(&(bar)[XB_TMO], 1u); break; } } } } while (0)

struct XcdBarrier {
    unsigned* bar; unsigned x;
    volatile LAS unsigned* st;
};

__device__ __forceinline__ XcdBarrier xcd_barrier_post(unsigned* bar, volatile LAS unsigned* st) {
    XcdBarrier b; b.bar = bar; b.x = xb_xcc_id(); b.st = st;
    if (threadIdx.x == 0) (void)xb_add(&bar[XB_XCNT(b.x)], 1u);
    return b;
}
__device__ __forceinline__ void xcd_barrier_complete(unsigned* bar, unsigned x, unsigned& nloc, unsigned& nx) {
    const unsigned G = gridDim.x * gridDim.y * gridDim.z;
    unsigned sum, cnt, mine, sp = 0u;
    for (;;) {
        sum = 0u; cnt = 0u; mine = 0u;
#pragma unroll
        for (unsigned j = 0; j < 16; ++j) { const unsigned c = xb_ld(&bar[XB_XCNT(j)]); sum += c; cnt += (c > 0u) ? 1u : 0u; mine = (j == x) ? c : mine; }
        if (sum == G) break;
        __builtin_amdgcn_s_sleep(1);
        if ((++sp & 255u) == 0u) { if (xb_ld(&bar[XB_TMO])) break; if (sp > XB_SPIN_CAP) { atomicAdd(&bar[XB_TMO], 1u); break; } }
    }
    nloc = mine > 0u ? mine : 1u; nx = cnt > 0u ? cnt : 1u;
}

__device__ __forceinline__ void xcd_barrier(const XcdBarrier& b) {
    asm volatile("s_waitcnt vmcnt(0)" ::: "memory");
    __syncthreads();
    if (threadIdx.x == 0) {
        unsigned* bar = b.bar;
        __builtin_amdgcn_s_waitcnt(0);
        unsigned nloc = b.st[0], nx = b.st[1];
        if (nloc == 0u) { xcd_barrier_complete(bar, b.x, nloc, nx); b.st[0] = nloc; b.st[1] = nx; }
        const unsigned old = xb_add(&bar[XB_XSUB(b.x)], 1u);
        const unsigned gen = old / nloc;
        if (old + 1u == (gen + 1u) * nloc) {
            __builtin_amdgcn_fence(__ATOMIC_RELEASE, "agent");
            asm volatile("s_waitcnt vmcnt(0)" ::: "memory");
            const unsigned og = xb_add(&bar[XB_TOP], 1u);
            const unsigned tg = og / nx;
            if (og + 1u == (tg + 1u) * nx) xb_add(&bar[XB_TOPGEN], 1u);
            else XB_SPIN(xb_ld(&bar[XB_TOPGEN]) == tg, bar);
            __builtin_amdgcn_fence(__ATOMIC_ACQUIRE, "agent");
            xb_add(&bar[XB_XGEN(b.x)], 1u);
            asm volatile("s_waitcnt vmcnt(0)" ::: "memory");
        } else {
            XB_SPIN(xb_ld(&bar[XB_XGEN(b.x)]) == gen, bar);
            __builtin_amdgcn_fence(__ATOMIC_ACQUIRE, "agent");
            asm volatile("s_waitcnt vmcnt(0)" ::: "memory");
        }
    }
    __syncthreads();
}

#define GSYNC_CG() do { asm volatile("s_waitcnt vmcnt(0) lgkmcnt(0)" ::: "memory"); grid.sync(); __builtin_amdgcn_fence(__ATOMIC_ACQUIRE, "agent"); asm volatile("s_waitcnt vmcnt(0)" ::: "memory"); } while (0)
#define GSYNC() do { XcdBarrier xb_; xb_.bar = (unsigned*)(p.ws + WS_CTL); xb_.x = xb_xcc_id(); xb_.st = (volatile LAS unsigned*)(lds + L_MISC); xcd_barrier(xb_); } while (0)
__global__ void __launch_bounds__(NTHR, 2) fwd_kernel(Params p) {
    extern __shared__ __attribute__((aligned(16))) unsigned char lds_raw[];
    LAS unsigned char* lds = (LAS unsigned char*)lds_raw;
    cg::grid_group grid = cg::this_grid();
    const int G = gridDim.x, cid = blockIdx.x;
    volatile LAS unsigned* misc = (volatile LAS unsigned*)(lds + L_MISC);
    if (threadIdx.x < 2) misc[threadIdx.x] = 0u;
    if (threadIdx.x < 33) ((LAS unsigned long long*)(lds + L_PTAB))[threadIdx.x] = ((const unsigned long long*)__builtin_amdgcn_kernarg_segment_ptr())[threadIdx.x];
    __syncthreads();
    (void)xcd_barrier_post((unsigned*)(p.ws + WS_CTL), misc);
#ifndef EN
#define EN 0xff
#endif
#ifndef DUP
#define DUP 0
#endif
#define REPS(bit) (((DUP) & (bit)) && l == 0 ? 2 : 1)
#ifndef DUPP
#define DUPP 1
#endif
#pragma unroll 1
    for (int rp = 0; rp < DUPP; ++rp) { if (EN & 1) prologue(p, lds); __syncthreads(); }
#ifdef NOCG
    if (gridDim.y == 0x7fffffffu)
#endif
    GSYNC_CG();
#ifdef NOCG
    GSYNC();
#endif
#pragma unroll 1
    for (int l = 0; l < DEPTH; ++l) {
        if (EN & 2) {
            pg8::Gemm gm{WSP(const bf16_t, WS_XB), WSP(const bf16_t, WS_WIN) + (size_t)l * DIN * DM, MP, DIN, DM}; pg8::StaticOrder S; S.init(MP, DIN, G, cid);
            EpiIn E{p.ws, p.out, l};
            pg8::gemm_phase<EpiIn, pg8::StaticOrder, true, true>(lds, gm, S, E);
            slab_gemm<2>(p, lds, WSP(const bf16_t, WS_XB), WSP(const bf16_t, WS_WIN) + (size_t)l * DIN * DM, DM, DIN, (const float*)(size_t)l, nullptr, nullptr, WSP(float, WS_SS), nullptr);
        }
        GSYNC();
        if (EN & 4) mixer_pass(p, l, 0, lds);
        GSYNC();
        if (EN & 8) mixer_pass(p, l, 1, lds);
        GSYNC();
        if (EN & 16) {
            pg8::Gemm gm{WSP(const bf16_t, WS_MIX), WSP(const bf16_t, WS_WOUT) + (size_t)l * DM * DM, MP, DM, DM}; pg8::StaticOrder S; S.init(MP, DM, G, cid);
            EpiResB E{WSP(bf16_t, WS_XB), WSP(float, WS_SS)};
            pg8::gemm_phase<EpiResB, pg8::StaticOrder, true, true>(lds, gm, S, E);
            slab_gemm<0>(p, lds, WSP(const bf16_t, WS_MIX), WSP(const bf16_t, WS_WOUT) + (size_t)l * DM * DM, DM, DM, nullptr, nullptr, WSP(bf16_t, WS_XB), WSP(float, WS_SS), nullptr);
        }
        GSYNC();
        if (EN & 32) {
            pg8::Gemm gm{WSP(const bf16_t, WS_XB), WSP(const bf16_t, WS_WUP) + (size_t)l * DFF * DM, MP, DFF, DM}; pg8::StaticOrder S; S.init(MP, DFF, G, cid);
            EpiUp E{WSP(const float, WS_SS), WSP(bf16_t, WS_HID)};
            pg8::gemm_phase<EpiUp, pg8::StaticOrder, true, true>(lds, gm, S, E);
            slab_gemm<1>(p, lds, WSP(const bf16_t, WS_XB), WSP(const bf16_t, WS_WUP) + (size_t)l * DFF * DM, DM, DFF, nullptr, nullptr, nullptr, WSP(float, WS_SS), WSP(bf16_t, WS_HID));
        }
        GSYNC();
        if (EN & 64) {
            pg8::Gemm gm{WSP(const bf16_t, WS_HID), WSP(const bf16_t, WS_WDN) + (size_t)l * DM * DFF, MP, DM, DFF}; pg8::StaticOrder S; S.init(MP, DM, G, cid);
            EpiResB E{WSP(bf16_t, WS_XB), WSP(float, WS_SS)};
            pg8::gemm_phase<EpiResB, pg8::StaticOrder, true, true>(lds, gm, S, E);
            slab_gemm<0>(p, lds, WSP(const bf16_t, WS_HID), WSP(const bf16_t, WS_WDN) + (size_t)l * DM * DFF, DFF, DM, nullptr, nullptr, WSP(bf16_t, WS_XB), WSP(float, WS_SS), nullptr);
        }
        GSYNC();
    }
    if (EN & 128) final_norm(p);
}

extern "C" void kernel_launch(void* const* d_in, const int* in_sizes, int n_in, void* d_out, int out_size, void* d_ws, size_t ws_size, hipStream_t stream) {
    static int grid = 0;
    if (grid == 0) {
        if (n_in != 33 || (size_t)out_size != O_END || ws_size < WS_TOTAL) { fprintf(stderr, "kernel_launch: unexpected shapes (n_in %d out %d ws %zu)\n", n_in, out_size, ws_size); grid = -1; return; }
        int dev = 0, cus = 0, per = 0;
        if (hipGetDevice(&dev) != hipSuccess || hipDeviceGetAttribute(&cus, hipDeviceAttributeMultiprocessorCount, dev) != hipSuccess) { grid = -1; return; }
        if (hipFuncSetAttribute((const void*)fwd_kernel, hipFuncAttributeMaxDynamicSharedMemorySize, LDS_BYTES) != hipSuccess) { fprintf(stderr, "kernel_launch: hipFuncSetAttribute failed\n"); grid = -1; return; }
        if (hipOccupancyMaxActiveBlocksPerMultiprocessor(&per, (const void*)fwd_kernel, NTHR, LDS_BYTES) != hipSuccess || per < 1) { fprintf(stderr, "kernel_launch: occupancy query says %d\n", per); per = 1; }
        (void)hipGetLastError();
        grid = cus;
    }
    if (grid < 0) return;
    if (hipMemsetAsync((char*)d_ws + WS_CTL, 0, CTL_BYTES, stream) != hipSuccess) { fprintf(stderr, "kernel_launch: hipMemsetAsync failed\n"); return; }
    Params p{};
    for (int i = 0; i < 33; ++i) p.in[i] = (const float*)d_in[i];
    p.out = (float*)d_out; p.ws = (unsigned char*)d_ws;
    void* args[] = {&p};
    hipError_t e = hipLaunchCooperativeKernel((const void*)fwd_kernel, dim3(grid), dim3(NTHR), args, LDS_BYTES, stream);
    if (e != hipSuccess) fprintf(stderr, "kernel_launch: cooperative launch failed: %s (grid %d)\n", hipGetErrorString(e), grid);
}
```

```cpp
#define NOCG 1
#include <hip/hip_runtime.h>
#include <hip/hip_cooperative_groups.h>
#include <cstdio>
#include <cstdint>
namespace cg = cooperative_groups;
namespace pg8 {
#define PG8_LAS __attribute__((address_space(3)))
typedef unsigned short bf16_t;
typedef short bf16x8 __attribute__((ext_vector_type(8)));
typedef float f32x4 __attribute__((ext_vector_type(4)));
typedef unsigned u32x4 __attribute__((ext_vector_type(4)));
constexpr int BM = 256, BK = 64, HALF = 128, HTB = HALF * BK * 2  , STAGE_BYTES = 8 * HTB, NXCD = 8, WGM = 8;

__host__ __device__ __forceinline__ int lds_byte(int r, int c) { const int st = (r >> 4) * 2 + (c >> 5), rr = r & 15, cc = c & 31, ob = rr * 64 + cc * 2; return st * 1024 + (ob ^ (((ob >> 9) & 1) << 5)); }
__host__ __device__ __forceinline__ void stage_rc(int b, int& R, int& C) { const int st = b / 1024, sb = b % 1024, swz = sb ^ (((sb >> 9) & 1) << 5); R = (st >> 1) * 16 + swz / 64; C = (st & 1) * 32 + (swz % 64) / 2; }
__host__ __device__ __forceinline__ int perm32(int rho) { const int n = rho >> 4, i = rho & 15; return 8 * (i >> 2) + 4 * n + (i & 3); }

struct Unit { int pm, pn; };
struct Gemm { const bf16_t* A; const bf16_t* Bt; int M, N, K; };

struct StaticOrder {
    int nM, nN, nwg, G, c;
    __host__ __device__ void init(int M, int N, int G_, int c_) { nM = M / BM; nN = N / BM; nwg = nM * nN; G = G_; c = c_; }
    __host__ __device__ bool next(int i, Unit& u) const {
        const long L = (long)i * G + c; if (L >= nwg) return false;
        int wgid = (int)L; { const int q = nwg / NXCD, r = nwg % NXCD, xcd = wgid % NXCD, off = wgid / NXCD; wgid = (xcd < r ? xcd * (q + 1) : r * (q + 1) + (xcd - r) * q) + off; }
        const int nig = WGM * nN, gid = wgid / nig, fm = gid * WGM, gsz = (nM - fm) < WGM ? (nM - fm) : WGM;
        u.pm = fm + ((wgid % nig) % gsz); u.pn = (wgid % nig) / gsz; return true;
    }
    __device__ __forceinline__ void a_ready(const Unit&) const {}
    __device__ __forceinline__ void done(const Unit&) const {}
};

__device__ __forceinline__ unsigned cvt_pk_bf16(float lo, float hi) { unsigned r; asm volatile("v_cvt_pk_bf16_f32 %0, %1, %2" : "=v"(r) : "v"(lo), "v"(hi)); return r; }
typedef float f32x2 __attribute__((ext_vector_type(2)));
template <class Epi, class Sched, bool ALIGN_EPI = false, bool SP2 = false>
__device__ __forceinline__ void gemm_phase(PG8_LAS unsigned char* lds, const Gemm g, const Sched& S, const Epi& E) {
    int tid_ = threadIdx.x; asm volatile("" : "+v"(tid_));
    const int tid = tid_, wid = __builtin_amdgcn_readfirstlane(tid >> 6), lane = tid & 63, wr = wid >> 2, wc = wid & 3, fr = lane & 15, fq = lane >> 4;
    const int K = g.K, nt = K / BK;
    unsigned voffA[2], voffB[2];
#pragma unroll
    for (int i = 0; i < 2; ++i) { int R, C; stage_rc(tid * 16 + i * 8192, R, C); const int Rb = Epi::PERM ? ((R & ~31) + perm32(R & 31)) : R;
        voffA[i] = (unsigned)(R * K + C) * 2u; voffB[i] = (unsigned)(Rb * K + C) * 2u; }
    const size_t kstep = (size_t)(BK * 2);
    const size_t hstep = (size_t)HALF * K * 2;
    const size_t tstep = 2 * hstep;
    const unsigned ldsw = (unsigned)wid * 1024u;
    const int aoff = lds_byte(wr * 64 + fr, fq * 8), boff = lds_byte(wc * 32 + fr, fq * 8);
#define PG8_SA(b, h) (((b) * 2 + (h)) * HTB)
#define PG8_SB(b, h) ((4 + (b) * 2 + (h)) * HTB)
#define PG8_STAGE(bufoff, gbase, voff) do { _Pragma("unroll") for (int _i = 0; _i < 2; ++_i) \
        __builtin_amdgcn_global_load_lds((const unsigned*)((const char*)(gbase) + (voff)[_i]), (PG8_LAS unsigned*)(lds + (bufoff) + ldsw + _i * 8192), 16, 0, 0); } while (0)
#define PG8_LDA(dst, b, h) do { _Pragma("unroll") for (int m = 0; m < 4; ++m) _Pragma("unroll") for (int k = 0; k < 2; ++k) dst[m][k] = *(const PG8_LAS bf16x8*)(lds + PG8_SA(b, h) + aoff + m * 2048 + k * 1024); } while (0)
#define PG8_LDB(dst, b, h) do { _Pragma("unroll") for (int n = 0; n < 2; ++n) _Pragma("unroll") for (int k = 0; k < 2; ++k) dst[n][k] = *(const PG8_LAS bf16x8*)(lds + PG8_SB(b, h) + boff + n * 2048 + k * 1024); } while (0)
#define PG8_MMA(ai, bj, At, Bt) do { __builtin_amdgcn_s_setprio(1); _Pragma("unroll") for (int m = 0; m < 4; ++m) _Pragma("unroll") for (int n = 0; n < 2; ++n) _Pragma("unroll") for (int k = 0; k < 2; ++k) \
        acc[ai][bj][m][n] = __builtin_amdgcn_mfma_f32_16x16x32_bf16(Bt[n][k], At[m][k], acc[ai][bj][m][n], 0, 0, 0); __builtin_amdgcn_s_setprio(0); } while (0)
#define PG8_WAIT_V(n) asm volatile("s_waitcnt vmcnt(" #n ")" ::: "memory")
#define PG8_WAIT_L(n) asm volatile("s_waitcnt lgkmcnt(" #n ")" ::: "memory")
#define PG8_BAR __builtin_amdgcn_s_barrier()
#define PG8_SCHED __builtin_amdgcn_sched_barrier(0)
    Unit cur, nxt; int ui = 0;
    if (!S.next(0, cur)) return;
    f32x4 acc[2][2][4][2];
#pragma unroll
    for (int a = 0; a < 2; ++a)
#pragma unroll
        for (int b = 0; b < 2; ++b)
#pragma unroll
            for (int m = 0; m < 4; ++m)
#pragma unroll
                for (int n = 0; n < 2; ++n) acc[a][b][m][n] = (f32x4){0.f, 0.f, 0.f, 0.f};
    bf16x8 At[4][2], B0[2][2], B1[2][2];
    const char* cA = (const char*)g.A + (size_t)cur.pm * tstep; const char* cB = (const char*)g.Bt + (size_t)cur.pn * tstep;
    S.a_ready(cur);
    if constexpr (SP2) {
        PG8_STAGE(PG8_SB(0, 0), cB, voffB); PG8_STAGE(PG8_SB(0, 1), cB + hstep, voffB); PG8_STAGE(PG8_SA(0, 0), cA, voffA); PG8_STAGE(PG8_SA(0, 1), cA + hstep, voffA);
        if (wr == 1) PG8_BAR;
        PG8_WAIT_V(2); PG8_BAR;
        PG8_STAGE(PG8_SB(1, 0), cB + kstep, voffB); PG8_STAGE(PG8_SA(1, 0), cA + kstep, voffA); PG8_STAGE(PG8_SB(1, 1), cB + hstep + kstep, voffB);
        PG8_WAIT_V(6); PG8_BAR;
    } else {
        PG8_STAGE(PG8_SB(0, 0), cB, voffB); PG8_STAGE(PG8_SA(0, 0), cA, voffA); PG8_STAGE(PG8_SB(0, 1), cB + hstep, voffB); PG8_STAGE(PG8_SA(0, 1), cA + hstep, voffA);
        if (wr == 1) PG8_BAR;
        PG8_WAIT_V(4); PG8_BAR;
        PG8_STAGE(PG8_SB(1, 0), cB + kstep, voffB); PG8_STAGE(PG8_SA(1, 0), cA + kstep, voffA); PG8_STAGE(PG8_SB(1, 1), cB + hstep + kstep, voffB);
        PG8_WAIT_V(6); PG8_BAR;
    }
    for (;;) {
        const bool has_next = S.next(ui + 1, nxt);
        const char* nA = has_next ? (const char*)g.A + (size_t)nxt.pm * tstep : cA; const char* nB = has_next ? (const char*)g.Bt + (size_t)nxt.pn * tstep : cB;
        for (int t = 0; t < nt; t += 2) {
            const bool last = (t == nt - 2);
            const char* a1 = cA + (size_t)(t + 1) * kstep;
            const char* a2 = last ? nA : cA + (size_t)(t + 2) * kstep; const char* b2 = last ? nB : cB + (size_t)(t + 2) * kstep;
            const char* a3 = a2 + kstep; const char* b3 = b2 + kstep;
            if (last && has_next) S.a_ready(nxt);
            if constexpr (SP2) {
            PG8_LDB(B0, 0, 0); PG8_LDB(B1, 0, 1); PG8_SCHED; PG8_LDA(At, 0, 0); PG8_STAGE(PG8_SA(1, 1), a1 + hstep, voffA);
            PG8_WAIT_V(8); PG8_WAIT_L(0); PG8_BAR; PG8_MMA(0, 0, At, B0); PG8_MMA(0, 1, At, B1); PG8_BAR; PG8_SCHED;
            PG8_LDA(At, 0, 1); PG8_STAGE(PG8_SB(0, 0), b2, voffB); PG8_STAGE(PG8_SB(0, 1), b2 + hstep, voffB); PG8_STAGE(PG8_SA(0, 0), a2, voffA);
            PG8_WAIT_V(8); PG8_WAIT_L(0); PG8_BAR; PG8_MMA(1, 0, At, B0); PG8_MMA(1, 1, At, B1); PG8_BAR; PG8_SCHED;
            PG8_LDB(B0, 1, 0); PG8_LDB(B1, 1, 1); PG8_SCHED; PG8_LDA(At, 1, 0); PG8_STAGE(PG8_SA(0, 1), a2 + hstep, voffA);
            PG8_WAIT_V(8); PG8_WAIT_L(0); PG8_BAR; PG8_MMA(0, 0, At, B0); PG8_MMA(0, 1, At, B1); PG8_BAR; PG8_SCHED;
            PG8_LDA(At, 1, 1); PG8_STAGE(PG8_SB(1, 0), b3, voffB); PG8_STAGE(PG8_SB(1, 1), b3 + hstep, voffB); PG8_STAGE(PG8_SA(1, 0), a3, voffA);
            PG8_WAIT_V(8); PG8_WAIT_L(0); PG8_BAR; PG8_MMA(1, 0, At, B0); PG8_MMA(1, 1, At, B1); PG8_BAR; PG8_SCHED;
            } else {
            PG8_LDB(B0, 0, 0); PG8_SCHED; PG8_LDA(At, 0, 0); PG8_STAGE(PG8_SA(1, 1), a1 + hstep, voffA);
            PG8_WAIT_L(8); PG8_BAR; PG8_WAIT_L(0); PG8_MMA(0, 0, At, B0); PG8_BAR; PG8_SCHED;
            PG8_LDB(B1, 0, 1); PG8_STAGE(PG8_SB(0, 0), b2, voffB);
            PG8_BAR; PG8_WAIT_L(0); PG8_MMA(0, 1, At, B1); PG8_BAR;
            PG8_LDA(At, 0, 1); PG8_STAGE(PG8_SA(0, 0), a2, voffA);
            PG8_BAR; PG8_WAIT_L(0); PG8_MMA(1, 0, At, B0); PG8_BAR; PG8_SCHED;
            PG8_STAGE(PG8_SB(0, 1), b2 + hstep, voffB);
            PG8_WAIT_V(6); PG8_BAR; PG8_MMA(1, 1, At, B1); PG8_BAR;
            PG8_LDB(B0, 1, 0); PG8_SCHED; PG8_LDA(At, 1, 0); PG8_STAGE(PG8_SA(0, 1), a2 + hstep, voffA);
            PG8_WAIT_L(8); PG8_BAR; PG8_WAIT_L(0); PG8_MMA(0, 0, At, B0); PG8_BAR; PG8_SCHED;
            PG8_LDB(B1, 1, 1); PG8_STAGE(PG8_SB(1, 0), b3, voffB);
            PG8_BAR; PG8_WAIT_L(0); PG8_MMA(0, 1, At, B1); PG8_BAR;
            PG8_LDA(At, 1, 1); PG8_STAGE(PG8_SA(1, 0), a3, voffA);
            PG8_BAR; PG8_WAIT_L(0); PG8_MMA(1, 0, At, B0); PG8_BAR; PG8_SCHED;
            PG8_STAGE(PG8_SB(1, 1), b3 + hstep, voffB);
            PG8_WAIT_V(6); PG8_BAR; PG8_MMA(1, 1, At, B1); PG8_BAR;
            }
        }
        if constexpr (ALIGN_EPI) { if (wr == 0) PG8_BAR; }
        if constexpr (!Epi::AFTER_DRAIN) { E(acc, cur, wr, wc, fr, fq); S.done(cur); }
        if (!has_next) break;
#pragma unroll
        for (int a = 0; a < 2; ++a)
#pragma unroll
            for (int b = 0; b < 2; ++b)
#pragma unroll
                for (int m = 0; m < 4; ++m)
#pragma unroll
                    for (int n = 0; n < 2; ++n) acc[a][b][m][n] = (f32x4){0.f, 0.f, 0.f, 0.f};
        cur = nxt; cA = nA; cB = nB; ++ui;
        if constexpr (ALIGN_EPI) { if (wr == 1) PG8_BAR; }
    }
    PG8_WAIT_V(0);
    if constexpr (!ALIGN_EPI) { if (wr == 0) PG8_BAR; }
    PG8_BAR;
    if constexpr (Epi::AFTER_DRAIN) { E.fused(acc, cur, wr, wc, fr, fq, lds, wid, lane); S.done(cur); }
#undef PG8_SA
#undef PG8_SB
#undef PG8_STAGE
#undef PG8_LDA
#undef PG8_LDB
#undef PG8_MMA
#undef PG8_WAIT_V
#undef PG8_WAIT_L
#undef PG8_BAR
#undef PG8_SCHED
}
}

using pg8::bf16_t; using pg8::bf16x8; using pg8::f32x4; using pg8::u32x4; using pg8::cvt_pk_bf16;
typedef short bf16x4 __attribute__((ext_vector_type(4)));
typedef unsigned u32x2 __attribute__((ext_vector_type(2)));
#define LAS __attribute__((address_space(3)))

constexpr int DM = 1024, NB = 16, SEQ = 4096, DEPTH = 2, SB = 8, SS = 16;
constexpr int MP = NB * SEQ, MS = SB * SS, MREAL = MP + MS, MPAD = 65792;
constexpr int DIN = 1536, DFF = 4096, NPOS = SEQ + SS;
constexpr float EPS = 1e-6f;
constexpr int NTHR = 512, NWAVES = 8;
constexpr int LDS_BYTES = 147456 + 512, L_MISC = 147456, L_PTAB = 147456 + 64;

constexpr size_t O_Y = 0;
constexpr size_t O_CONVP = (size_t)MREAL * DM;
constexpr size_t O_LRUP = O_CONVP + (size_t)DEPTH * NB * 3 * 256;
constexpr size_t O_SREP = O_LRUP + (size_t)DEPTH * NB * 256;
constexpr size_t O_SIMP = O_SREP + (size_t)DEPTH * NB * 1024;
constexpr size_t O_KP = O_SIMP + (size_t)DEPTH * NB * 1024;
constexpr size_t O_VP = O_KP + (size_t)DEPTH * NB * 128 * 128;
constexpr size_t O_CONVS = O_VP + (size_t)DEPTH * NB * 128 * 128;
constexpr size_t O_LRUS = O_CONVS + (size_t)DEPTH * SB * 3 * 256;
constexpr size_t O_SRES = O_LRUS + (size_t)DEPTH * SB * 256;
constexpr size_t O_SIMS = O_SRES + (size_t)DEPTH * SB * 1024;
constexpr size_t O_KS = O_SIMS + (size_t)DEPTH * SB * 1024;
constexpr size_t O_VS = O_KS + (size_t)DEPTH * SB * 16 * 128;
constexpr size_t O_END = O_VS + (size_t)DEPTH * SB * 16 * 128;
static_assert(O_END == 68501504, "d_out map");

constexpr size_t WS_WIN = 0;
constexpr size_t WS_WOUT = WS_WIN + (size_t)DEPTH * DIN * DM * 2;
constexpr size_t WS_WUP = WS_WOUT + (size_t)DEPTH * DM * DM * 2;
constexpr size_t WS_WDN = WS_WUP + (size_t)DEPTH * DFF * DM * 2;
constexpr size_t WS_ROPE = WS_WDN + (size_t)DEPTH * DM * DFF * 2;
constexpr size_t WS_GATE = WS_ROPE + (size_t)NPOS * 32 * 8;
constexpr size_t WS_SP = WS_GATE + (size_t)DEPTH * 2 * 4 * 64 * 64 * 2;
constexpr size_t WS_ABAR = WS_SP + (size_t)DEPTH * 256 * 4;
constexpr size_t WS_BBM = WS_ABAR + (size_t)DEPTH * 16 * 64 * 4 * 4;
constexpr size_t WS_CMT = WS_BBM + (size_t)DEPTH * 16 * 128 * 16 * 2;
constexpr size_t WS_WGT = WS_CMT + (size_t)DEPTH * 16 * 16 * 128 * 2;
constexpr size_t WS_KBS = WS_WGT + (size_t)DEPTH * 256 * 256 * 2;
constexpr size_t WS_VTS = WS_KBS + (size_t)DEPTH * SB * 144 * 128 * 2;
constexpr size_t WS_SMALL = WS_VTS + (size_t)DEPTH * SB * 128 * 144 * 2;
constexpr int SM_CCONV = 0, SM_SLRU = SM_CCONV + DEPTH * SB * 3 * 256, SM_SSRE = SM_SLRU + DEPTH * SB * 256, SM_SSIM = SM_SSRE + DEPTH * SB * 1024, SM_CW = SM_SSIM + DEPTH * SB * 1024,
              SM_CB = SM_CW + DEPTH * 4 * 256, SM_BRG = SM_CB + DEPTH * 256, SM_BIG = SM_BRG + DEPTH * 256, SM_SD = SM_BIG + DEPTH * 256, SM_BGLU = SM_SD + DEPTH * 256,
              SM_SINK = SM_BGLU + DEPTH * 256, SM_NF = SM_SINK + 64, SM_END = SM_NF + DM;
constexpr size_t WS_SS = WS_SMALL + (size_t)((SM_END * 4 + 255) / 256) * 256;
constexpr size_t WS_SUMA = WS_SS + (size_t)MPAD * 16 * 4;
constexpr size_t WS_SUMB = WS_SUMA + (size_t)NB * 64 * 256 * 4;
constexpr size_t WS_SUMS = WS_SUMB + (size_t)NB * 64 * 256 * 4;
constexpr size_t WS_FOLD = WS_SUMS + (size_t)NB * 64 * 16 * 128 * 4;
constexpr size_t WS_XB = WS_FOLD + (size_t)320 * 16 * 128 * 4;
constexpr size_t WS_XRES = WS_XB + (size_t)MPAD * DM * 2;
constexpr size_t WS_BIG = WS_XRES + (size_t)MPAD * DM * 4;
constexpr size_t WS_UA = WS_BIG;
constexpr size_t WS_GA = WS_UA + (size_t)MPAD * 256 * 2;
constexpr size_t WS_UB = WS_GA + (size_t)MPAD * 256 * 2;
constexpr size_t WS_Q = WS_UB + (size_t)MPAD * 256 * 2;
constexpr size_t WS_KBP = WS_Q + (size_t)MPAD * 512 * 2;
constexpr size_t WS_VTP = WS_KBP + (size_t)MP * 128 * 2;
constexpr size_t WS_MIX = WS_VTP + (size_t)NB * 128 * SEQ * 2;
constexpr size_t WS_MIXEND = WS_MIX + (size_t)MPAD * DM * 2;
constexpr size_t WS_HID = WS_BIG;
constexpr size_t WS_END = WS_BIG + (size_t)MPAD * DFF * 2;
constexpr size_t WS_CTL = WS_END, CTL_BYTES = 16384;
constexpr size_t WS_TOTAL = WS_CTL + CTL_BYTES;
static_assert(WS_MIXEND <= WS_END && WS_TOTAL <= (size_t)1 << 30, "d_ws map");

struct Params { const float* in[33]; float* out; unsigned char* ws; };
enum { I_XP = 0, I_XS, I_CCONV, I_SLRU, I_SSRE, I_SSIM, I_CK, I_CV, I_N1, I_WIN, I_CW, I_CB, I_WRG, I_BRG, I_WIG, I_BIG_, I_LAM,
       I_ARE, I_AIM, I_BRE, I_BIM, I_CRE, I_CIM, I_SD, I_LDT, I_WGLU, I_BGLU, I_SINK, I_WOUT, I_N2, I_WUP, I_WDN, I_NF };

__device__ __forceinline__ float bf2f(short v) { return __uint_as_float(((unsigned)(unsigned short)v) << 16); }
__device__ __forceinline__ bf16_t f2bf(float v) { return (bf16_t)(cvt_pk_bf16(v, 0.f) & 0xffffu); }
__device__ __forceinline__ float sigmoidf_(float x) { return __builtin_amdgcn_rcpf(1.f + __expf(-x)); }
__device__ __forceinline__ float gelu_tanh(float x) { const float u = 1.5957691216f * (x + 0.044715f * x * x * x); return x * __builtin_amdgcn_rcpf(1.f + __expf(-u)); }
__device__ __forceinline__ f32x4 mma16(bf16x8 x, bf16x8 y, f32x4 acc) { return __builtin_amdgcn_mfma_f32_16x16x32_bf16(x, y, acc, 0, 0, 0); }
__device__ __forceinline__ float wave_sum(float v) {
#pragma unroll
    for (int o = 1; o < 64; o <<= 1) v += __shfl_xor(v, o);
    return v;
}
__device__ __forceinline__ void store8(bf16_t* dst, const float (&v)[8]) {
    u32x4 w; w.x = cvt_pk_bf16(v[0], v[1]); w.y = cvt_pk_bf16(v[2], v[3]); w.z = cvt_pk_bf16(v[4], v[5]); w.w = cvt_pk_bf16(v[6], v[7]);
    *(u32x4*)dst = w;
}
__device__ __forceinline__ float ss_rs(const float* ss, int row) {
    const f32x4* s4 = (const f32x4*)(ss + (size_t)row * 16);
    const f32x4 a = s4[0], b = s4[1], c = s4[2], d = s4[3];
    const float tot = (((a[0] + a[1]) + (a[2] + a[3])) + ((b[0] + b[1]) + (b[2] + b[3]))) + (((c[0] + c[1]) + (c[2] + c[3])) + ((d[0] + d[1]) + (d[2] + d[3])));
    return __builtin_amdgcn_rsqf(tot * (1.f / 1024.f) + EPS);
}
__device__ __forceinline__ void rope8(float (&v)[8], const float* rope, int pos, int jp) {
    const f32x4* r = (const f32x4*)(rope + ((size_t)pos * 32 + jp) * 2);
    const f32x4 a = r[0], b = r[1];
    float x1, x2;
    x1 = v[0]; x2 = v[1]; v[0] = x1 * a[0] - x2 * a[1]; v[1] = x2 * a[0] + x1 * a[1];
    x1 = v[2]; x2 = v[3]; v[2] = x1 * a[2] - x2 * a[3]; v[3] = x2 * a[2] + x1 * a[3];
    x1 = v[4]; x2 = v[5]; v[4] = x1 * b[0] - x2 * b[1]; v[5] = x2 * b[0] + x1 * b[1];
    x1 = v[6]; x2 = v[7]; v[6] = x1 * b[2] - x2 * b[3]; v[7] = x2 * b[2] + x1 * b[3];
}

__device__ __forceinline__ void rs8(float (&rsv)[2][4], const float* ss, int rowbase, int fq) {
    f32x4 part[2][4];
#pragma unroll
    for (int ai = 0; ai < 2; ++ai)
#pragma unroll
        for (int m = 0; m < 4; ++m) { const int row = rowbase + ai * 128 + m * 16;
            part[ai][m] = (f32x4){0.f, 0.f, 0.f, 0.f};
            if (row < MREAL) part[ai][m] = *(const f32x4*)(ss + (size_t)row * 16 + 4 * fq); }
#pragma unroll
    for (int ai = 0; ai < 2; ++ai)
#pragma unroll
        for (int m = 0; m < 4; ++m) { float t = (part[ai][m][0] + part[ai][m][1]) + (part[ai][m][2] + part[ai][m][3]);
            t += __shfl_xor(t, 16); t += __shfl_xor(t, 32);
            rsv[ai][m] = __builtin_amdgcn_rsqf(t * (1.f / 1024.f) + EPS); }
}

struct EpiIn {
    static constexpr bool PERM = true, AFTER_DRAIN = false;
    unsigned char* ws; float* out; int l;
    __device__ __forceinline__ void operator()(const f32x4 (&acc)[2][2][4][2], const pg8::Unit& u, int wr, int wc, int fr, int fq) const {
        asm volatile("" : "+v"(fr), "+v"(fq)); asm volatile("" : "+s"(wr), "+s"(wc));
        const int pn = u.pn;
        const float* ss = (const float*)(ws + WS_SS); const float* rope = (const float*)(ws + WS_ROPE);
        bf16_t* ua = (bf16_t*)(ws + WS_UA); bf16_t* ga = (bf16_t*)(ws + WS_GA); bf16_t* ub = (bf16_t*)(ws + WS_UB); bf16_t* q = (bf16_t*)(ws + WS_Q);
        bf16_t* kbp = (bf16_t*)(ws + WS_KBP); bf16_t* vtp = (bf16_t*)(ws + WS_VTP);
        bf16_t* kbs = (bf16_t*)(ws + WS_KBS) + (size_t)l * SB * 144 * 128; bf16_t* vts = (bf16_t*)(ws + WS_VTS) + (size_t)l * SB * 128 * 144;
        float* conv_p = out + O_CONVP + (size_t)l * NB * 3 * 256; float* conv_s = out + O_CONVS + (size_t)l * SB * 3 * 256;
        float* k_p = out + O_KP + (size_t)l * NB * 128 * 128; float* v_p = out + O_VP + (size_t)l * NB * 128 * 128;
        float* k_s = out + O_KS + (size_t)l * SB * 16 * 128; float* v_s = out + O_VS + (size_t)l * SB * 16 * 128;
        float rsv[2][4]; rs8(rsv, ss, u.pm * 256 + wr * 64 + fr, fq);
#pragma unroll
        for (int bjo = 0; bjo < 2; ++bjo) {
#pragma unroll
        for (int ai = 0; ai < 2; ++ai)
#pragma unroll
            for (int m = 0; m < 4; ++m) {
                const int row = u.pm * 256 + ai * 128 + wr * 64 + m * 16 + fr;
                if (row < MREAL) {
                    const float rs = rsv[ai][m];
                    const bool smp = row >= MP;
                    const int b = smp ? (row - MP) >> 4 : row >> 12, t = smp ? (row - MP) & 15 : row & 4095, pos = smp ? SEQ + t : t;
#pragma unroll
                    for (int bj = bjo; bj < bjo + 1; ++bj) {
                        const int c0 = bj * 128 + wc * 32 + fq * 8;
                        float v[8];
#pragma unroll
                        for (int e = 0; e < 4; ++e) { v[e] = acc[ai][bj][m][0][e] * rs; v[4 + e] = acc[ai][bj][m][1][e] * rs; }
                        if (pn <= 2) {
                            bf16_t* dst = (pn == 0 ? ua : (pn == 1 ? ga : ub)) + (size_t)row * 256 + c0;
                            store8(dst, v);
                            if (pn == 0) {
                                const int tt = smp ? t - (SS - 3) : t - (SEQ - 3);
                                if (tt >= 0) { float* o = (smp ? conv_s : conv_p) + (size_t)(b * 3 + tt) * 256 + c0;
                                    *(f32x4*)o = (f32x4){v[0], v[1], v[2], v[3]}; *(f32x4*)(o + 4) = (f32x4){v[4], v[5], v[6], v[7]}; }
                            }
                        } else if (pn <= 4) {
                            rope8(v, rope, pos, (c0 & 63) >> 1);
#pragma unroll
                            for (int e = 0; e < 8; ++e) v[e] *= 0.125f;
                            store8(q + (size_t)row * 512 + (pn - 3) * 256 + c0, v);
                        } else if (bj == 0) {
                            const int kvh = c0 >> 6, jp = (c0 & 63) >> 1;
                            rope8(v, rope, pos, jp);
                            bf16_t* dst = smp ? kbs + (size_t)(b * 144 + 128 + t) * 128 + c0 : kbp + (size_t)row * 128 + c0;
                            store8(dst, v);
                            const int tt = smp ? t : t - (SEQ - 128);
                            if (tt >= 0) { float* o = (smp ? k_s + ((size_t)(b * SS + tt) * 2 + kvh) * 64 : k_p + ((size_t)(b * 128 + tt) * 2 + kvh) * 64) + jp;
                                *(f32x4*)o = (f32x4){v[0], v[2], v[4], v[6]}; *(f32x4*)(o + 32) = (f32x4){v[1], v[3], v[5], v[7]}; }
                        } else {
                            const int cv = c0 - 128, kvh = cv >> 6, d0 = cv & 63;
                            if (!smp) { bf16_t* dst = vtp + (size_t)(b * 128 + cv) * SEQ + t;
#pragma unroll
                                for (int e = 0; e < 8; ++e) dst[(size_t)e * SEQ] = f2bf(v[e]);
                            } else { bf16_t* dst = vts + (size_t)(b * 128 + cv) * 144 + 128 + t;
#pragma unroll
                                for (int e = 0; e < 8; ++e) dst[e * 144] = f2bf(v[e]); }
                            const int tt = smp ? t : t - (SEQ - 128);
                            if (tt >= 0) { float* o = (smp ? v_s + ((size_t)(b * SS + tt) * 2 + kvh) * 64 : v_p + ((size_t)(b * 128 + tt) * 2 + kvh) * 64) + d0;
                                *(f32x4*)o = (f32x4){v[0], v[1], v[2], v[3]}; *(f32x4*)(o + 4) = (f32x4){v[4], v[5], v[6], v[7]}; }
                        }
                    }
                }
            }
        asm volatile("" ::: "memory");
        }
    }
};

struct EpiRes {
    static constexpr bool PERM = true, AFTER_DRAIN = false;
    const __attribute__((address_space(1))) float *xin_p, *xin_s;
    float *xout_p, *xout_s; bf16_t* xb; float* ss;
    __device__ __forceinline__ void operator()(const f32x4 (&acc)[2][2][4][2], const pg8::Unit& u, int wr, int wc, int fr, int fq) const {
        asm volatile("" : "+v"(fr), "+v"(fq)); asm volatile("" : "+s"(wr), "+s"(wc));
        const int pn = u.pn;
#pragma unroll
        for (int ai = 0; ai < 2; ++ai)
#pragma unroll
            for (int m = 0; m < 4; ++m) {
                const int row = u.pm * 256 + ai * 128 + wr * 64 + m * 16 + fr;
                const bool valid = row < MREAL;
                float sq = 0.f;
                if (valid) {
                    const size_t ro = row < MP ? (size_t)row * DM : (size_t)(row - MP) * DM;
                    const __attribute__((address_space(1))) float* xi = (row < MP ? xin_p : xin_s) + ro; float* xo = (row < MP ? xout_p : xout_s) + ro;
#pragma unroll
                    for (int bj = 0; bj < 2; ++bj) {
                        const int c = pn * 256 + bj * 128 + wc * 32 + fq * 8;
                        const f32x4 a0 = *(const __attribute__((address_space(1))) f32x4*)(xi + c) + acc[ai][bj][m][0], a1 = *(const __attribute__((address_space(1))) f32x4*)(xi + c + 4) + acc[ai][bj][m][1];
                        if (xout_p) { *(f32x4*)(xo + c) = a0; *(f32x4*)(xo + c + 4) = a1; }
                        sq += ((a0[0] * a0[0] + a0[1] * a0[1]) + (a0[2] * a0[2] + a0[3] * a0[3])) + ((a1[0] * a1[0] + a1[1] * a1[1]) + (a1[2] * a1[2] + a1[3] * a1[3]));
                        if (xb) { u32x4 w; w.x = cvt_pk_bf16(a0[0], a0[1]); w.y = cvt_pk_bf16(a0[2], a0[3]); w.z = cvt_pk_bf16(a1[0], a1[1]); w.w = cvt_pk_bf16(a1[2], a1[3]);
                            *(u32x4*)(xb + (size_t)row * DM + c) = w; }
                    }
                }
                sq += __shfl_xor(sq, 16); sq += __shfl_xor(sq, 32);
                if (valid && fq == 0) ss[(size_t)row * 16 + pn * 4 + wc] = sq;
            }
    }
};

struct EpiResB {
    static constexpr bool PERM = true, AFTER_DRAIN = false;
    bf16_t* xb; float* ss;
    __device__ __forceinline__ void operator()(const f32x4 (&acc)[2][2][4][2], const pg8::Unit& u, int wr, int wc, int fr, int fq) const {
        asm volatile("" : "+v"(fr), "+v"(fq)); asm volatile("" : "+s"(wr), "+s"(wc));
        const int pn = u.pn;
#pragma unroll
        for (int ai = 0; ai < 2; ++ai) {
            u32x4 xw[4][2];
#pragma unroll
            for (int m = 0; m < 4; ++m) {
                const int row = u.pm * 256 + ai * 128 + wr * 64 + m * 16 + fr;
#pragma unroll
                for (int bj = 0; bj < 2; ++bj) { xw[m][bj] = (u32x4){0u, 0u, 0u, 0u};
                    if (row < MREAL) xw[m][bj] = *(const u32x4*)(xb + (size_t)row * DM + pn * 256 + bj * 128 + wc * 32 + fq * 8); }
            }
#pragma unroll
            for (int m = 0; m < 4; ++m) {
                const int row = u.pm * 256 + ai * 128 + wr * 64 + m * 16 + fr;
                const bool valid = row < MREAL;
                float sq = 0.f;
#pragma unroll
                for (int bj = 0; bj < 2; ++bj) {
                    const int c = pn * 256 + bj * 128 + wc * 32 + fq * 8;
                    const u32x4 w0 = xw[m][bj];
                    const f32x4 x0 = {__uint_as_float(w0.x << 16), __uint_as_float(w0.x & 0xffff0000u), __uint_as_float(w0.y << 16), __uint_as_float(w0.y & 0xffff0000u)};
                    const f32x4 x1 = {__uint_as_float(w0.z << 16), __uint_as_float(w0.z & 0xffff0000u), __uint_as_float(w0.w << 16), __uint_as_float(w0.w & 0xffff0000u)};
                    const f32x4 a0 = x0 + acc[ai][bj][m][0], a1 = x1 + acc[ai][bj][m][1];
                    sq += ((a0[0] * a0[0] + a0[1] * a0[1]) + (a0[2] * a0[2] + a0[3] * a0[3])) + ((a1[0] * a1[0] + a1[1] * a1[1]) + (a1[2] * a1[2] + a1[3] * a1[3]));
                    u32x4 w; w.x = cvt_pk_bf16(a0[0], a0[1]); w.y = cvt_pk_bf16(a0[2], a0[3]); w.z = cvt_pk_bf16(a1[0], a1[1]); w.w = cvt_pk_bf16(a1[2], a1[3]);
                    if (valid) *(u32x4*)(xb + (size_t)row * DM + c) = w;
                }
                sq += __shfl_xor(sq, 16); sq += __shfl_xor(sq, 32);
                if (valid && fq == 0) ss[(size_t)row * 16 + pn * 4 + wc] = sq;
            }
            asm volatile("" ::: "memory");
        }
    }
};

struct EpiUp {
    static constexpr bool PERM = true, AFTER_DRAIN = false;
    const float* ss; bf16_t* hid;
    __device__ __forceinline__ void operator()(const f32x4 (&acc)[2][2][4][2], const pg8::Unit& u, int wr, int wc, int fr, int fq) const {
        asm volatile("" : "+v"(fr), "+v"(fq)); asm volatile("" : "+s"(wr), "+s"(wc));
        float rsv[2][4]; rs8(rsv, ss, u.pm * 256 + wr * 64 + fr, fq);
#pragma unroll
        for (int ai = 0; ai < 2; ++ai)
#pragma unroll
            for (int m = 0; m < 4; ++m) {
                const int row = u.pm * 256 + ai * 128 + wr * 64 + m * 16 + fr;
                if (row < MREAL) {
                    const float rs = rsv[ai][m];
#pragma unroll
                    for (int bj = 0; bj < 2; ++bj) {
                        const int c = u.pn * 256 + bj * 128 + wc * 32 + fq * 8;
                        float v[8];
#pragma unroll
                        for (int e = 0; e < 4; ++e) { float a = fmaxf(acc[ai][bj][m][0][e] * rs, 0.f), b = fmaxf(acc[ai][bj][m][1][e] * rs, 0.f); v[e] = a * a; v[4 + e] = b * b; }
                        store8(hid + (size_t)row * DFF + c, v);
                    }
                }
            }
    }
};

#define WSP(T, off) ((T*)(p.ws + (off)))
#define INP(i) ((const float*)(((const LAS unsigned long long*)(lds + L_PTAB))[i]))
#define LDS_WAIT() asm volatile("s_waitcnt lgkmcnt(0)" ::: "memory")

__device__ __forceinline__ void sincos_d(double x, double& s, double& c) {
    const double TWO_PI = 6.283185307179586476925;
    const double k = rint(x / TWO_PI), r = x - k * TWO_PI, r2 = r * r;
    double ps = 1.0, pc = 1.0;
#pragma unroll
    for (int n = 15; n >= 1; --n) { ps = 1.0 - r2 / ((2.0 * n) * (2.0 * n + 1.0)) * ps; pc = 1.0 - r2 / ((2.0 * n - 1.0) * (2.0 * n)) * pc; }
    s = r * ps; c = pc;
}

template <int MODE>
__device__ __forceinline__ void transpose_item(const float* W, const float* gain, int K, int N, bf16_t* WT, LAS float* scr, int item, int lane) {
    const int nblk = N / 32, kb = item / nblk, nb = item % nblk, k0 = 64 * kb, n0 = 32 * nb;
    float wv[32];
#pragma unroll
    for (int i = 0; i < 32; ++i) wv[i] = W[(size_t)(k0 + 2 * i + (lane >> 5)) * N + n0 + (lane & 31)];
    if (gain) {
#pragma unroll
        for (int i = 0; i < 32; ++i) wv[i] *= gain[k0 + 2 * i + (lane >> 5)];
    }
#pragma unroll
    for (int i = 0; i < 32; ++i) scr[(2 * i + (lane >> 5)) * 33 + (lane & 31)] = wv[i];
    LDS_WAIT();
    const int c = lane & 7;
#pragma unroll
    for (int j = 0; j < 4; ++j) { const int n = (lane >> 3) + 8 * j; const LAS float* s = scr + (8 * c) * 33 + n;
        u32x4 o; o.x = cvt_pk_bf16(s[0 * 33], s[1 * 33]); o.y = cvt_pk_bf16(s[2 * 33], s[3 * 33]); o.z = cvt_pk_bf16(s[4 * 33], s[5 * 33]); o.w = cvt_pk_bf16(s[6 * 33], s[7 * 33]);
        int nn = n0 + n;
        if (MODE == 1 && nn >= 768 && nn < 1408) { const int r = nn - 768, d = r & 63; nn = 768 + (r & ~63) + 2 * (d & 31) + (d >> 5); }
        *(u32x4*)(WT + (size_t)nn * K + k0 + 8 * c) = o; }
    LDS_WAIT();
}

__device__ __forceinline__ void prologue(const Params& p, LAS unsigned char* lds) {
    const int tid = threadIdx.x, lane = tid & 63, wave = tid >> 6;
    const int gw = blockIdx.x * NWAVES + wave, NGW = gridDim.x * NWAVES, gt = blockIdx.x * NTHR + tid, NGT = gridDim.x * NTHR;
    LAS float* scr = (LAS float*)(lds + wave * 16384);
#pragma unroll 1
    for (int ph = 0; ph < 2; ++ph) {
      if (((ph ^ wave) & 1) == 0) {
    constexpr int I_IN = 16 * 48, I_OUT = 16 * 32, I_UP = 16 * 128, I_DN = 64 * 32, I_L = I_IN + I_OUT + I_UP + I_DN;
    for (int it = gw; it < DEPTH * I_L; it += NGW) {
        const int l = it / I_L; int r = it % I_L;
        if (r < I_IN) { transpose_item<1>(INP(I_WIN) + (size_t)l * DM * DIN, INP(I_N1) + l * DM, DM, DIN, WSP(bf16_t, WS_WIN) + (size_t)l * DIN * DM, scr, r, lane); continue; } r -= I_IN;
        if (r < I_OUT) { transpose_item<0>(INP(I_WOUT) + (size_t)l * DM * DM, nullptr, DM, DM, WSP(bf16_t, WS_WOUT) + (size_t)l * DM * DM, scr, r, lane); continue; } r -= I_OUT;
        if (r < I_UP) { transpose_item<0>(INP(I_WUP) + (size_t)l * DM * DFF, INP(I_N2) + l * DM, DM, DFF, WSP(bf16_t, WS_WUP) + (size_t)l * DFF * DM, scr, r, lane); continue; } r -= I_UP;
        transpose_item<0>(INP(I_WDN) + (size_t)l * DFF * DM, nullptr, DFF, DM, WSP(bf16_t, WS_WDN) + (size_t)l * DM * DFF, scr, r, lane);
    }
      } else {
    {
        bf16_t* xb = WSP(bf16_t, WS_XB); float* ss = WSP(float, WS_SS);
        static_assert(MPAD % 4 == 0 && MREAL % 4 == 0 && MP % 4 == 0, "row groups of 4");
#pragma unroll 1
        for (int row0 = gw * 4; row0 < MPAD; row0 += NGW * 4) {
            f32x4 v[4][4];
            if (row0 < MREAL) {
                const float* xbase = row0 < MP ? INP(I_XP) + (size_t)row0 * DM : INP(I_XS) + (size_t)(row0 - MP) * DM;
#pragma unroll
                for (int r = 0; r < 4; ++r)
#pragma unroll
                    for (int j = 0; j < 4; ++j) v[r][j] = ((const f32x4*)(xbase + (size_t)r * DM) + lane)[64 * j];
            } else {
#pragma unroll
                for (int r = 0; r < 4; ++r)
#pragma unroll
                    for (int j = 0; j < 4; ++j) v[r][j] = (f32x4){0.f, 0.f, 0.f, 0.f};
            }
#pragma unroll
            for (int r = 0; r < 4; ++r) {
                float sq = 0.f;
#pragma unroll
                for (int j = 0; j < 4; ++j) sq += (v[r][j][0] * v[r][j][0] + v[r][j][1] * v[r][j][1]) + (v[r][j][2] * v[r][j][2] + v[r][j][3] * v[r][j][3]);
                const float tot = wave_sum(sq);
                unsigned long long* o8 = (unsigned long long*)(xb + (size_t)(row0 + r) * DM) + lane;
#pragma unroll
                for (int j = 0; j < 4; ++j) o8[64 * j] = (unsigned long long)cvt_pk_bf16(v[r][j][0], v[r][j][1]) | ((unsigned long long)cvt_pk_bf16(v[r][j][2], v[r][j][3]) << 32);
                if (lane < 16) ss[(size_t)(row0 + r) * 16 + lane] = lane == 0 ? tot : 0.f;
            }
        }
    }
      }
    }
    { float* sm = WSP(float, WS_SMALL);
#define CPY(I, OFF, N) for (int idx = gt; idx < (N); idx += NGT) sm[(OFF) + idx] = INP(I)[idx];
      CPY(I_CCONV, SM_CCONV, DEPTH * SB * 3 * 256) CPY(I_SLRU, SM_SLRU, DEPTH * SB * 256) CPY(I_SSRE, SM_SSRE, DEPTH * SB * 1024) CPY(I_SSIM, SM_SSIM, DEPTH * SB * 1024)
      CPY(I_CW, SM_CW, DEPTH * 4 * 256) CPY(I_CB, SM_CB, DEPTH * 256) CPY(I_BRG, SM_BRG, DEPTH * 256) CPY(I_BIG_, SM_BIG, DEPTH * 256) CPY(I_SD, SM_SD, DEPTH * 256)
      CPY(I_BGLU, SM_BGLU, DEPTH * 256) CPY(I_SINK, SM_SINK, DEPTH * 8) CPY(I_NF, SM_NF, DM)
#undef CPY
    }
    { float* rope = WSP(float, WS_ROPE);
      for (int idx = gt; idx < NPOS * 32; idx += NGT) { const int pos = idx >> 5, j = idx & 31;
          const float invf = (float)exp(-(double)j * (9.210340371976184 / 32.0)); double s, c; sincos_d((double)pos * (double)invf, s, c);
          rope[2 * idx] = (float)c; rope[2 * idx + 1] = (float)s; } }
    { bf16_t* gate = WSP(bf16_t, WS_GATE);
      for (int idx = gt; idx < DEPTH * 2 * 4 * 64 * 64; idx += NGT) { const int k = idx & 63, n = (idx >> 6) & 63, h = (idx >> 12) & 3, gt_ = (idx >> 14) & 1, l = idx >> 15;
          gate[idx] = f2bf((gt_ ? INP(I_WIG) : INP(I_WRG))[((size_t)(l * 4 + h) * 64 + k) * 64 + n]); } }
    { float* sp = WSP(float, WS_SP);
      for (int idx = gt; idx < DEPTH * 256; idx += NGT) sp[idx] = (float)log1p(exp(-(double)INP(I_LAM)[idx])); }
    { float* abar = WSP(float, WS_ABAR); bf16_t* bbm = WSP(bf16_t, WS_BBM);
      for (int idx = gt; idx < DEPTH * 16 * 64; idx += NGT) { const int lg = idx >> 6, pp = idx & 63;
          const double dt = exp((double)INP(I_LDT)[lg]), lr = (double)INP(I_ARE)[idx], li = (double)INP(I_AIM)[idx], mag = exp(lr * dt);
          double sn, cs; sincos_d(li * dt, sn, cs);
          const double ar = mag * cs, ai = mag * sn, den = lr * lr + li * li, nr = ar - 1.0, fr = (nr * lr + ai * li) / den, fi = (ai * lr - nr * li) / den;
          double xr = ar, xi = ai;
#pragma unroll
          for (int q = 0; q < 6; ++q) { const double t = xr * xr - xi * xi; xi = 2.0 * xr * xi; xr = t; }
          *(f32x4*)(abar + (size_t)idx * 4) = (f32x4){(float)ar, (float)ai, (float)xr, (float)xi};
          for (int c = 0; c < 16; ++c) { const double br = (double)INP(I_BRE)[(size_t)idx * 16 + c], bi = (double)INP(I_BIM)[(size_t)idx * 16 + c];
              bbm[((size_t)lg * 128 + pp) * 16 + c] = f2bf((float)(fr * br - fi * bi)); bbm[((size_t)lg * 128 + 64 + pp) * 16 + c] = f2bf((float)(fr * bi + fi * br)); } } }
    { bf16_t* cmt = WSP(bf16_t, WS_CMT);
      for (int idx = gt; idx < DEPTH * 16 * 16 * 128; idx += NGT) { const int k = idx & 127, lgc = idx >> 7;
          cmt[idx] = f2bf(k < 64 ? INP(I_CRE)[(size_t)lgc * 64 + k] : -INP(I_CIM)[(size_t)lgc * 64 + k - 64]); } }
    { bf16_t* wgt = WSP(bf16_t, WS_WGT);
      for (int idx = gt; idx < DEPTH * 65536; idx += NGT) { const int k = idx & 255, n = (idx >> 8) & 255, l = idx >> 16;
          wgt[idx] = f2bf(INP(I_WGLU)[((size_t)l * 256 + k) * 256 + n]); } }
    { bf16_t* kbs = WSP(bf16_t, WS_KBS); bf16_t* vts = WSP(bf16_t, WS_VTS);
      for (int idx = gt; idx < DEPTH * SB * 128 * 128; idx += NGT) { const int col = idx & 127, i = (idx >> 7) & 127, lb = idx >> 14;
          const int kvh = col >> 6, ph = col & 63, d = (ph >> 1) + 32 * (ph & 1);
          kbs[((size_t)lb * 144 + i) * 128 + col] = f2bf(INP(I_CK)[(((size_t)lb * 128 + i) * 2 + kvh) * 64 + d]);
          vts[((size_t)lb * 128 + col) * 144 + i] = f2bf(INP(I_CV)[((size_t)lb * 128 + i) * 128 + col]); } }
}

constexpr int L_AL = 0, L_BL = 33792;
constexpr int L_BU = 0;
constexpr int L_UA = 67584;
constexpr int L_SL = 67584;
constexpr int L_UZ = 103424;
constexpr int L_PAR = 137216;
constexpr int L_KL = 0, L_VL = 52224;
constexpr int UP = 264;
constexpr int P_CW = 0, P_CB = 1024, P_BRG = 1280, P_BIG = 1536, P_SP = 1792, P_SD = 2048, P_BGLU = 2304;
static_assert(L_PAR + 2560 * 4 <= L_MISC && L_UA + 67 * UP * 2 <= L_UZ && L_UZ + 64 * UP * 2 <= L_PAR && L_VL + 128 * 400 <= L_UZ, "mixer LDS map");

template <int NT, bool SMP>
__device__ __forceinline__ void stage_uab(const Params& p, int l, int b, int c, LAS unsigned char* lds) {
    int tid_ = threadIdx.x; asm volatile("" : "+v"(tid_));
    const int tid = tid_;
    const bf16_t* ua = WSP(const bf16_t, WS_UA); const bf16_t* ub = WSP(const bf16_t, WS_UB);
    const size_t seq0 = SMP ? (size_t)MP + b * SS : (size_t)b * SEQ;
    const int ts0 = SMP ? 0 : c * 64;
    constexpr int NR = NT * 16 + 3, NIA = (NR * 32 + NTHR - 1) / NTHR, NIB = (NT * 16 * 32 + NTHR - 1) / NTHR;
    u32x4 va[NIA], vb[NIB];
#pragma unroll
    for (int i = 0; i < NIA; ++i) { const int idx = tid + i * NTHR, r = idx >> 5, ck = idx & 31, ts = ts0 - 3 + r;
        va[i] = (u32x4){0u, 0u, 0u, 0u};
        if (idx < NR * 32) {
            if (ts >= 0) va[i] = *(const u32x4*)(ua + (seq0 + ts) * 256 + 8 * ck);
            else if (SMP) { const float* h = WSP(const float, WS_SMALL) + SM_CCONV + ((size_t)(l * SB + b) * 3 + (3 + ts)) * 256 + 8 * ck;
                const f32x4 x = *(const f32x4*)h, y = *(const f32x4*)(h + 4);
                va[i] = (u32x4){cvt_pk_bf16(x[0], x[1]), cvt_pk_bf16(x[2], x[3]), cvt_pk_bf16(y[0], y[1]), cvt_pk_bf16(y[2], y[3])}; }
        } }
#pragma unroll
    for (int i = 0; i < NIB; ++i) { const int idx = tid + i * NTHR, t = idx >> 5, ck = idx & 31;
        vb[i] = (u32x4){0u, 0u, 0u, 0u};
        if (idx < NT * 16 * 32) vb[i] = *(const u32x4*)(ub + (seq0 + ts0 + t) * 256 + 8 * ck); }
#pragma unroll
    for (int i = 0; i < NIA; ++i) { const int idx = tid + i * NTHR, r = idx >> 5, ck = idx & 31;
        if (idx < NR * 32) *(LAS u32x4*)(lds + L_UA + r * (UP * 2) + ck * 16) = va[i]; }
#pragma unroll
    for (int i = 0; i < NIB; ++i) { const int idx = tid + i * NTHR, t = idx >> 5, ck = idx & 31;
        if (idx < NT * 16 * 32) *(LAS u32x4*)(lds + L_UZ + t * (UP * 2) + ck * 16) = vb[i]; }
}

template <int NV>
__device__ __forceinline__ void conv_lds(float (&xc)[NV], const LAS bf16_t* uaL, const LAS float* par, int tl, int ch) {
#pragma unroll
    for (int e = 0; e < NV; e += 4) { const f32x4 cb = *(const LAS f32x4*)(par + P_CB + ch + e); xc[e] = cb[0]; xc[e + 1] = cb[1]; xc[e + 2] = cb[2]; xc[e + 3] = cb[3]; }
#pragma unroll
    for (int j = 0; j < 4; ++j) {
        float w[NV];
#pragma unroll
        for (int e = 0; e < NV; e += 4) { const f32x4 cw = *(const LAS f32x4*)(par + P_CW + j * 256 + ch + e); w[e] = cw[0]; w[e + 1] = cw[1]; w[e + 2] = cw[2]; w[e + 3] = cw[3]; }
        const LAS bf16_t* src = uaL + (tl + j) * UP + ch;
        if constexpr (NV == 8) { const bf16x8 v = *(const LAS bf16x8*)src;
#pragma unroll
            for (int e = 0; e < 8; ++e) xc[e] += bf2f(v[e]) * w[e];
        } else { const bf16x4 v = *(const LAS bf16x4*)src;
#pragma unroll
            for (int e = 0; e < 4; ++e) xc[e] += bf2f(v[e]) * w[e]; }
    }
}

template <int NT, bool SMP>
__device__ __forceinline__ void lru_item(const Params& p, int l, int b, int c, int pass, LAS unsigned char* lds, float& hfold, int cprev) {
    constexpr int HT = NT >= 2 ? 2 : 1, NH = NT / HT, TS = HT * 16 + 1, NPF = HT * 16 * 128 / NTHR;
    LAS float* aL = (LAS float*)(lds + L_AL); LAS float* bL = (LAS float*)(lds + L_BL);
    const LAS bf16_t* uaL = (const LAS bf16_t*)(lds + L_UA); const LAS float* par = (const LAS float*)(lds + L_PAR);
    int tid_ = threadIdx.x; asm volatile("" : "+v"(tid_));
    const int tid = tid_, wid = __builtin_amdgcn_readfirstlane(tid >> 6), lane = tid & 63, l15 = lane & 15, g = lane >> 4, h = wid >> 1, nh = wid & 1;
    const bf16_t* ga = WSP(const bf16_t, WS_GA); bf16_t* mix = WSP(bf16_t, WS_MIX);
    const size_t row0 = SMP ? (size_t)MP + b * SS : (size_t)b * SEQ + c * 64;
    const bf16_t* gwt = WSP(const bf16_t, WS_GATE) + (size_t)l * 2 * 4 * 4096;
    bf16x8 xr[2][2], xi[2][2];
#pragma unroll
    for (int nt2 = 0; nt2 < 2; ++nt2)
#pragma unroll
        for (int ks = 0; ks < 2; ++ks) { const int n = 32 * nh + 16 * nt2 + l15;
            xr[nt2][ks] = *(const bf16x8*)(gwt + ((size_t)(0 * 4 + h) * 64 + n) * 64 + 32 * ks + 8 * g);
            xi[nt2][ks] = *(const bf16x8*)(gwt + ((size_t)(1 * 4 + h) * 64 + n) * 64 + 32 * ks + 8 * g); }
    float fA[16], fB[16], hsm = 0.f;
#pragma unroll
    for (int i = 0; i < 16; ++i) { fA[i] = 1.f; fB[i] = 0.f; }
    if (tid < 256) {
        if (SMP) hsm = WSP(const float, WS_SMALL)[SM_SLRU + (size_t)(l * SB + b) * 256 + tid];
        else if (pass == 1) {
            const float* sA = WSP(const float, WS_SUMA) + (size_t)b * 64 * 256 + tid; const float* sB = WSP(const float, WS_SUMB) + (size_t)b * 64 * 256 + tid;
#pragma unroll
            for (int i = 0; i < 16; ++i) { const int cc = cprev + i < 63 ? cprev + i : 63; fA[i] = sA[cc * 256]; fB[i] = sB[cc * 256]; }
        }
    }
    {
        const int cgp = tid & 31, t0 = NT * (tid >> 5);
        float w[4][8], xc[NT][8];
#pragma unroll
        for (int j = 0; j < 4; ++j)
#pragma unroll
            for (int e = 0; e < 8; e += 4) { const f32x4 cw = *(const LAS f32x4*)(par + P_CW + j * 256 + 8 * cgp + e); w[j][e] = cw[0]; w[j][e + 1] = cw[1]; w[j][e + 2] = cw[2]; w[j][e + 3] = cw[3]; }
#pragma unroll
        for (int e = 0; e < 8; e += 4) { const f32x4 cb = *(const LAS f32x4*)(par + P_CB + 8 * cgp + e);
#pragma unroll
            for (int tk = 0; tk < NT; ++tk) { xc[tk][e] = cb[0]; xc[tk][e + 1] = cb[1]; xc[tk][e + 2] = cb[2]; xc[tk][e + 3] = cb[3]; } }
#pragma unroll
        for (int i = 0; i < NT + 3; ++i) { const bf16x8 v = *(const LAS bf16x8*)(uaL + (t0 + i) * UP + 8 * cgp);
#pragma unroll
            for (int tk = 0; tk < NT; ++tk) { const int j = i - tk; if (j >= 0 && j < 4) {
#pragma unroll
                for (int e = 0; e < 8; ++e) xc[tk][e] += bf2f(v[e]) * w[j][e]; } } }
        __syncthreads();
#pragma unroll
        for (int tk = 0; tk < NT; ++tk) { u32x4 o; o.x = cvt_pk_bf16(xc[tk][0], xc[tk][1]); o.y = cvt_pk_bf16(xc[tk][2], xc[tk][3]); o.z = cvt_pk_bf16(xc[tk][4], xc[tk][5]); o.w = cvt_pk_bf16(xc[tk][6], xc[tk][7]);
            *(LAS u32x4*)((LAS unsigned char*)(lds + L_UA) + ((t0 + tk) * UP + 8 * cgp) * 2) = o; }
        __syncthreads();
    }
    float hrun = 0.f, prun = 1.f;
    if (tid < 256) {
        if (SMP) hrun = hsm;
        else if (pass == 1) {
            float hf = hfold;
#pragma unroll
            for (int i = 0; i < 16; ++i) if (cprev + i < c) hf = fA[i] * hf + fB[i];
            hfold = hf; hrun = hf;
        }
    }
#pragma unroll 1
    for (int half = 0; half < NH; ++half) {
        unsigned gp[NPF];
        if (pass == 1) {
#pragma unroll
            for (int k = 0; k < NPF; ++k) { const int idx = tid + k * NTHR, t = idx >> 7, ch = 2 * (idx & 127); gp[k] = *(const unsigned*)(ga + (row0 + half * HT * 16 + t) * 256 + ch); }
        }
        f32x4 ar[2][HT], ai_[2][HT];
#pragma unroll
        for (int a = 0; a < 2; ++a)
#pragma unroll
            for (int t = 0; t < HT; ++t) { ar[a][t] = (f32x4){0.f, 0.f, 0.f, 0.f}; ai_[a][t] = (f32x4){0.f, 0.f, 0.f, 0.f}; }
#pragma unroll
        for (int tt = 0; tt < HT; ++tt) {
            const int tl = (half * HT + tt) * 16 + l15;
#pragma unroll
            for (int ks = 0; ks < 2; ++ks) {
                const bf16x8 y = *(const LAS bf16x8*)(uaL + tl * UP + 64 * h + 32 * ks + 8 * g);
#pragma unroll
                for (int nt2 = 0; nt2 < 2; ++nt2) { ar[nt2][tt] = mma16(xr[nt2][ks], y, ar[nt2][tt]); ai_[nt2][tt] = mma16(xi[nt2][ks], y, ai_[nt2][tt]); }
            }
        }
#pragma unroll
        for (int nt2 = 0; nt2 < 2; ++nt2)
#pragma unroll
            for (int tt = 0; tt < HT; ++tt) {
                const int tl = (half * HT + tt) * 16 + l15, ch0 = 64 * h + 32 * nh + 16 * nt2 + 4 * g;
                const bf16x4 xv = *(const LAS bf16x4*)(uaL + tl * UP + ch0);
                const f32x4 br4 = *(const LAS f32x4*)(par + P_BRG + ch0), bi4 = *(const LAS f32x4*)(par + P_BIG + ch0), sp4 = *(const LAS f32x4*)(par + P_SP + ch0);
#pragma unroll
                for (int j = 0; j < 4; ++j) { const int ch = ch0 + j;
                    const float r = sigmoidf_(ar[nt2][tt][j] + br4[j]), ig = sigmoidf_(ai_[nt2][tt][j] + bi4[j]);
                    const float la = -8.0f * r * sp4[j], a = __expf(la), x2 = 2.0f * la;
                    const float ser = -x2 * (1.0f + x2 * (0.5f + x2 * (0.16666667f + x2 * (0.041666668f + x2 * 0.008333334f))));
                    const float mult = __builtin_amdgcn_sqrtf(x2 > -0.25f ? ser : 1.0f - a * a);
                    aL[ch * TS + tt * 16 + l15] = a; bL[ch * TS + tt * 16 + l15] = mult * ig * bf2f(xv[j]); }
            }
        __syncthreads();
        if (tid < 256) {
#pragma unroll 8
            for (int t = 0; t < HT * 16; ++t) { const float a = aL[tid * TS + t]; hrun = a * hrun + bL[tid * TS + t]; prun *= a; bL[tid * TS + t] = hrun; }
        }
        __syncthreads();
        if (pass == 1) {
#pragma unroll
            for (int k = 0; k < NPF; ++k) { const int idx = tid + k * NTHR, t = idx >> 7, ch = 2 * (idx & 127); const size_t row = row0 + half * HT * 16 + t;
                const float h0 = bL[ch * TS + t], h1 = bL[(ch + 1) * TS + t];
                const float g0 = __uint_as_float(gp[k] << 16), g1 = __uint_as_float(gp[k] & 0xffff0000u);
                *(unsigned*)(mix + row * DM + ch) = cvt_pk_bf16(h0 * gelu_tanh(g0), h1 * gelu_tanh(g1)); }
        }
        __syncthreads();
    }
    if (tid < 256) {
        if (!SMP && pass == 0) { WSP(float, WS_SUMA)[((size_t)b * 64 + c) * 256 + tid] = prun; WSP(float, WS_SUMB)[((size_t)b * 64 + c) * 256 + tid] = hrun; }
        if (pass == 1) { if (SMP) p.out[O_LRUS + (size_t)(l * SB + b) * 256 + tid] = hrun; else if (c == 63) p.out[O_LRUP + (size_t)(l * NB + b) * 256 + tid] = hrun; }
    }
}

template <int NT, bool SMP>
__device__ __forceinline__ void s5_item(const Params& p, int l, int b, int c, int pass, LAS unsigned char* lds, int cprev) {
    const bool fin = SMP || pass == 1;
    int tid_ = threadIdx.x; asm volatile("" : "+v"(tid_));
    const int tid = tid_, wid = __builtin_amdgcn_readfirstlane(tid >> 6), lane = tid & 63, l15 = lane & 15, g = lane >> 4;
    LAS float* buL = (LAS float*)(lds + L_BU + wid * 8448);
    LAS bf16_t* sL = (LAS bf16_t*)(lds + L_SL + wid * 4352);
    LAS bf16_t* uz = (LAS bf16_t*)(lds + L_UZ);
    const LAS float* par = (const LAS float*)(lds + L_PAR);
    bf16_t* mix = WSP(bf16_t, WS_MIX);
    const size_t row0 = SMP ? (size_t)MP + b * SS : (size_t)b * SEQ + c * 64;
    const float* abar = WSP(const float, WS_ABAR); const bf16_t* bbm = WSP(const bf16_t, WS_BBM); const bf16_t* cmt = WSP(const bf16_t, WS_CMT);
    const bf16x8 z8 = {0, 0, 0, 0, 0, 0, 0, 0};
    float zf = 0.f; asm volatile("" : "+v"(zf));
#pragma unroll 1
    for (int gi = 0; gi < 2; ++gi) {
        const int grp = 2 * wid + gi, lg = l * 16 + grp;
        const f32x4 ab = *(const f32x4*)(abar + ((size_t)lg * 64 + lane) * 4);
        float sre = 0.f, sim = 0.f;
        if (SMP) { sre = WSP(const float, WS_SMALL)[SM_SSRE + ((size_t)(l * SB + b) * 16 + grp) * 64 + lane]; sim = WSP(const float, WS_SMALL)[SM_SSIM + ((size_t)(l * SB + b) * 16 + grp) * 64 + lane]; }
        else if (pass == 1) {
            float* fs = WSP(float, WS_FOLD) + ((size_t)blockIdx.x * 16 + grp) * 128 + lane;
            if (cprev > 0) { sre = fs[0]; sim = fs[64]; }
            const float* S = WSP(const float, WS_SUMS) + ((size_t)b * 64 * 16 + grp) * 128 + lane;
            float re[16], im[16];
#pragma unroll
            for (int i = 0; i < 16; ++i) { const int cc = cprev + i < 63 ? cprev + i : 63; re[i] = S[(size_t)cc * 2048]; im[i] = S[(size_t)cc * 2048 + 64]; }
#pragma unroll
            for (int i = 0; i < 16; ++i) if (cprev + i < c) { const float nre = ab[2] * sre - ab[3] * sim + re[i], nim = ab[2] * sim + ab[3] * sre + im[i]; sre = nre; sim = nim; }
            fs[0] = sre; fs[64] = sim;
        }
        bf16x8 ybb[8], ycm[4];
#pragma unroll
        for (int pt = 0; pt < 8; ++pt) ybb[pt] = g < 2 ? *(const bf16x8*)(bbm + ((size_t)lg * 128 + 16 * pt + l15) * 16 + 8 * g) : z8;
#pragma unroll
        for (int ks = 0; ks < 4; ++ks) ycm[ks] = *(const bf16x8*)(cmt + ((size_t)lg * 16 + l15) * 128 + 32 * ks + 8 * g);
        const float dd = par[P_SD + 16 * grp + l15];
#pragma unroll 1
        for (int tt = 0; tt < NT; ++tt) {
            const bf16x8 x = g < 2 ? *(const LAS bf16x8*)(uz + (tt * 16 + l15) * UP + 16 * grp + 8 * g) : z8;
            LAS bf16_t* buT = (LAS bf16_t*)buL;
#pragma unroll
            for (int pt = 0; pt < 8; ++pt) { const f32x4 a = mma16(x, ybb[pt], (f32x4){0.f, 0.f, 0.f, 0.f});
                u32x2 w; w.x = cvt_pk_bf16(a[0] + zf, a[1] + zf); w.y = cvt_pk_bf16(a[2] + zf, a[3] + zf);
                *(LAS u32x2*)(buT + (16 * pt + l15) * 24 + 4 * g) = w; }
            LDS_WAIT();
            {
                const u32x4 r0 = *(const LAS u32x4*)(buT + lane * 24), r1 = *(const LAS u32x4*)(buT + lane * 24 + 8);
                const u32x4 i0 = *(const LAS u32x4*)(buT + (64 + lane) * 24), i1 = *(const LAS u32x4*)(buT + (64 + lane) * 24 + 8);
                const unsigned rw[8] = {r0.x, r0.y, r0.z, r0.w, r1.x, r1.y, r1.z, r1.w}, iw[8] = {i0.x, i0.y, i0.z, i0.w, i1.x, i1.y, i1.z, i1.w};
#pragma unroll
                for (int t = 0; t < 16; ++t) {
                    const float re = (t & 1) ? __uint_as_float(rw[t >> 1] & 0xffff0000u) : __uint_as_float(rw[t >> 1] << 16);
                    const float im = (t & 1) ? __uint_as_float(iw[t >> 1] & 0xffff0000u) : __uint_as_float(iw[t >> 1] << 16);
                    const float nre = ab[0] * sre - ab[1] * sim + re, nim = ab[0] * sim + ab[1] * sre + im; sre = nre; sim = nim;
                    if (fin) { sL[t * 136 + lane] = f2bf(sre); sL[t * 136 + 64 + lane] = f2bf(sim); } }
            }
            LDS_WAIT();
            if (fin) {
                f32x4 y = {0.f, 0.f, 0.f, 0.f};
#pragma unroll
                for (int ks = 0; ks < 4; ++ks) { const bf16x8 xs = *(const LAS bf16x8*)(sL + l15 * 136 + 32 * ks + 8 * g); y = mma16(xs, ycm[ks], y); }
#pragma unroll
                for (int j = 0; j < 4; ++j) { const int t = tt * 16 + 4 * g + j, ch = 16 * grp + l15;
                    const float u = bf2f((short)uz[t * UP + ch]); uz[t * UP + ch] = f2bf(gelu_tanh(y[j] + dd * u)); }
            }
            LDS_WAIT();
        }
        if (!SMP && pass == 0) { float* S = WSP(float, WS_SUMS) + (((size_t)b * 64 + c) * 16 + grp) * 128; S[lane] = sre; S[64 + lane] = sim; }
        if (pass == 1) {
            if (SMP) { p.out[O_SRES + ((size_t)(l * SB + b) * 16 + grp) * 64 + lane] = sre; p.out[O_SIMS + ((size_t)(l * SB + b) * 16 + grp) * 64 + lane] = sim; }
            else if (c == 63) { p.out[O_SREP + ((size_t)(l * NB + b) * 16 + grp) * 64 + lane] = sre; p.out[O_SIMP + ((size_t)(l * NB + b) * 16 + grp) * 64 + lane] = sim; }
        }
    }
    if (fin) {
        __syncthreads();
        const bf16_t* wgt = WSP(const bf16_t, WS_WGT) + (size_t)l * 65536;
#pragma unroll 1
        for (int nt2 = 0; nt2 < 2; ++nt2) {
            bf16x8 yw[8];
#pragma unroll
            for (int ks = 0; ks < 8; ++ks) yw[ks] = *(const bf16x8*)(wgt + (size_t)(32 * wid + 16 * nt2 + l15) * 256 + 32 * ks + 8 * g);
            const float bg = par[P_BGLU + 32 * wid + 16 * nt2 + l15];
#pragma unroll 1
            for (int tt = 0; tt < NT; ++tt) {
                f32x4 a = {0.f, 0.f, 0.f, 0.f};
#pragma unroll
                for (int ks = 0; ks < 8; ++ks) { const bf16x8 xz = *(const LAS bf16x8*)(uz + (tt * 16 + l15) * UP + 32 * ks + 8 * g); a = mma16(xz, yw[ks], a); }
#pragma unroll
                for (int j = 0; j < 4; ++j) { const int t = tt * 16 + 4 * g + j, n = 32 * wid + 16 * nt2 + l15;
                    const float z = bf2f((short)uz[t * UP + n]); mix[(row0 + t) * DM + 256 + n] = f2bf(z * sigmoidf_(a[j] + bg)); }
            }
        }
    }
    __syncthreads();
}

template <int NQT, bool SMP>
__device__ __forceinline__ void attn_item(const Params& p, int l, int b, int c, LAS unsigned char* lds) {
    int tid_ = threadIdx.x; asm volatile("" : "+v"(tid_));
    const int tid = tid_, wid = __builtin_amdgcn_readfirstlane(tid >> 6), lane = tid & 63, l15 = lane & 15, g = lane >> 4, kvh = wid >> 2;
    const bf16_t* q = WSP(const bf16_t, WS_Q); bf16_t* mix = WSP(bf16_t, WS_MIX);
    const bf16_t* kbase; const bf16_t* vbase; size_t vstride, row0; int nkt;
    if (SMP) { kbase = WSP(const bf16_t, WS_KBS) + (size_t)(l * SB + b) * 144 * 128; vbase = WSP(const bf16_t, WS_VTS) + (size_t)(l * SB + b) * 128 * 144; vstride = 144; nkt = 9; row0 = (size_t)MP + b * SS; }
    else { const int c0 = c >= 2 ? c - 2 : 0; kbase = WSP(const bf16_t, WS_KBP) + ((size_t)b * SEQ + c0 * 64) * 128; vbase = WSP(const bf16_t, WS_VTP) + (size_t)b * 128 * SEQ + c0 * 64;
        vstride = SEQ; nkt = 4 * (c - c0 + 1); row0 = (size_t)b * SEQ + c * 64; }
    bf16x8 yq[NQT][2];
#pragma unroll
    for (int qt = 0; qt < NQT; ++qt)
#pragma unroll
        for (int ks = 0; ks < 2; ++ks) yq[qt][ks] = *(const bf16x8*)(q + (row0 + qt * 16 + l15) * 512 + wid * 64 + 32 * ks + 8 * g);
    {
        const int nkc = nkt * 16 * 16, cpr = nkt * 2, nvc = 128 * cpr;
        u32x4 kv[6], vv[6];
#pragma unroll
        for (int i = 0; i < 6; ++i) { const int idx = tid + i * NTHR; kv[i] = (u32x4){0u, 0u, 0u, 0u};
            if (idx < nkc) kv[i] = *(const u32x4*)(kbase + (size_t)(idx >> 4) * 128 + 8 * (idx & 15)); }
#pragma unroll
        for (int i = 0; i < 6; ++i) { const int idx = tid + i * NTHR, r = idx / cpr, ck = idx - r * cpr; vv[i] = (u32x4){0u, 0u, 0u, 0u};
            if (idx < nvc) vv[i] = *(const u32x4*)(vbase + (size_t)r * vstride + 8 * ck); }
#pragma unroll
        for (int i = 0; i < 6; ++i) { const int idx = tid + i * NTHR; if (idx < nkc) *(LAS u32x4*)(lds + L_KL + (idx >> 4) * 272 + (idx & 15) * 16) = kv[i]; }
#pragma unroll
        for (int i = 0; i < 6; ++i) { const int idx = tid + i * NTHR, r = idx / cpr, ck = idx - r * cpr; if (idx < nvc) *(LAS u32x4*)(lds + L_VL + r * 400 + ck * 16) = vv[i]; }
    }
    __syncthreads();
    const float sink = WSP(const float, WS_SMALL)[SM_SINK + l * 8 + wid];
    const bf16x4 z4 = {0, 0, 0, 0};
    const LAS unsigned char* kL = lds + L_KL + l15 * 272 + (kvh * 64 + 8 * g) * 2;
    const LAS unsigned char* vL = lds + L_VL + (kvh * 64 + l15) * 400 + (4 * g) * 2;
    constexpr int QB = NQT >= 2 ? 2 : 1;
#pragma unroll
    for (int qp = 0; qp < NQT / QB; ++qp) {
        f32x4 s[QB][12];
#pragma unroll
        for (int kt = 0; kt < 12; ++kt) {
#pragma unroll
            for (int qb = 0; qb < QB; ++qb) s[qb][kt] = (f32x4){0.f, 0.f, 0.f, 0.f};
            if (kt < nkt) {
#pragma unroll
                for (int ks = 0; ks < 2; ++ks) { const bf16x8 x = *(const LAS bf16x8*)(kL + kt * 16 * 272 + ks * 64);
#pragma unroll
                    for (int qb = 0; qb < QB; ++qb) s[qb][kt] = mma16(x, yq[qp * QB + qb][ks], s[qb][kt]); } } }
        float inv[QB];
#pragma unroll
        for (int qb = 0; qb < QB; ++qb) {
            float mx = sink;
#pragma unroll
            for (int kt = 0; kt < 12; ++kt) if (kt < nkt) mx = fmaxf(fmaxf(mx, fmaxf(s[qb][kt][0], s[qb][kt][1])), fmaxf(s[qb][kt][2], s[qb][kt][3]));
            mx = fmaxf(mx, __shfl_xor(mx, 16)); mx = fmaxf(mx, __shfl_xor(mx, 32));
            float sum = 0.f;
#pragma unroll
            for (int kt = 0; kt < 12; ++kt) if (kt < nkt) {
#pragma unroll
                for (int j = 0; j < 4; ++j) { const float e = __expf(s[qb][kt][j] - mx); s[qb][kt][j] = e; sum += e; } }
            sum += __shfl_xor(sum, 16); sum += __shfl_xor(sum, 32); sum += __expf(sink - mx);
            inv[qb] = 1.0f / sum;
        }
        f32x4 o[QB][4];
#pragma unroll
        for (int qb = 0; qb < QB; ++qb)
#pragma unroll
            for (int dt = 0; dt < 4; ++dt) o[qb][dt] = (f32x4){0.f, 0.f, 0.f, 0.f};
#pragma unroll
        for (int kk = 0; kk < 6; ++kk) if (2 * kk < nkt) {
            bf16x8 y[QB];
#pragma unroll
            for (int qb = 0; qb < QB; ++qb) { u32x4 w; w.x = cvt_pk_bf16(s[qb][2 * kk][0], s[qb][2 * kk][1]); w.y = cvt_pk_bf16(s[qb][2 * kk][2], s[qb][2 * kk][3]);
                w.z = cvt_pk_bf16(s[qb][2 * kk + 1][0], s[qb][2 * kk + 1][1]); w.w = cvt_pk_bf16(s[qb][2 * kk + 1][2], s[qb][2 * kk + 1][3]);
                y[qb] = __builtin_bit_cast(bf16x8, w); }
            const bool hi = 2 * kk + 1 < nkt;
#pragma unroll
            for (int dt = 0; dt < 4; ++dt) { const LAS unsigned char* vr = vL + dt * 16 * 400 + kk * 64;
                const bf16x4 lo = *(const LAS bf16x4*)vr; const bf16x4 h4 = hi ? *(const LAS bf16x4*)(vr + 32) : z4;
                const bf16x8 x = __builtin_shufflevector(lo, h4, 0, 1, 2, 3, 4, 5, 6, 7);
#pragma unroll
                for (int qb = 0; qb < QB; ++qb) o[qb][dt] = mma16(x, y[qb], o[qb][dt]); }
        }
#pragma unroll
        for (int qb = 0; qb < QB; ++qb) { const size_t qrow = row0 + (qp * QB + qb) * 16 + l15;
#pragma unroll
            for (int dt = 0; dt < 4; ++dt) { u32x2 w; w.x = cvt_pk_bf16(o[qb][dt][0] * inv[qb], o[qb][dt][1] * inv[qb]); w.y = cvt_pk_bf16(o[qb][dt][2] * inv[qb], o[qb][dt][3] * inv[qb]);
                *(u32x2*)(mix + qrow * DM + 512 + wid * 64 + 16 * dt + 4 * g) = w; } }
    }
    __syncthreads();
}

__device__ __forceinline__ void mixer_pass(const Params& p, int l, int pass, LAS unsigned char* lds) {
    {
        LAS float* par = (LAS float*)(lds + L_PAR); const float* sm = WSP(const float, WS_SMALL);
        for (int i = threadIdx.x; i < 2560; i += NTHR) { float v;
            if (i < 1024) v = sm[SM_CW + l * 1024 + i];
            else { const int k = (i - 1024) >> 8, j = i & 255;
                v = k == 0 ? sm[SM_CB + l * 256 + j] : k == 1 ? sm[SM_BRG + l * 256 + j] : k == 2 ? sm[SM_BIG + l * 256 + j] : k == 3 ? WSP(const float, WS_SP)[l * 256 + j] : k == 4 ? sm[SM_SD + l * 256 + j] : sm[SM_BGLU + l * 256 + j]; }
            par[i] = v; }
        __syncthreads();
    }
    float hfold = 0.f; int cprev = 0;
#pragma unroll 1
    for (int it = blockIdx.x; it < NB * 64 + SB; it += gridDim.x) {
        if (it < NB * 64) { const int b = it & 15, c = it >> 4;
            stage_uab<4, false>(p, l, b, c, lds); __syncthreads();
#ifndef DUPM
#define DUPM 0
#endif
            { float hf0 = hfold; for (int r2 = 0; r2 < ((DUPM & 1) ? 2 : 1); ++r2) { hfold = hf0; lru_item<4, false>(p, l, b, c, pass, lds, hfold, cprev); } }
            for (int r2 = 0; r2 < ((DUPM & 2) ? 2 : 1); ++r2) { if ((DUPM & 2) && r2 == 1) { stage_uab<4, false>(p, l, b, c, lds); __syncthreads(); } s5_item<4, false>(p, l, b, c, pass, lds, r2 == 1 && pass == 1 ? c : cprev); }
            cprev = c;
            for (int r2 = 0; r2 < ((DUPM & 4) ? 2 : 1); ++r2) if (pass == 0) attn_item<4, false>(p, l, b, c, lds);
        } else { const int b = it - NB * 64;
            if (pass == 0) { attn_item<1, true>(p, l, b, 0, lds);
                float hf = 0.f; stage_uab<1, true>(p, l, b, 0, lds); __syncthreads(); lru_item<1, true>(p, l, b, 0, 1, lds, hf, 0); s5_item<1, true>(p, l, b, 0, 1, lds, 0); }
        }
    }
}

__device__ __forceinline__ void final_norm(const Params& p) {
    int tid_ = threadIdx.x; asm volatile("" : "+v"(tid_));
    const int lane = tid_ & 63, gw = blockIdx.x * NWAVES + (tid_ >> 6), NGW = gridDim.x * NWAVES;
    const float* ss = WSP(const float, WS_SS); const f32x4* nf = (const f32x4*)(WSP(const float, WS_SMALL) + SM_NF) + 2 * lane;
    const bf16_t* xb = WSP(const bf16_t, WS_XB);
    static_assert(MREAL % 4 == 0, "row groups of 4");
    f32x4 g[2][2];
#pragma unroll
    for (int j = 0; j < 2; ++j) { g[j][0] = nf[128 * j]; g[j][1] = nf[128 * j + 1]; }
#pragma unroll 1
    for (int row0 = gw * 4; row0 < MREAL; row0 += NGW * 4) {
        u32x4 w[4][2]; float rs[4];
#pragma unroll
        for (int r = 0; r < 4; ++r)
#pragma unroll
            for (int j = 0; j < 2; ++j) w[r][j] = ((const u32x4*)(xb + (size_t)(row0 + r) * DM) + lane)[64 * j];
#pragma unroll
        for (int r = 0; r < 4; ++r) rs[r] = ss_rs(ss, row0 + r);
#pragma unroll
        for (int r = 0; r < 4; ++r) { f32x4* o = (f32x4*)(p.out + O_Y + (size_t)(row0 + r) * DM) + 2 * lane;
#pragma unroll
            for (int j = 0; j < 2; ++j) { const u32x4 v = w[r][j]; const float s = rs[r];
                o[128 * j] = (f32x4){__uint_as_float(v.x << 16) * s * g[j][0][0], __uint_as_float(v.x & 0xffff0000u) * s * g[j][0][1], __uint_as_float(v.y << 16) * s * g[j][0][2], __uint_as_float(v.y & 0xffff0000u) * s * g[j][0][3]};
                o[128 * j + 1] = (f32x4){__uint_as_float(v.z << 16) * s * g[j][1][0], __uint_as_float(v.z & 0xffff0000u) * s * g[j][1][1], __uint_as_float(v.w << 16) * s * g[j][1][2], __uint_as_float(v.w & 0xffff0000u) * s * g[j][1][3]}; } }
    }
}

template <int KIND>
__device__ __forceinline__ void slab_gemm(const Params& p, LAS unsigned char* lds, const bf16_t* A, const bf16_t* Bt, int K, int N,
                                          const float* xin_s, float* xout_s, bf16_t* xb, float* ss, bf16_t* hid) {
    int tid_ = threadIdx.x; asm volatile("" : "+v"(tid_));
    const int tid = tid_, wid = __builtin_amdgcn_readfirstlane(tid >> 6), lane = tid & 63, l15 = lane & 15, g = lane >> 4;
    const int npieces = 8 * (N / 64), kw = K / 8;
#pragma unroll 1
    for (int pc = blockIdx.x; pc < npieces; pc += gridDim.x) {
        const int rt = pc & 7, cg = pc >> 3;
        f32x4 acc[4];
#pragma unroll
        for (int ct = 0; ct < 4; ++ct) acc[ct] = (f32x4){0.f, 0.f, 0.f, 0.f};
        const bf16_t* ap = A + (size_t)(MP + rt * 16 + l15) * K + wid * kw + 8 * g;
        const bf16_t* bp = Bt + (size_t)(cg * 64 + l15) * K + wid * kw + 8 * g;
#pragma unroll 4
        for (int ks = 0; ks < kw / 32; ++ks) {
            const bf16x8 x = *(const bf16x8*)(ap + 32 * ks);
#pragma unroll
            for (int ct = 0; ct < 4; ++ct) { const bf16x8 y = *(const bf16x8*)(bp + (size_t)ct * 16 * K + 32 * ks); acc[ct] = mma16(x, y, acc[ct]); }
        }
        LAS f32x4* part = (LAS f32x4*)lds;
#pragma unroll
        for (int ct = 0; ct < 4; ++ct) part[(wid * 4 + ct) * 64 + lane] = acc[ct];
        __syncthreads();
        const int r = 2 * wid + (lane >> 5), c = 2 * (lane & 31), gg = r >> 2, j = r & 3;
        float v0 = 0.f, v1 = 0.f;
#pragma unroll
        for (int w = 0; w < 8; ++w) { const LAS float* pp = (const LAS float*)lds + ((w * 4 + (c >> 4)) * 64 + 16 * gg + (c & 15)) * 4 + j; v0 += pp[0]; v1 += pp[4]; }
        const int row = MP + rt * 16 + r, col = cg * 64 + c;
        if (KIND == 0) {
            const size_t off = (size_t)(rt * 16 + r) * DM + col;
            float r0, r1;
            if (xin_s) { r0 = xin_s[off]; r1 = xin_s[off + 1]; }
            else { const unsigned xw = *(const unsigned*)(xb + (size_t)row * DM + col); r0 = __uint_as_float(xw << 16); r1 = __uint_as_float(xw & 0xffff0000u); }
            const float o0 = r0 + v0, o1 = r1 + v1;
            if (xout_s) { xout_s[off] = o0; xout_s[off + 1] = o1; }
            if (xb) *(unsigned*)(xb + (size_t)row * DM + col) = cvt_pk_bf16(o0, o1);
            float sq = o0 * o0 + o1 * o1;
#pragma unroll
            for (int o = 1; o < 32; o <<= 1) sq += __shfl_xor(sq, o);
            if ((lane & 31) == 0) ss[(size_t)row * 16 + cg] = sq;
        } else if (KIND == 1) {
            const float rs = ss_rs(ss, row), a0 = fmaxf(v0 * rs, 0.f), a1 = fmaxf(v1 * rs, 0.f);
            *(unsigned*)(hid + (size_t)row * DFF + col) = cvt_pk_bf16(a0 * a0, a1 * a1);
        } else {
            const int l = (int)(size_t)xin_s;
            const int sb = rt, st = r, pos = SEQ + st;
            const float rs = ss_rs(ss, row), a0 = v0 * rs, a1 = v1 * rs;
            if (col < 768) {
                bf16_t* dst = col < 256 ? WSP(bf16_t, WS_UA) : (col < 512 ? WSP(bf16_t, WS_GA) : WSP(bf16_t, WS_UB)); const int cc = col & 255;
                *(unsigned*)(dst + (size_t)row * 256 + cc) = cvt_pk_bf16(a0, a1);
                if (col < 256 && st >= SS - 3) { float* o = p.out + O_CONVS + ((size_t)(l * SB + sb) * 3 + (st - (SS - 3))) * 256 + cc; o[0] = a0; o[1] = a1; }
            } else if (col < 1408) {
                const int jp = (col & 63) >> 1; const float* rp = WSP(const float, WS_ROPE) + ((size_t)pos * 32 + jp) * 2;
                const float cs = rp[0], sn = rp[1], o0 = a0 * cs - a1 * sn, o1 = a1 * cs + a0 * sn;
                if (col < 1280) *(unsigned*)(WSP(bf16_t, WS_Q) + (size_t)row * 512 + (col - 768)) = cvt_pk_bf16(o0 * 0.125f, o1 * 0.125f);
                else { const int kc = col - 1280, kvh = kc >> 6;
                    *(unsigned*)(WSP(bf16_t, WS_KBS) + ((size_t)(l * SB + sb) * 144 + 128 + st) * 128 + kc) = cvt_pk_bf16(o0, o1);
                    float* o = p.out + O_KS + (((size_t)(l * SB + sb) * SS + st) * 2 + kvh) * 64 + jp; o[0] = o0; o[32] = o1; }
            } else {
                const int vc = col - 1408, kvh = vc >> 6, d = vc & 63;
                bf16_t* vt = WSP(bf16_t, WS_VTS) + ((size_t)(l * SB + sb) * 128 + vc) * 144 + 128 + st; vt[0] = f2bf(a0); vt[144] = f2bf(a1);
                float* o = p.out + O_VS + (((size_t)(l * SB + sb) * SS + st) * 2 + kvh) * 64 + d; o[0] = a0; o[1] = a1;
            }
        }
        __syncthreads();
    }
}

#define XB_TMO      128
#define XB_XCNT(j)  (256  + 64 * (j))
#define XB_XSUB(j)  (1280 + 64 * (j))
#define XB_XGEN(j)  (2304 + 64 * (j))
#define XB_TOP      3328
#define XB_TOPGEN   3392
#define XCD_BAR_WORDS 3456
#define XB_SPIN_CAP (1u << 18)

__device__ __forceinline__ unsigned xb_ld(unsigned* p)              { return __hip_atomic_load(p, __ATOMIC_RELAXED, __HIP_MEMORY_SCOPE_AGENT); }
__device__ __forceinline__ unsigned xb_add(unsigned* p, unsigned v) { return __hip_atomic_fetch_add(p, v, __ATOMIC_RELAXED, __HIP_MEMORY_SCOPE_AGENT); }
__device__ __forceinline__ unsigned xb_xcc_id() { return (unsigned)__builtin_amdgcn_s_getreg((3 << 11) | 20) & 0xFu; }
#define XB_SPIN(cond, bar) do { unsigned _sp = 0; while (cond) { __builtin_amdgcn_s_sleep(1); \
    if ((++_sp & 255u) == 0u) { if (xb_ld(&(bar)[XB_TMO])) break; if (_sp > XB_SPIN_CAP) { atomicAdd(&(bar)[XB_TMO], 1u); break; } } } } while (0)

struct XcdBarrier {
    unsigned* bar; unsigned x;
    volatile LAS unsigned* st;
};

__device__ __forceinline__ XcdBarrier xcd_barrier_post(unsigned* bar, volatile LAS unsigned* st) {
    XcdBarrier b; b.bar = bar; b.x = xb_xcc_id(); b.st = st;
    if (threadIdx.x == 0) (void)xb_add(&bar[XB_XCNT(b.x)], 1u);
    return b;
}
__device__ __forceinline__ void xcd_barrier_complete(unsigned* bar, unsigned x, unsigned& nloc, unsigned& nx) {
    const unsigned G = gridDim.x * gridDim.y * gridDim.z;
    unsigned sum, cnt, mine, sp = 0u;
    for (;;) {
        sum = 0u; cnt = 0u; mine = 0u;
#pragma unroll
        for (unsigned j = 0; j < 16; ++j) { const unsigned c = xb_ld(&bar[XB_XCNT(j)]); sum += c; cnt += (c > 0u) ? 1u : 0u; mine = (j == x) ? c : mine; }
        if (sum == G) break;
        __builtin_amdgcn_s_sleep(1);
        if ((++sp & 255u) == 0u) { if (xb_ld(&bar[XB_TMO])) break; if (sp > XB_SPIN_CAP) { atomicAdd(&bar[XB_TMO], 1u); break; } }
    }
    nloc = mine > 0u ? mine : 1u; nx = cnt > 0u ? cnt : 1u;
}

__device__ __forceinline__ void xcd_barrier(const XcdBarrier& b) {
    asm volatile("s_waitcnt vmcnt(0)" ::: "memory");
    __syncthreads();
    if (threadIdx.x == 0) {
        unsigned* bar = b.bar;
        __builtin_amdgcn_s_waitcnt(0);
        unsigned nloc = b.st[0], nx = b.st[1];
        if (nloc == 0u) { xcd_barrier_complete(bar, b.x, nloc, nx); b.st[0] = nloc; b.st[1] = nx; }
        const unsigned old = xb_add(&bar[XB_XSUB(b.x)], 1u);
        const unsigned gen = old / nloc;
        if (old + 1u == (gen + 1u) * nloc) {
            __builtin_amdgcn_fence(__ATOMIC_RELEASE, "agent");
            asm volatile("s_waitcnt vmcnt(0)" ::: "memory");
            const unsigned og = xb_add(&bar[XB_TOP], 1u);
            const unsigned tg = og / nx;
            if (og + 1u == (tg + 1u) * nx) xb_add(&bar[XB_TOPGEN], 1u);
            else XB_SPIN(xb_ld(&bar[XB_TOPGEN]) == tg, bar);
            __builtin_amdgcn_fence(__ATOMIC_ACQUIRE, "agent");
            xb_add(&bar[XB_XGEN(b.x)], 1u);
            asm volatile("s_waitcnt vmcnt(0)" ::: "memory");
        } else {
            XB_SPIN(xb_ld(&bar[XB_XGEN(b.x)]) == gen, bar);
            __builtin_amdgcn_fence(__ATOMIC_ACQUIRE, "agent");
            asm volatile("s_waitcnt vmcnt(0)" ::: "memory");
        }
    }
    __syncthreads();
}

#define GSYNC_CG() do { asm volatile("s_waitcnt vmcnt(0) lgkmcnt(0)" ::: "memory"); grid.sync(); __builtin_amdgcn_fence(__ATOMIC_ACQUIRE, "agent"); asm volatile("s_waitcnt vmcnt(0)" ::: "memory"); } while (0)
#define GSYNC() do { XcdBarrier xb_; xb_.bar = (unsigned*)(p.ws + WS_CTL); xb_.x = xb_xcc_id(); xb_.st = (volatile LAS unsigned*)(lds + L_MISC); xcd_barrier(xb_); } while (0)
__global__ void __launch_bounds__(NTHR, 2) fwd_kernel(Params p) {
    extern __shared__ __attribute__((aligned(16))) unsigned char lds_raw[];
    LAS unsigned char* lds = (LAS unsigned char*)lds_raw;
    cg::grid_group grid = cg::this_grid();
    const int G = gridDim.x, cid = blockIdx.x;
    volatile LAS unsigned* misc = (volatile LAS unsigned*)(lds + L_MISC);
    if (threadIdx.x < 2) misc[threadIdx.x] = 0u;
    if (threadIdx.x < 33) ((LAS unsigned long long*)(lds + L_PTAB))[threadIdx.x] = ((const unsigned long long*)__builtin_amdgcn_kernarg_segment_ptr())[threadIdx.x];
    __syncthreads();
    (void)xcd_barrier_post((unsigned*)(p.ws + WS_CTL), misc);
#ifndef EN
#define EN 0xff
#endif
#ifndef DUP
#define DUP 0
#endif
#define REPS(bit) (((DUP) & (bit)) && l == 0 ? 2 : 1)
#ifndef DUPP
#define DUPP 1
#endif
#pragma unroll 1
    for (int rp = 0; rp < DUPP; ++rp) { if (EN & 1) prologue(p, lds); __syncthreads(); }
#ifdef NOCG
    if (gridDim.y == 0x7fffffffu)
#endif
    GSYNC_CG();
#ifdef NOCG
    GSYNC();
#endif
#pragma unroll 1
    for (int l = 0; l < DEPTH; ++l) {
        if (EN & 2) {
            pg8::Gemm gm{WSP(const bf16_t, WS_XB), WSP(const bf16_t, WS_WIN) + (size_t)l * DIN * DM, MP, DIN, DM}; pg8::StaticOrder S; S.init(MP, DIN, G, cid);
            EpiIn E{p.ws, p.out, l};
            pg8::gemm_phase<EpiIn, pg8::StaticOrder, true, true>(lds, gm, S, E);
            slab_gemm<2>(p, lds, WSP(const bf16_t, WS_XB), WSP(const bf16_t, WS_WIN) + (size_t)l * DIN * DM, DM, DIN, (const float*)(size_t)l, nullptr, nullptr, WSP(float, WS_SS), nullptr);
        }
        GSYNC();
        if (EN & 4) mixer_pass(p, l, 0, lds);
        GSYNC();
        if (EN & 8) mixer_pass(p, l, 1, lds);
        GSYNC();
        if (EN & 16) {
            pg8::Gemm gm{WSP(const bf16_t, WS_MIX), WSP(const bf16_t, WS_WOUT) + (size_t)l * DM * DM, MP, DM, DM}; pg8::StaticOrder S; S.init(MP, DM, G, cid);
            EpiResB E{WSP(bf16_t, WS_XB), WSP(float, WS_SS)};
            pg8::gemm_phase<EpiResB, pg8::StaticOrder, true, true>(lds, gm, S, E);
            slab_gemm<0>(p, lds, WSP(const bf16_t, WS_MIX), WSP(const bf16_t, WS_WOUT) + (size_t)l * DM * DM, DM, DM, nullptr, nullptr, WSP(bf16_t, WS_XB), WSP(float, WS_SS), nullptr);
        }
        GSYNC();
        if (EN & 32) {
            pg8::Gemm gm{WSP(const bf16_t, WS_XB), WSP(const bf16_t, WS_WUP) + (size_t)l * DFF * DM, MP, DFF, DM}; pg8::StaticOrder S; S.init(MP, DFF, G, cid);
            EpiUp E{WSP(const float, WS_SS), WSP(bf16_t, WS_HID)};
            pg8::gemm_phase<EpiUp, pg8::StaticOrder, true, true>(lds, gm, S, E);
            slab_gemm<1>(p, lds, WSP(const bf16_t, WS_XB), WSP(const bf16_t, WS_WUP) + (size_t)l * DFF * DM, DM, DFF, nullptr, nullptr, nullptr, WSP(float, WS_SS), WSP(bf16_t, WS_HID));
        }
        GSYNC();
        if (EN & 64) {
            pg8::Gemm gm{WSP(const bf16_t, WS_HID), WSP(const bf16_t, WS_WDN) + (size_t)l * DM * DFF, MP, DM, DFF}; pg8::StaticOrder S; S.init(MP, DM, G, cid);
            EpiResB E{WSP(bf16_t, WS_XB), WSP(float, WS_SS)};
            pg8::gemm_phase<EpiResB, pg8::StaticOrder, true, true>(lds, gm, S, E);
            slab_gemm<0>(p, lds, WSP(const bf16_t, WS_HID), WSP(const bf16_t, WS_WDN) + (size_t)l * DM * DFF, DFF, DM, nullptr, nullptr, WSP(bf16_t, WS_XB), WSP(float, WS_SS), nullptr);
        }
        GSYNC();
    }
    if (EN & 128) final_norm(p);
}

extern "C" void kernel_launch(void* const* d_in, const int* in_sizes, int n_in, void* d_out, int out_size, void* d_ws, size_t ws_size, hipStream_t stream) {
    static int grid = 0;
    if (grid == 0) {
        if (n_in != 33 || (size_t)out_size != O_END || ws_size < WS_TOTAL) { fprintf(stderr, "kernel_launch: unexpected shapes (n_in %d out %d ws %zu)\n", n_in, out_size, ws_size); grid = -1; return; }
        int dev = 0, cus = 0, per = 0;
        if (hipGetDevice(&dev) != hipSuccess || hipDeviceGetAttribute(&cus, hipDeviceAttributeMultiprocessorCount, dev) != hipSuccess) { grid = -1; return; }
        if (hipFuncSetAttribute((const void*)fwd_kernel, hipFuncAttributeMaxDynamicSharedMemorySize, LDS_BYTES) != hipSuccess) { fprintf(stderr, "kernel_launch: hipFuncSetAttribute failed\n"); grid = -1; return; }
        if (hipOccupancyMaxActiveBlocksPerMultiprocessor(&per, (const void*)fwd_kernel, NTHR, LDS_BYTES) != hipSuccess || per < 1) { fprintf(stderr, "kernel_launch: occupancy query says %d\n", per); per = 1; }
        (void)hipGetLastError();
        grid = cus;
    }
    if (grid < 0) return;
    if (hipMemsetAsync((char*)d_ws + WS_CTL, 0, CTL_BYTES, stream) != hipSuccess) { fprintf(stderr, "kernel_launch: hipMemsetAsync failed\n"); return; }
    Params p{};
    for (int i = 0; i < 33; ++i) p.in[i] = (const float*)d_in[i];
    p.out = (float*)d_out; p.ws = (unsigned char*)d_ws;
    void* args[] = {&p};
    hipError_t e = hipLaunchCooperativeKernel((const void*)fwd_kernel, dim3(grid), dim3(NTHR), args, LDS_BYTES, stream);
    if (e != hipSuccess) fprintf(stderr, "kernel_launch: cooperative launch failed: %s (grid %d)\n", hipGetErrorString(e), grid);
}
```
